# Optimizing an MI355X kernel written in HIP

```python
import math
import jax, jax.numpy as jnp
from jax import lax
import numpy as np

D_MODEL = 2048
BATCH = 8
SEQ = 2048
DEPTH = 2

HEAD_DIM = 128
N_HEADS = D_MODEL // HEAD_DIM
N_HEADS_A = (3 * N_HEADS) // 8
N_HEADS_B = (N_HEADS - N_HEADS_A) // 2
N_HEADS_C = N_HEADS - N_HEADS_A - N_HEADS_B
DILATION_PATTERNS = ((128, 1), (512, 4), (2048, 16))
BLOCK = 128
D_FF = ((8 * D_MODEL // 3 + 255) // 256) * 256
CONV_WIDTH = 3
EPS = 1e-6
NEG = -1e30
IN_SIZES = ([N_HEADS_A * HEAD_DIM] * 3 + [N_HEADS_B * HEAD_DIM] * 3
            + [N_HEADS_C * HEAD_DIM] * 3 + [N_HEADS_C])
N_IN = sum(IN_SIZES)

kernel_name = "hybrid_dilated_stickbreak_forgetting_convffn"


def rmsnorm(x, g):
    xf = x.astype(jnp.float32)
    y = xf * lax.rsqrt(jnp.mean(xf * xf, axis=-1, keepdims=True) + EPS)
    return (y * g.astype(jnp.float32)).astype(x.dtype)


def split_heads(t, h):
    b, s, _ = t.shape
    return t.reshape(b, s, h, HEAD_DIM).transpose(0, 2, 1, 3).astype(jnp.float32)


def alibi_slopes(n):
    return 2.0 ** (-8.0 * (jnp.arange(n, dtype=jnp.float32) + 1.0) / n)


def dilated_pattern(q, k, v, slopes, window, dil):
    b, h, t, d = q.shape
    length = t // dil
    nb = -(-length // BLOCK)
    lp = nb * BLOCK
    wsub = window // dil

    def to_sub(a):
        a = a.reshape(b, h, length, dil, d).transpose(0, 1, 3, 2, 4)
        a = jnp.pad(a, ((0, 0), (0, 0), (0, 0), (0, lp - length), (0, 0)))
        return a.reshape(b, h, dil, nb, BLOCK, d)

    def band(a):
        prev = jnp.concatenate([jnp.zeros_like(a[:, :, :, :1]), a[:, :, :, :-1]], axis=3)
        return jnp.concatenate([prev, a], axis=4)

    qb = to_sub(q)
    kw = band(to_sub(k))
    vw = band(to_sub(v))
    s = jnp.einsum('bhrnqd,bhrnkd->bhrnqk', qb, kw) / math.sqrt(d)
    qi = jnp.arange(BLOCK)[:, None]
    kc = jnp.arange(2 * BLOCK)[None, :]
    delta = BLOCK + qi - kc
    keypos = (jnp.arange(nb)[:, None, None] - 1) * BLOCK + kc[None]
    valid = (delta >= 0) & (delta <= wsub) & (keypos >= 0)
    alibi = -slopes[:, None, None, None, None] * (dil * delta).astype(jnp.float32)
    s = jnp.where(valid, s + alibi, NEG)
    lse = jax.nn.logsumexp(s, axis=-1)
    p = jnp.exp(s - lse[..., None])
    o = jnp.einsum('bhrnqk,bhrnkd->bhrnqd', p, vw)
    o = o.reshape(b, h, dil, lp, d)[:, :, :, :length].transpose(0, 1, 3, 2, 4).reshape(b, h, t, d)
    lse = lse.reshape(b, h, dil, lp)[:, :, :, :length].transpose(0, 1, 3, 2).reshape(b, h, t)
    return o, lse


def dilated_mixture(q, k, v):
    slopes = alibi_slopes(q.shape[1])
    outs, lses = [], []
    for window, dil in DILATION_PATTERNS:
        o, lse = dilated_pattern(q, k, v, slopes, window, dil)
        outs.append(o)
        lses.append(lse)
    w = jax.nn.softmax(jnp.stack(lses, axis=0), axis=0)
    return jnp.sum(w[..., None] * jnp.stack(outs, axis=0), axis=0)


def stick_breaking(q, k, v):
    b, h, t, d = q.shape
    nb = t // BLOCK
    qb = q.reshape(b, h, nb, BLOCK, d).transpose(2, 0, 1, 3, 4)
    kpos = jnp.arange(t)
    scale = 1.0 / math.sqrt(d)

    def one(args):
        qblk, n = args
        z = jnp.einsum('bhqd,bhkd->bhqk', qblk, k) * scale
        qpos = n * BLOCK + jnp.arange(BLOCK)
        causal = kpos[None, :] < qpos[:, None]
        log_1m = jnp.where(causal, jax.nn.log_sigmoid(-z), 0.0)
        after = lax.cumsum(log_1m, axis=3, reverse=True) - log_1m
        a = jnp.where(causal, jnp.exp(jax.nn.log_sigmoid(z) + after), 0.0)
        return jnp.einsum('bhqk,bhkd->bhqd', a, v)

    o = lax.map(one, (qb, jnp.arange(nb)))
    return o.transpose(1, 2, 0, 3, 4).reshape(b, h, t, d)


def forgetting_attention(q, k, v, log_f):
    b, h, t, d = q.shape
    nb = t // BLOCK
    c = lax.cumsum(log_f, axis=2)
    qb = q.reshape(b, h, nb, BLOCK, d).transpose(2, 0, 1, 3, 4)
    cb = c.reshape(b, h, nb, BLOCK).transpose(2, 0, 1, 3)
    kpos = jnp.arange(t)
    scale = 1.0 / math.sqrt(d)

    def one(args):
        qblk, cq, n = args
        s = jnp.einsum('bhqd,bhkd->bhqk', qblk, k) * scale + cq[..., None] - c[:, :, None, :]
        qpos = n * BLOCK + jnp.arange(BLOCK)
        causal = kpos[None, :] <= qpos[:, None]
        p = jax.nn.softmax(jnp.where(causal, s, NEG), axis=-1)
        return jnp.einsum('bhqk,bhkd->bhqd', p, v)

    o = lax.map(one, (qb, cb, jnp.arange(nb)))
    return o.transpose(1, 2, 0, 3, 4).reshape(b, h, t, d)


def causal_dwconv(hdn, w, bias):
    t = hdn.shape[1]
    padded = jnp.pad(hdn, ((0, 0), (CONV_WIDTH - 1, 0), (0, 0)))
    out = bias
    for j in range(CONV_WIDTH):
        out = out + w[j] * padded[:, j:j + t]
    return out


def hybrid_layer(x, g_mix, w_in, b_f, g_head, w_o, g_ffn, w_gu, conv_w, conv_b, w_down):
    b, t, _ = x.shape
    hn = rmsnorm(x, g_mix)
    proj = hn @ w_in
    idx = [int(v) for v in np.cumsum(IN_SIZES)[:-1]]
    qa, ka, va, qb_, kb, vb, qc, kc, vc, fc = jnp.split(proj, idx, axis=-1)
    o_a = dilated_mixture(split_heads(qa, N_HEADS_A), split_heads(ka, N_HEADS_A),
                          split_heads(va, N_HEADS_A))
    o_b = stick_breaking(split_heads(qb_, N_HEADS_B), split_heads(kb, N_HEADS_B),
                         split_heads(vb, N_HEADS_B))
    log_f = jax.nn.log_sigmoid(fc.astype(jnp.float32) + b_f.astype(jnp.float32))
    o_c = forgetting_attention(split_heads(qc, N_HEADS_C), split_heads(kc, N_HEADS_C),
                               split_heads(vc, N_HEADS_C), log_f.transpose(0, 2, 1))
    o = jnp.concatenate([o_a, o_b, o_c], axis=1)
    o = o * lax.rsqrt(jnp.mean(o * o, axis=-1, keepdims=True) + EPS) \
        * g_head.astype(jnp.float32)[None, :, None, :]
    o = o.transpose(0, 2, 1, 3).reshape(b, t, D_MODEL).astype(x.dtype)
    x = x + o @ w_o
    hn = rmsnorm(x, g_ffn)
    gu = causal_dwconv(hn @ w_gu, conv_w, conv_b)
    gate, up = jnp.split(gu, 2, axis=-1)
    return x + (jax.nn.silu(gate) * up) @ w_down


def setup_inputs(seed: int = 0) -> dict:
    key = jax.random.key(seed)
    ks = jax.random.split(key, 12)
    f32 = jnp.float32
    nrm = jax.random.normal
    return {
        "x": nrm(ks[0], (BATCH, SEQ, D_MODEL), f32),
        "g_mix": 1.0 + 0.02 * nrm(ks[1], (DEPTH, D_MODEL), f32),
        "w_in": nrm(ks[2], (DEPTH, D_MODEL, N_IN), f32) * D_MODEL ** -0.5,
        "b_f": 1.0 + 3.0 * jax.random.uniform(ks[3], (DEPTH, N_HEADS_C), f32),
        "g_head": 1.0 + 0.02 * nrm(ks[4], (DEPTH, N_HEADS, HEAD_DIM), f32),
        "w_o": nrm(ks[5], (DEPTH, D_MODEL, D_MODEL), f32) * D_MODEL ** -0.5,
        "g_ffn": 1.0 + 0.02 * nrm(ks[6], (DEPTH, D_MODEL), f32),
        "w_gu": nrm(ks[7], (DEPTH, D_MODEL, 2 * D_FF), f32) * D_MODEL ** -0.5,
        "conv_w": nrm(ks[8], (DEPTH, CONV_WIDTH, 2 * D_FF), f32) * CONV_WIDTH ** -0.5,
        "conv_b": 0.02 * nrm(ks[9], (DEPTH, 2 * D_FF), f32),
        "w_down": nrm(ks[10], (DEPTH, D_FF, D_MODEL), f32) * D_FF ** -0.5,
        "g_final": 1.0 + 0.02 * nrm(ks[11], (D_MODEL,), f32),
    }


def reference(x, g_mix, w_in, b_f, g_head, w_o, g_ffn, w_gu, conv_w, conv_b, w_down, g_final):
    for layer in range(DEPTH):
        x = hybrid_layer(x, g_mix[layer], w_in[layer], b_f[layer], g_head[layer], w_o[layer],
                         g_ffn[layer], w_gu[layer], conv_w[layer], conv_b[layer], w_down[layer])
    return rmsnorm(x, g_final)
```

```cpp
#include <hip/hip_runtime.h>
#include <hip/hip_cooperative_groups.h>
#include <cstdio>
#include <cstdint>
namespace cg = cooperative_groups;
namespace pg8 {
#define PG8_LAS __attribute__((address_space(3)))
typedef unsigned short bf16_t;
typedef short bf16x8 __attribute__((ext_vector_type(8)));
typedef float f32x4 __attribute__((ext_vector_type(4)));
typedef unsigned u32x4 __attribute__((ext_vector_type(4)));
constexpr int BM = 256, BK = 64, HALF = 128, HTB = HALF * BK * 2  , STAGE_BYTES = 8 * HTB, NXCD = 8, WGM = 8;

__host__ __device__ __forceinline__ int lds_byte(int r, int c) { const int st = (r >> 4) * 2 + (c >> 5), rr = r & 15, cc = c & 31, ob = rr * 64 + cc * 2; return st * 1024 + (ob ^ (((ob >> 9) & 1) << 5)); }
__host__ __device__ __forceinline__ void stage_rc(int b, int& R, int& C) { const int st = b / 1024, sb = b % 1024, swz = sb ^ (((sb >> 9) & 1) << 5); R = (st >> 1) * 16 + swz / 64; C = (st & 1) * 32 + (swz % 64) / 2; }
__host__ __device__ __forceinline__ int perm32(int rho) { const int n = rho >> 4, i = rho & 15; return 8 * (i >> 2) + 4 * n + (i & 3); }

struct Unit { int pm, pn; };
struct Gemm { const bf16_t* A; const bf16_t* Bt; int M, N, K; };

struct StaticOrder {
    int nM, nN, nwg, G, c;
    __host__ __device__ void init(int M, int N, int G_, int c_) { nM = M / BM; nN = N / BM; nwg = nM * nN; G = G_; c = c_; }
    __host__ __device__ bool next(int i, Unit& u) const {
        const long L = (long)i * G + c; if (L >= nwg) return false;
        int wgid = (int)L; { const int q = nwg / NXCD, r = nwg % NXCD, xcd = wgid % NXCD, off = wgid / NXCD; wgid = (xcd < r ? xcd * (q + 1) : r * (q + 1) + (xcd - r) * q) + off; }
        const int nig = WGM * nN, gid = wgid / nig, fm = gid * WGM, gsz = (nM - fm) < WGM ? (nM - fm) : WGM;
        u.pm = fm + ((wgid % nig) % gsz); u.pn = (wgid % nig) / gsz; return true;
    }
    __device__ __forceinline__ void a_ready(const Unit&) const {}
    __device__ __forceinline__ void done(const Unit&) const {}
};
struct CountedOrder : StaticOrder {
    const unsigned* ready; unsigned need; unsigned* tmo;
    __device__ __forceinline__ void a_ready(const Unit& u) const {
        if (threadIdx.x < 64) {
            const unsigned long long t0 = __builtin_amdgcn_s_memrealtime(); unsigned polls = 0;
            while ((unsigned)__builtin_amdgcn_readfirstlane(__hip_atomic_load(ready + 64 * u.pm, __ATOMIC_RELAXED, __HIP_MEMORY_SCOPE_AGENT)) < need) {
                if ((++polls & 255u) == 0u && __builtin_amdgcn_readfirstlane(__hip_atomic_load(tmo, __ATOMIC_RELAXED, __HIP_MEMORY_SCOPE_AGENT)) != 0u) break;
                if (__builtin_amdgcn_s_memrealtime() - t0 > 2000000ull) {
                    if (threadIdx.x == 0) { unsigned expect = 0u; __hip_atomic_compare_exchange_strong(tmo + 1, &expect, 0x600u | (unsigned)(u.pm & 0xff), __ATOMIC_RELAXED, __ATOMIC_RELAXED, __HIP_MEMORY_SCOPE_AGENT); __hip_atomic_store(tmo, 1u, __ATOMIC_RELAXED, __HIP_MEMORY_SCOPE_AGENT); }
                    break; }
                __builtin_amdgcn_s_sleep(2); }
            __builtin_amdgcn_fence(__ATOMIC_ACQUIRE, "agent");
            asm volatile("s_waitcnt vmcnt(0)" ::: "memory");
        }
#if !defined(BROKEN_HOOK_NO_BARRIER)
        asm volatile("" ::: "memory"); __builtin_amdgcn_s_barrier(); asm volatile("" ::: "memory");
#endif
    }
};

__device__ __forceinline__ unsigned cvt_pk_bf16(float lo, float hi) { unsigned r; asm volatile("v_cvt_pk_bf16_f32 %0, %1, %2" : "=v"(r) : "v"(lo), "v"(hi)); return r; }
typedef float f32x2 __attribute__((ext_vector_type(2)));
__device__ __forceinline__ f32x2 gelu_pk(f32x2 v) {
    const f32x2 av = __builtin_elementwise_abs(v), d = av * 0.2316418882f + 1.0f;
    f32x2 t; t.x = __builtin_amdgcn_rcpf(d.x); t.y = __builtin_amdgcn_rcpf(d.y);
    f32x2 q = t * 0.5307027145f + (-0.7265760135f); q = q * t + 0.7107068705f; q = q * t + (-0.142248368f); q = q * t + 0.127414796f; q = q * t;
    const f32x2 s = (v * v) * (-0.72134752044f);
    f32x2 e; e.x = __builtin_amdgcn_exp2f(s.x); e.y = __builtin_amdgcn_exp2f(s.y);
    const f32x2 m = v * (q * e), r = v - m;
    f32x2 o; o.x = v.x < 0.f ? m.x : r.x; o.y = v.y < 0.f ? m.y : r.y; return o;
}

struct EpiF32 {
    static constexpr bool PERM = false, AFTER_DRAIN = false;
    float* C; int ldc; const float* bias;
    __device__ __forceinline__ void operator()(const f32x4 (&acc)[2][2][4][2], const Unit& u, int wr, int wc, int fr, int fq) const {
        const int row0 = u.pm * BM + wr * 64 + fr, col0 = u.pn * BM + wc * 32 + 4 * fq;
        f32x4 bv[2][2];
#pragma unroll
        for (int bj = 0; bj < 2; ++bj)
#pragma unroll
            for (int n = 0; n < 2; ++n) bv[bj][n] = bias ? *(const f32x4*)(bias + col0 + bj * HALF + n * 16) : (f32x4){0.f, 0.f, 0.f, 0.f};
#pragma unroll
        for (int ai = 0; ai < 2; ++ai)
#pragma unroll
            for (int m = 0; m < 4; ++m) { float* rowp = C + (size_t)(row0 + ai * HALF + m * 16) * ldc + col0;
#pragma unroll
                for (int bj = 0; bj < 2; ++bj)
#pragma unroll
                    for (int n = 0; n < 2; ++n) *(f32x4*)(rowp + bj * HALF + n * 16) = acc[ai][bj][m][n] + bv[bj][n]; }
    }
};
template <int ACT  > struct EpiBf16 {
    static constexpr bool PERM = true, AFTER_DRAIN = false;
    bf16_t* O; int ldc; const float* bias; int split_cols; size_t split_stride;
    __device__ __forceinline__ void operator()(const f32x4 (&acc)[2][2][4][2], const Unit& u, int wr, int wc, int fr, int fq) const {
        const int row0 = u.pm * BM + wr * 64 + fr; int colt = u.pn * BM; bf16_t* base = O;
        if (split_cols) { const int t = colt / split_cols; base += (size_t)t * split_stride; colt -= t * split_cols; }
        const int col0 = colt + wc * 32 + 8 * fq, bcol0 = u.pn * BM + wc * 32 + 8 * fq;
        f32x4 bv[2][2];
#pragma unroll
        for (int bj = 0; bj < 2; ++bj)
#pragma unroll
            for (int n = 0; n < 2; ++n) bv[bj][n] = bias ? *(const f32x4*)(bias + bcol0 + bj * HALF + 4 * n) : (f32x4){0.f, 0.f, 0.f, 0.f};
#pragma unroll
        for (int ai = 0; ai < 2; ++ai)
#pragma unroll
            for (int m = 0; m < 4; ++m) { bf16_t* rowp = base + (size_t)(row0 + ai * HALF + m * 16) * ldc + col0;
#pragma unroll
                for (int bj = 0; bj < 2; ++bj) { f32x4 v0 = acc[ai][bj][m][0] + bv[bj][0], v1 = acc[ai][bj][m][1] + bv[bj][1];
                    if (ACT == 1) { f32x2 a = gelu_pk((f32x2){v0[0], v0[1]}), b = gelu_pk((f32x2){v0[2], v0[3]}), c = gelu_pk((f32x2){v1[0], v1[1]}), d = gelu_pk((f32x2){v1[2], v1[3]});
                        v0 = (f32x4){a.x, a.y, b.x, b.y}; v1 = (f32x4){c.x, c.y, d.x, d.y}; }
                    if (ACT == 2) {
#pragma unroll
                        for (int j = 0; j < 4; ++j) { v0[j] = 0.5f * v0[j] * (1.0f + erff(v0[j] * 0.70710678f)); v1[j] = 0.5f * v1[j] * (1.0f + erff(v1[j] * 0.70710678f)); } }
                    u32x4 w; w.x = cvt_pk_bf16(v0[0], v0[1]); w.y = cvt_pk_bf16(v0[2], v0[3]); w.z = cvt_pk_bf16(v1[0], v1[1]); w.w = cvt_pk_bf16(v1[2], v1[3]);
                    *(u32x4*)(rowp + bj * HALF) = w; } }
    }
};
struct EpiRes {
    static constexpr bool PERM = false, AFTER_DRAIN = false;
    const float* base; float* out; int ldc;
    __device__ __forceinline__ void operator()(const f32x4 (&acc)[2][2][4][2], const Unit& u, int wr, int wc, int fr, int fq) const {
        const int row0 = u.pm * BM + wr * 64 + fr, col0 = u.pn * BM + wc * 32 + 4 * fq;
#pragma unroll
        for (int ai = 0; ai < 2; ++ai)
#pragma unroll
            for (int m = 0; m < 4; ++m) { const size_t off = (size_t)(row0 + ai * HALF + m * 16) * ldc + col0;
                f32x4 bv[2][2];
#pragma unroll
                for (int bj = 0; bj < 2; ++bj)
#pragma unroll
                    for (int n = 0; n < 2; ++n) bv[bj][n] = *(const f32x4*)(base + off + bj * HALF + n * 16);
#pragma unroll
                for (int bj = 0; bj < 2; ++bj)
#pragma unroll
                    for (int n = 0; n < 2; ++n) *(f32x4*)(out + off + bj * HALF + n * 16) = acc[ai][bj][m][n] + bv[bj][n];
                asm volatile("" ::: "memory"); }
    }
};
template <class Epi, class Sched, bool STAMP = false>
__device__ __forceinline__ void gemm_phase(PG8_LAS unsigned char* lds, const Gemm g, const Sched& S, const Epi& E, unsigned long long* stamps) {
    int tid_l = threadIdx.x; asm volatile("" : "+v"(tid_l)); const int tid = tid_l, wid = __builtin_amdgcn_readfirstlane(tid >> 6), lane = tid & 63, wr = wid >> 2, wc = wid & 3, fr = lane & 15, fq = lane >> 4;
    const int K = g.K, nt = K / BK;
    int ts_lo = 0, ts_hi = 0, nts = 0; const unsigned long long rt_entry = STAMP ? (unsigned long long)wall_clock64() : 0ull;
#define PG8_STAMP() do { if (STAMP && wid == 0 && nts < 64) { const unsigned long long _c = (unsigned long long)clock64(); \
        ts_lo = (lane == nts) ? (int)(unsigned)_c : ts_lo; ts_hi = (lane == nts) ? (int)(unsigned)(_c >> 32) : ts_hi; ++nts; } } while (0)
    PG8_STAMP();
    unsigned voffA[2], voffB[2];
#pragma unroll
    for (int i = 0; i < 2; ++i) { int R, C; stage_rc(tid * 16 + i * 8192, R, C); const int Rb = Epi::PERM ? ((R & ~31) + perm32(R & 31)) : R;
        voffA[i] = (unsigned)(R * K + C) * 2u; voffB[i] = (unsigned)(Rb * K + C) * 2u; }
    const size_t kstep = (size_t)(BK * 2);
    const size_t hstep = (size_t)HALF * K * 2;
    const size_t tstep = 2 * hstep;
    const unsigned ldsw = (unsigned)wid * 1024u;
    const int aoff = lds_byte(wr * 64 + fr, fq * 8), boff = lds_byte(wc * 32 + fr, fq * 8);
#define PG8_SA(b, h) (((b) * 2 + (h)) * HTB)
#define PG8_SB(b, h) ((4 + (b) * 2 + (h)) * HTB)
#define PG8_STAGE(bufoff, gbase, voff) do { _Pragma("unroll") for (int _i = 0; _i < 2; ++_i) \
        __builtin_amdgcn_global_load_lds((const unsigned*)((const char*)(gbase) + (voff)[_i]), (PG8_LAS unsigned*)(lds + (bufoff) + ldsw + _i * 8192), 16, 0, 0); } while (0)
#define PG8_LDA(dst, b, h) do { _Pragma("unroll") for (int m = 0; m < 4; ++m) _Pragma("unroll") for (int k = 0; k < 2; ++k) dst[m][k] = *(const PG8_LAS bf16x8*)(lds + PG8_SA(b, h) + aoff + m * 2048 + k * 1024); } while (0)
#define PG8_LDB(dst, b, h) do { _Pragma("unroll") for (int n = 0; n < 2; ++n) _Pragma("unroll") for (int k = 0; k < 2; ++k) dst[n][k] = *(const PG8_LAS bf16x8*)(lds + PG8_SB(b, h) + boff + n * 2048 + k * 1024); } while (0)
#define PG8_MMA(ai, bj, At, Bt) do { __builtin_amdgcn_s_setprio(1); _Pragma("unroll") for (int m = 0; m < 4; ++m) _Pragma("unroll") for (int n = 0; n < 2; ++n) _Pragma("unroll") for (int k = 0; k < 2; ++k) \
        acc[ai][bj][m][n] = __builtin_amdgcn_mfma_f32_16x16x32_bf16(Bt[n][k], At[m][k], acc[ai][bj][m][n], 0, 0, 0); __builtin_amdgcn_s_setprio(0); } while (0)
#define PG8_WAIT_V(n) asm volatile("s_waitcnt vmcnt(" #n ")" ::: "memory")
#define PG8_WAIT_L(n) asm volatile("s_waitcnt lgkmcnt(" #n ")" ::: "memory")
#define PG8_BAR __builtin_amdgcn_s_barrier()
#define PG8_SCHED __builtin_amdgcn_sched_barrier(0)
    Unit cur, nxt; int ui = 0;
    if (!S.next(0, cur)) return;
    f32x4 acc[2][2][4][2];
#pragma unroll
    for (int a = 0; a < 2; ++a)
#pragma unroll
        for (int b = 0; b < 2; ++b)
#pragma unroll
            for (int m = 0; m < 4; ++m)
#pragma unroll
                for (int n = 0; n < 2; ++n) acc[a][b][m][n] = (f32x4){0.f, 0.f, 0.f, 0.f};
    bf16x8 At[4][2], B0[2][2], B1[2][2];
    const char* cA = (const char*)g.A + (size_t)cur.pm * tstep; const char* cB = (const char*)g.Bt + (size_t)cur.pn * tstep;
    S.a_ready(cur);
    PG8_STAGE(PG8_SB(0, 0), cB, voffB); PG8_STAGE(PG8_SA(0, 0), cA, voffA); PG8_STAGE(PG8_SB(0, 1), cB + hstep, voffB); PG8_STAGE(PG8_SA(0, 1), cA + hstep, voffA);
    if (wr == 1) PG8_BAR;
    PG8_WAIT_V(4); PG8_BAR;
    PG8_STAGE(PG8_SB(1, 0), cB + kstep, voffB); PG8_STAGE(PG8_SA(1, 0), cA + kstep, voffA); PG8_STAGE(PG8_SB(1, 1), cB + hstep + kstep, voffB);
    PG8_WAIT_V(6); PG8_BAR;
    PG8_STAMP();
    for (;;) {
        const bool has_next = S.next(ui + 1, nxt);
        const char* nA = has_next ? (const char*)g.A + (size_t)nxt.pm * tstep : cA; const char* nB = has_next ? (const char*)g.Bt + (size_t)nxt.pn * tstep : cB;
        for (int t = 0; t < nt; t += 2) {
            const bool last = (t == nt - 2);
            const char* a1 = cA + (size_t)(t + 1) * kstep;
            const char* a2 = last ? nA : cA + (size_t)(t + 2) * kstep; const char* b2 = last ? nB : cB + (size_t)(t + 2) * kstep;
            const char* a3 = a2 + kstep; const char* b3 = b2 + kstep;
            if (last && has_next) S.a_ready(nxt);
            PG8_LDB(B0, 0, 0); PG8_SCHED; PG8_LDA(At, 0, 0); PG8_STAGE(PG8_SA(1, 1), a1 + hstep, voffA);
            PG8_WAIT_L(8); PG8_BAR; PG8_WAIT_L(0); PG8_MMA(0, 0, At, B0); PG8_BAR; PG8_SCHED;
            PG8_LDB(B1, 0, 1); PG8_STAGE(PG8_SB(0, 0), b2, voffB);
            PG8_BAR; PG8_WAIT_L(0); PG8_MMA(0, 1, At, B1); PG8_BAR;
            PG8_LDA(At, 0, 1); PG8_STAGE(PG8_SA(0, 0), a2, voffA);
            PG8_BAR; PG8_WAIT_L(0); PG8_MMA(1, 0, At, B0); PG8_BAR; PG8_SCHED;
            PG8_STAGE(PG8_SB(0, 1), b2 + hstep, voffB);
            PG8_WAIT_V(6); PG8_BAR; PG8_MMA(1, 1, At, B1); PG8_BAR;
            PG8_LDB(B0, 1, 0); PG8_SCHED; PG8_LDA(At, 1, 0); PG8_STAGE(PG8_SA(0, 1), a2 + hstep, voffA);
            PG8_WAIT_L(8); PG8_BAR; PG8_WAIT_L(0); PG8_MMA(0, 0, At, B0); PG8_BAR; PG8_SCHED;
            PG8_LDB(B1, 1, 1); PG8_STAGE(PG8_SB(1, 0), b3, voffB);
            PG8_BAR; PG8_WAIT_L(0); PG8_MMA(0, 1, At, B1); PG8_BAR;
            PG8_LDA(At, 1, 1); PG8_STAGE(PG8_SA(1, 0), a3, voffA);
            PG8_BAR; PG8_WAIT_L(0); PG8_MMA(1, 0, At, B0); PG8_BAR; PG8_SCHED;
            PG8_STAGE(PG8_SB(1, 1), b3 + hstep, voffB);
            PG8_WAIT_V(6); PG8_BAR; PG8_MMA(1, 1, At, B1); PG8_BAR;
        }
        PG8_STAMP();
        if constexpr (!Epi::AFTER_DRAIN) { E(acc, cur, wr, wc, fr, fq); S.done(cur); }
        PG8_STAMP();
        if (!has_next) break;
#pragma unroll
        for (int a = 0; a < 2; ++a)
#pragma unroll
            for (int b = 0; b < 2; ++b)
#pragma unroll
                for (int m = 0; m < 4; ++m)
#pragma unroll
                    for (int n = 0; n < 2; ++n) acc[a][b][m][n] = (f32x4){0.f, 0.f, 0.f, 0.f};
        cur = nxt; cA = nA; cB = nB; ++ui;
    }
    PG8_WAIT_V(0);
    if (wr == 0) PG8_BAR;
    PG8_BAR;
    if constexpr (Epi::AFTER_DRAIN) { E.fused(acc, cur, wr, wc, fr, fq, lds, wid, lane); S.done(cur); }
    PG8_STAMP();
    if (STAMP && wid == 0) { stamps[lane] = lane < nts ? (((unsigned long long)(unsigned)ts_hi << 32) | (unsigned)ts_lo) : 0ull;
        if (lane == 62) stamps[62] = rt_entry; if (lane == 63) stamps[63] = (unsigned long long)wall_clock64(); }
#undef PG8_STAMP
#undef PG8_SA
#undef PG8_SB
#undef PG8_STAGE
#undef PG8_LDA
#undef PG8_LDB
#undef PG8_MMA
#undef PG8_WAIT_V
#undef PG8_WAIT_L
#undef PG8_BAR
#undef PG8_SCHED
}
}
namespace mk {
#define LAS __attribute__((address_space(3)))
typedef unsigned short bf16_t;
typedef short bf16x8 __attribute__((ext_vector_type(8)));
typedef short s16x4 __attribute__((ext_vector_type(4)));
typedef float f32x16 __attribute__((ext_vector_type(16)));
typedef float f32x4 __attribute__((ext_vector_type(4)));
typedef unsigned u32x4 __attribute__((ext_vector_type(4)));
typedef unsigned u32x2 __attribute__((ext_vector_type(2)));

constexpr int BATCH = 8, SEQ = 2048, DM = 2048, MTOK = BATCH * SEQ, NIN = 6149, NQKV = 6144, DFF = 5632, NGU = 2 * DFF, HD = 128, NTHR = 512;
constexpr float EPS = 1e-6f;
constexpr float LOG2E = 1.4426950408889634f;
constexpr float C2 = 0.08838834764831845f * LOG2E;
constexpr int LDS_BYTES = 131072;

constexpr size_t WS_WIN = 0, SZ_WIN = (size_t)NQKV * DM * 2;
constexpr size_t WS_WO = WS_WIN + SZ_WIN, SZ_WO = (size_t)DM * DM * 2;
constexpr size_t WS_WGU = WS_WO + SZ_WO, SZ_WGU = (size_t)NGU * DM * 2;
constexpr size_t WS_WD = WS_WGU + SZ_WGU, SZ_WD = (size_t)DM * DFF * 2;
constexpr size_t WS_ABUF = WS_WD + SZ_WD, SZ_ABUF = (size_t)MTOK * DM * 2;
constexpr size_t WS_GU = WS_ABUF + SZ_ABUF, SZ_GU = (size_t)MTOK * NGU * 2;
constexpr size_t WS_H = WS_GU + SZ_GU, SZ_H = (size_t)MTOK * DFF * 2;
constexpr size_t WS_FC = WS_H + SZ_H, SZ_FC = (size_t)MTOK * 8 * 4;
constexpr size_t WS_CTR = WS_FC + SZ_FC, WS_END = WS_CTR + 256;

struct Params { const float *x, *g_mix, *w_in, *b_f, *g_head, *w_o, *g_ffn, *w_gu, *conv_w, *conv_b, *w_down, *g_final; float* out; unsigned char* ws; int ph_lo, ph_hi; };

__device__ __forceinline__ unsigned cvtpk(float lo, float hi) { unsigned r; asm volatile("v_cvt_pk_bf16_f32 %0, %1, %2" : "=v"(r) : "v"(lo), "v"(hi)); return r; }
__device__ __forceinline__ float bf2f_lo(unsigned w) { return __uint_as_float(w << 16); }
__device__ __forceinline__ float bf2f_hi(unsigned w) { return __uint_as_float(w & 0xffff0000u); }

__device__ __forceinline__ void conv_matrix(const float* __restrict__ W, int ldn, int K, int N, bf16_t* __restrict__ Bt, LAS float* tile, int& gofs) {
    int tid_l = threadIdx.x; asm volatile("" : "+v"(tid_l)); const int tid = tid_l, G = gridDim.x;
    const int ntn = N / 64, ntk = K / 64, nt = ntn * ntk;
    const int first = (((int)blockIdx.x - gofs) % G + G) % G;
    for (int t = first; t < nt; t += G) {
        const int tn = t % ntn, tk = t / ntn, k0 = tk * 64, n0 = tn * 64;
        { const int kk = tid >> 6, nn = tid & 63; float v[8];
#pragma unroll
          for (int i = 0; i < 8; ++i) v[i] = W[(size_t)(k0 + i * 8 + kk) * ldn + n0 + nn];
#pragma unroll
          for (int i = 0; i < 8; ++i) tile[(i * 8 + kk) * 65 + nn] = v[i]; }
        __syncthreads();
        { const int n = tid >> 3, kc = (tid & 7) * 8; float f[8];
#pragma unroll
          for (int j = 0; j < 8; ++j) f[j] = tile[(kc + j) * 65 + n];
          u32x4 w = {cvtpk(f[0], f[1]), cvtpk(f[2], f[3]), cvtpk(f[4], f[5]), cvtpk(f[6], f[7])};
          *(u32x4*)(Bt + (size_t)(n0 + n) * K + k0 + kc) = w; }
        __syncthreads();
    }
    gofs += nt;
}

template <bool FC, bool OUTF32>
__device__ __forceinline__ void norm_phase(const float* X, const float* __restrict__ g, bf16_t* hn, float* outf,
                                           const float* __restrict__ w_in_l, float* __restrict__ fcbuf, LAS float* wfc) {
    int tid_l = threadIdx.x; asm volatile("" : "+v"(tid_l)); const int tid = tid_l, wid = tid >> 6, lane = tid & 63;
    if (FC) { for (int i = tid; i < 5 * DM; i += NTHR) { const int d = i / 5, j = i - d * 5; wfc[j * DM + d] = w_in_l[(size_t)d * NIN + NQKV + j]; } __syncthreads(); }
    for (int row = blockIdx.x * 8 + wid; row < MTOK; row += gridDim.x * 8) {
        const float* xr = X + (size_t)row * DM;
        f32x4 v[8];
#pragma unroll
        for (int i = 0; i < 8; ++i) v[i] = *(const f32x4*)(xr + (i * 64 + lane) * 4);
        float ss = 0.f;
#pragma unroll
        for (int i = 0; i < 8; ++i) ss += v[i][0] * v[i][0] + v[i][1] * v[i][1] + v[i][2] * v[i][2] + v[i][3] * v[i][3];
#pragma unroll
        for (int o = 32; o >= 1; o >>= 1) ss += __shfl_xor(ss, o);
        const float rs = 1.0f / sqrtf(ss * (1.0f / DM) + EPS);
        float fc0 = 0.f, fc1 = 0.f, fc2 = 0.f, fc3 = 0.f, fc4 = 0.f;
#pragma unroll
        for (int i = 0; i < 8; ++i) {
            const int d = (i * 64 + lane) * 4;
            const f32x4 gv = *(const f32x4*)(g + d);
            const f32x4 y = v[i] * rs * gv;
            if (OUTF32) *(f32x4*)(outf + (size_t)row * DM + d) = y;
            else { u32x2 w = {cvtpk(y[0], y[1]), cvtpk(y[2], y[3])}; *(u32x2*)(hn + (size_t)row * DM + d) = w; }
            if (FC) {
                const f32x4 w0 = *(const LAS f32x4*)(wfc + 0 * DM + d), w1 = *(const LAS f32x4*)(wfc + 1 * DM + d), w2 = *(const LAS f32x4*)(wfc + 2 * DM + d),
                            w3 = *(const LAS f32x4*)(wfc + 3 * DM + d), w4 = *(const LAS f32x4*)(wfc + 4 * DM + d);
                fc0 += y[0] * w0[0] + y[1] * w0[1] + y[2] * w0[2] + y[3] * w0[3];
                fc1 += y[0] * w1[0] + y[1] * w1[1] + y[2] * w1[2] + y[3] * w1[3];
                fc2 += y[0] * w2[0] + y[1] * w2[1] + y[2] * w2[2] + y[3] * w2[3];
                fc3 += y[0] * w3[0] + y[1] * w3[1] + y[2] * w3[2] + y[3] * w3[3];
                fc4 += y[0] * w4[0] + y[1] * w4[1] + y[2] * w4[2] + y[3] * w4[3];
            }
        }
        if (FC) {
#pragma unroll
            for (int o = 32; o >= 1; o >>= 1) { fc0 += __shfl_xor(fc0, o); fc1 += __shfl_xor(fc1, o); fc2 += __shfl_xor(fc2, o); fc3 += __shfl_xor(fc3, o); fc4 += __shfl_xor(fc4, o); }
            if (lane == 0) { float* f = fcbuf + (size_t)row * 8; f[0] = fc0; f[1] = fc1; f[2] = fc2; f[3] = fc3; f[4] = fc4; }
        }
    }
}

__device__ __forceinline__ void unpack8(const u32x4 w, float (&f)[8]) {
    f[0] = bf2f_lo(w.x); f[1] = bf2f_hi(w.x); f[2] = bf2f_lo(w.y); f[3] = bf2f_hi(w.y); f[4] = bf2f_lo(w.z); f[5] = bf2f_hi(w.z); f[6] = bf2f_lo(w.w); f[7] = bf2f_hi(w.w);
}
__device__ __forceinline__ void convact_phase(const bf16_t* __restrict__ gu, bf16_t* __restrict__ h, const float* __restrict__ cw, const float* __restrict__ cb) {
    constexpr int NCG = DFF / 8, RCH = 16, NCH = MTOK / RCH;
    const long total = (long)NCG * NCH;
    for (long u = (long)blockIdx.x * NTHR + threadIdx.x; u < total; u += (long)gridDim.x * NTHR) {
        const int cgi = (int)(u % NCG), ch = (int)(u / NCG), j0 = cgi * 8, m0 = ch * RCH, t0 = m0 % SEQ;
        float wg[3][8], wu[3][8], bg[8], bu[8];
#pragma unroll
        for (int i = 0; i < 3; ++i)
#pragma unroll
            for (int c = 0; c < 8; ++c) { wg[i][c] = cw[(size_t)i * NGU + j0 + c]; wu[i][c] = cw[(size_t)i * NGU + DFF + j0 + c]; }
#pragma unroll
        for (int c = 0; c < 8; ++c) { bg[c] = cb[j0 + c]; bu[c] = cb[DFF + j0 + c]; }
        float g2[8], g1[8], u2[8], u1[8];
        if (t0 >= 2) {
            unpack8(*(const u32x4*)(gu + (size_t)(m0 - 2) * NGU + j0), g2); unpack8(*(const u32x4*)(gu + (size_t)(m0 - 1) * NGU + j0), g1);
            unpack8(*(const u32x4*)(gu + (size_t)(m0 - 2) * NGU + DFF + j0), u2); unpack8(*(const u32x4*)(gu + (size_t)(m0 - 1) * NGU + DFF + j0), u1);
        } else {
#pragma unroll
            for (int c = 0; c < 8; ++c) { g2[c] = 0.f; g1[c] = 0.f; u2[c] = 0.f; u1[c] = 0.f; }
        }
#pragma unroll 4
        for (int r = 0; r < RCH; ++r) {
            float g0[8], u0[8], o[8];
            unpack8(*(const u32x4*)(gu + (size_t)(m0 + r) * NGU + j0), g0); unpack8(*(const u32x4*)(gu + (size_t)(m0 + r) * NGU + DFF + j0), u0);
#pragma unroll
            for (int c = 0; c < 8; ++c) {
                const float G = bg[c] + wg[0][c] * g2[c] + wg[1][c] * g1[c] + wg[2][c] * g0[c];
                const float U = bu[c] + wu[0][c] * u2[c] + wu[1][c] * u1[c] + wu[2][c] * u0[c];
                const float s = G / (1.0f + __expf(-G));
                o[c] = s * U; g2[c] = g1[c]; g1[c] = g0[c]; u2[c] = u1[c]; u1[c] = u0[c];
            }
            u32x4 w = {cvtpk(o[0], o[1]), cvtpk(o[2], o[3]), cvtpk(o[4], o[5]), cvtpk(o[6], o[7])};
            *(u32x4*)(h + (size_t)(m0 + r) * DFF + j0) = w;
        }
    }
}

constexpr int SHM_K = 16384, SHM_V = 16384;
constexpr int AT_WS = 65536, AT_TAB = AT_WS + 2048, AT_ITEM = AT_TAB + 9216;
#define KSWZ(row, colB) ((row) * 256 + ((colB) ^ (((row) & 7) << 4)))
#define SBAR() __builtin_amdgcn_sched_barrier(0)
__device__ __forceinline__ int v_st(int k, int c) { const int kk = (k & ~0xC) | ((k & 4) << 1) | ((k & 8) >> 1); return ((kk >> 3) * 4 + (c >> 5)) * 512 + ((kk & 7) * 32 + (c & 31)) * 2; }
__device__ __forceinline__ int v_rd_base(int lane) { return ((lane & 3) << 3) | (((lane >> 2) & 3) << 6) | (((lane >> 4) & 1) << 5) | (((lane >> 5) & 1) << 8); }
constexpr int v_rd_off(int d0, int ks, int half) { return d0 * 512 + ks * 4096 + half * 2048; }
__device__ __forceinline__ int crow(int r, int hi) { return (r & 3) + 8 * (r >> 2) + 4 * hi; }
__device__ __forceinline__ float pl32_max(float x) { auto rr = __builtin_amdgcn_permlane32_swap(__float_as_uint(x), __float_as_uint(x), false, false); return fmaxf(__uint_as_float(rr[0]), __uint_as_float(rr[1])); }
__device__ __forceinline__ float pl32_sum(float x) { auto rr = __builtin_amdgcn_permlane32_swap(__float_as_uint(x), __float_as_uint(x), false, false); return __uint_as_float(rr[0]) + __uint_as_float(rr[1]); }
__device__ __forceinline__ float pl32_other(float x, int hi) { auto rr = __builtin_amdgcn_permlane32_swap(__float_as_uint(x), __float_as_uint(x), false, false); return __uint_as_float(hi ? rr[0] : rr[1]); }

__device__ __forceinline__ void qkt(f32x16& p0, f32x16& p1, const LAS char* Kb, int r32, int hi, const bf16x8* qr) {
    p0 = f32x16{}; p1 = f32x16{};
    const LAS char* kb[4];
#pragma unroll
    for (int dd = 0; dd < 4; ++dd) kb[dd] = Kb + KSWZ(r32, (dd * 16 + hi * 8) * 2);
#pragma unroll
    for (int d0 = 0; d0 < 8; ++d0) { const LAS char* a = kb[d0 & 3] + (d0 >> 2) * 128;
        bf16x8 b0 = *reinterpret_cast<const LAS bf16x8*>(a);
        bf16x8 b1 = *reinterpret_cast<const LAS bf16x8*>(a + 32 * 256);
        p0 = __builtin_amdgcn_mfma_f32_32x32x16_bf16(b0, qr[d0], p0, 0, 0, 0);
        p1 = __builtin_amdgcn_mfma_f32_32x32x16_bf16(b1, qr[d0], p1, 0, 0, 0); }
}
__device__ __forceinline__ void pv_tile(f32x16* o, int vb0, bf16x8 pa0, bf16x8 pa1, bf16x8 pa2, bf16x8 pa3) {
#define TRRD(dst, off) asm volatile("ds_read_b64_tr_b16 %0, %1 offset:%2" : "=&v"(dst) : "v"(vb0), "i"(off) : "memory")
#define PV_D0(d0) do { s16x4 l0, l1, l2, l3, h0, h1, h2, h3; constexpr int b_ = v_rd_off(d0, 0, 0); \
        TRRD(l0, b_); TRRD(h0, b_ + 2048); TRRD(l1, b_ + 4096); TRRD(h1, b_ + 6144); TRRD(l2, b_ + 8192); TRRD(h2, b_ + 10240); TRRD(l3, b_ + 12288); TRRD(h3, b_ + 14336); \
        asm volatile("s_waitcnt lgkmcnt(0)" ::: "memory"); SBAR(); \
        o[d0] = __builtin_amdgcn_mfma_f32_32x32x16_bf16(pa0, (bf16x8){l0[0], l0[1], l0[2], l0[3], h0[0], h0[1], h0[2], h0[3]}, o[d0], 0, 0, 0); \
        o[d0] = __builtin_amdgcn_mfma_f32_32x32x16_bf16(pa1, (bf16x8){l1[0], l1[1], l1[2], l1[3], h1[0], h1[1], h1[2], h1[3]}, o[d0], 0, 0, 0); \
        o[d0] = __builtin_amdgcn_mfma_f32_32x32x16_bf16(pa2, (bf16x8){l2[0], l2[1], l2[2], l2[3], h2[0], h2[1], h2[2], h2[3]}, o[d0], 0, 0, 0); \
        o[d0] = __builtin_amdgcn_mfma_f32_32x32x16_bf16(pa3, (bf16x8){l3[0], l3[1], l3[2], l3[3], h3[0], h3[1], h3[2], h3[3]}, o[d0], 0, 0, 0); } while (0)
    PV_D0(0); PV_D0(1); PV_D0(2); PV_D0(3);
#undef PV_D0
#undef TRRD
}
#define PK4(P, B_, OUT) do { unsigned a0 = cvtpk(P[B_+0], P[B_+1]), a1 = cvtpk(P[B_+2], P[B_+3]); \
        unsigned b0 = cvtpk(P[B_+4], P[B_+5]), b1 = cvtpk(P[B_+6], P[B_+7]); \
        auto r0 = __builtin_amdgcn_permlane32_swap(a0, b0, false, false); auto r1 = __builtin_amdgcn_permlane32_swap(a1, b1, false, false); \
        u32x4 w = {r0[0], r1[0], r0[1], r1[1]}; OUT = *reinterpret_cast<bf16x8*>(&w); } while (0)

template <int TYPE>
__device__ __forceinline__ void attn_item(const bf16_t* __restrict__ proj, bf16_t* __restrict__ obuf, const float* __restrict__ fcbuf, const float* __restrict__ bf_l,
                                          const float* __restrict__ ghead_l, int b, int hl, int qb, LAS char* lds) {
    int tid_l = threadIdx.x; asm volatile("" : "+v"(tid_l)); const int tid = tid_l, wid = __builtin_amdgcn_readfirstlane(tid >> 6), lane = tid & 63, r32 = lane & 31, hi = lane >> 5;
    constexpr int LD = NQKV;
    constexpr int QC = TYPE == 0 ? 0 : (TYPE == 1 ? 2304 : 4224), KC = TYPE == 0 ? 768 : (TYPE == 1 ? 2944 : 4864), VC = TYPE == 0 ? 1536 : (TYPE == 1 ? 3584 : 5504);
    constexpr int HOFF = TYPE == 0 ? 0 : (TYPE == 1 ? 6 : 11);
    const int q0 = qb * 256, qlo = q0 + wid * 32, NT = 4 * (qb + 1);
    const bf16_t* Qp = proj + (size_t)(b * SEQ + qlo + r32) * LD + QC + hl * HD;
    const bf16_t* Kp = proj + (size_t)(b * SEQ) * LD + KC + hl * HD;
    const bf16_t* Vp = proj + (size_t)(b * SEQ) * LD + VC + hl * HD;
    LAS char* V_lds = lds; LAS char* K_lds = lds + 2 * SHM_V;
    LAS float* wsf = (LAS float*)(lds + AT_WS) + wid * 64;
    LAS float* tab = (LAS float*)(lds + AT_TAB);
    const float NEGINF = -__builtin_inff();

    if (TYPE == 0) {
        const float slope2 = exp2f(-8.0f * (float)(hl + 1) / 6.0f) * LOG2E;
        for (int i = tid; i < 2304; i += NTHR) { const int d = i - 256; float v = NEGINF;
            if (d >= 0) { const int m = (d <= 128 ? 1 : 0) + (((d & 3) == 0 && d <= 512) ? 1 : 0) + ((d & 15) == 0 ? 1 : 0);
                if (m > 0) v = -slope2 * (float)d + (m == 1 ? 0.f : (m == 2 ? 1.0f : 1.5849625007211562f)); }
            tab[i] = v; }
    }
    if (TYPE == 2) {
        const float bf = bf_l[hl]; const int t0 = tid * 4; float lf[4];
#pragma unroll
        for (int j = 0; j < 4; ++j) { const float x = fcbuf[(size_t)(b * SEQ + t0 + j) * 8 + hl] + bf; lf[j] = (fminf(x, 0.f) - log1pf(expf(-fabsf(x)))) * LOG2E; }
        lf[1] += lf[0]; lf[2] += lf[1]; lf[3] += lf[2];
        const float tot = lf[3]; float incl = tot;
#pragma unroll
        for (int o = 1; o < 64; o <<= 1) { const float t = __shfl_up(incl, o); if (lane >= o) incl += t; }
        LAS float* wsum = (LAS float*)(lds + AT_WS);
        if (lane == 63) wsum[wid] = incl;
        __syncthreads();
        float pre = 0.f;
        for (int w = 0; w < wid; ++w) pre += wsum[w];
        const float ex = incl - tot + pre;
#pragma unroll
        for (int j = 0; j < 4; ++j) tab[t0 + j] = ex + lf[j];
    }
    bf16x8 qr[8];
#pragma unroll
    for (int d0 = 0; d0 < 8; ++d0) qr[d0] = *(const bf16x8*)(Qp + d0 * 16 + hi * 8);
    const int sr = tid >> 4, sc = (tid & 15) * 8;
    const int kws = KSWZ(sr, sc * 2), vst0 = v_st(sr, sc), vst1 = v_st(32 + sr, sc);
#define TILE_KB(it_) ((TYPE == 1 ? NT - 1 - (it_) : (it_)) * 64)
    bf16x8 st_k0, st_k1, st_v0, st_v1;
#define SLOAD(kb_) do { st_k0 = *(const bf16x8*)(Kp + (size_t)((kb_) + sr) * LD + sc); st_k1 = *(const bf16x8*)(Kp + (size_t)((kb_) + 32 + sr) * LD + sc); \
                        st_v0 = *(const bf16x8*)(Vp + (size_t)((kb_) + sr) * LD + sc); st_v1 = *(const bf16x8*)(Vp + (size_t)((kb_) + 32 + sr) * LD + sc); } while (0)
#define SWRITE(bf_) do { *(LAS bf16x8*)(K_lds + (bf_) * SHM_K + kws) = st_k0; *(LAS bf16x8*)(K_lds + (bf_) * SHM_K + kws + 32 * 256) = st_k1; \
                         *(LAS bf16x8*)(V_lds + (bf_) * SHM_V + vst0) = st_v0; *(LAS bf16x8*)(V_lds + (bf_) * SHM_V + vst1) = st_v1; } while (0)
    SLOAD(TILE_KB(0)); SWRITE(0);
    __syncthreads();
    const int vbase = (int)(unsigned)(uintptr_t)V_lds + v_rd_base(lane);
    float m_reg = -1e30f, l_reg = 0.f, Rc = 0.f;
    float cq2 = 0.f; if (TYPE == 2) cq2 = tab[qlo + r32];
    f32x16 o[4] = {};
    for (int it = 0; it < NT; ++it) {
        const int cur = it & 1, kbase = TILE_KB(it);
        if (it + 1 < NT) { const int kb2 = TILE_KB(it + 1); SLOAD(kb2); }
        const bool act = (TYPE == 1) ? (kbase <= qlo + 30) : (kbase <= qlo + 31);
        if (act) {
            f32x16 p0, p1;
            qkt(p0, p1, K_lds + cur * SHM_K, r32, hi, qr);
            const int dq = qlo + r32 - 4 * hi - kbase;
            bf16x8 pa0, pa1, pa2, pa3;
            if (TYPE != 1) {
                if (TYPE == 0) {
                    const LAS float* tb = tab + (dq + 256 - 63);
#pragma unroll
                    for (int r = 0; r < 16; ++r) { const int c = (r & 3) + 8 * (r >> 2); p0[r] = fmaf(p0[r], C2, tb[63 - c]); p1[r] = fmaf(p1[r], C2, tb[31 - c]); }
                } else {
#pragma unroll
                    for (int g = 0; g < 4; ++g) { const f32x4 ck0 = *(const LAS f32x4*)(tab + kbase + 8 * g + 4 * hi), ck1 = *(const LAS f32x4*)(tab + kbase + 32 + 8 * g + 4 * hi);
#pragma unroll
                        for (int j = 0; j < 4; ++j) { p0[4 * g + j] = fmaf(p0[4 * g + j], C2, cq2 - ck0[j]); p1[4 * g + j] = fmaf(p1[4 * g + j], C2, cq2 - ck1[j]); } }
                    if (kbase + 63 > qlo) {
#pragma unroll
                        for (int r = 0; r < 16; ++r) { const int c = (r & 3) + 8 * (r >> 2); if (dq - c < 0) p0[r] = NEGINF; if (dq - c - 32 < 0) p1[r] = NEGINF; }
                    }
                }
                float pmax = p0[0];
#pragma unroll
                for (int r = 1; r < 16; ++r) pmax = fmaxf(pmax, p0[r]);
#pragma unroll
                for (int r = 0; r < 16; ++r) pmax = fmaxf(pmax, p1[r]);
                pmax = pl32_max(pmax);
                float mn, alpha;
                if (__all((pmax - m_reg) <= 11.5f)) { mn = m_reg; alpha = 1.f; }
                else { mn = fmaxf(m_reg, pmax); alpha = __builtin_amdgcn_exp2f(m_reg - mn); m_reg = mn; }
                float ps = 0.f;
#pragma unroll
                for (int r = 0; r < 16; ++r) { p0[r] = __builtin_amdgcn_exp2f(p0[r] - mn); p1[r] = __builtin_amdgcn_exp2f(p1[r] - mn); ps += p0[r] + p1[r]; }
                ps = pl32_sum(ps);
                l_reg = l_reg * alpha + ps;
                if (__any(alpha < 1.f)) {
                    if (hi == 0) wsf[32 + r32] = alpha;
                    asm volatile("s_waitcnt lgkmcnt(0)" ::: "memory");
#pragma unroll
                    for (int r = 0; r < 16; ++r) { const float a = wsf[32 + crow(r, hi)];
#pragma unroll
                        for (int d_ = 0; d_ < 4; ++d_) o[d_][r] *= a; }
                }
            } else {
                f32x16 l0, l1;
                const bool diag = (kbase + 63 >= qlo);
#pragma unroll
                for (int r = 0; r < 16; ++r) { const int c = (r & 3) + 8 * (r >> 2);
                    const float z0 = p0[r] * C2, z1 = p1[r] * C2;
                    float a0 = -(fmaxf(z0, 0.f) + __builtin_amdgcn_logf(1.0f + __builtin_amdgcn_exp2f(-fabsf(z0))));
                    float a1 = -(fmaxf(z1, 0.f) + __builtin_amdgcn_logf(1.0f + __builtin_amdgcn_exp2f(-fabsf(z1))));
                    if (diag) { if (dq - c <= 0) a0 = 0.f; if (dq - c - 32 <= 0) a1 = 0.f; }
                    p0[r] = z0; p1[r] = z1; l0[r] = a0; l1[r] = a1; }
                float cs[2][4], pc[2][4];
#pragma unroll
                for (int g = 0; g < 4; ++g) { cs[0][g] = (l0[4 * g] + l0[4 * g + 1]) + (l0[4 * g + 2] + l0[4 * g + 3]); cs[1][g] = (l1[4 * g] + l1[4 * g + 1]) + (l1[4 * g + 2] + l1[4 * g + 3]); }
#pragma unroll
                for (int g = 0; g < 4; ++g) { pc[0][g] = pl32_other(cs[0][g], hi); pc[1][g] = pl32_other(cs[1][g], hi); }
                float run = Rc;
#pragma unroll
                for (int p = 1; p >= 0; --p)
#pragma unroll
                    for (int g = 3; g >= 0; --g) {
                        float acc = run + (hi == 0 ? pc[p][g] : 0.f);
                        run += cs[p][g] + pc[p][g];
#pragma unroll
                        for (int j = 3; j >= 0; --j) { if (p == 0) { acc += l0[4 * g + j]; l0[4 * g + j] = acc; } else { acc += l1[4 * g + j]; l1[4 * g + j] = acc; } }
                    }
                Rc = run;
#pragma unroll
                for (int r = 0; r < 16; ++r) { const int c = (r & 3) + 8 * (r >> 2);
                    float a0 = __builtin_amdgcn_exp2f(p0[r] + l0[r]), a1 = __builtin_amdgcn_exp2f(p1[r] + l1[r]);
                    if (diag) { if (dq - c <= 0) a0 = 0.f; if (dq - c - 32 <= 0) a1 = 0.f; }
                    p0[r] = a0; p1[r] = a1; }
            }
            PK4(p0, 0, pa0); PK4(p0, 8, pa1); PK4(p1, 0, pa2); PK4(p1, 8, pa3);
            pv_tile(o, vbase + cur * SHM_V, pa0, pa1, pa2, pa3);
        }
        if (it + 1 < NT) { SWRITE(cur ^ 1); }
        __syncthreads();
    }
    float rli[16];
    if (TYPE != 1) {
        if (hi == 0) wsf[r32] = l_reg;
        asm volatile("s_waitcnt lgkmcnt(0)" ::: "memory");
#pragma unroll
        for (int r = 0; r < 16; ++r) rli[r] = 1.0f / wsf[crow(r, hi)];
    } else {
#pragma unroll
        for (int r = 0; r < 16; ++r) rli[r] = 1.0f;
    }
    float gh[4];
#pragma unroll
    for (int d0 = 0; d0 < 4; ++d0) gh[d0] = ghead_l[(HOFF + hl) * HD + d0 * 32 + r32];
    bf16_t* Ow = obuf + (size_t)(b * SEQ + qlo) * DM + (HOFF + hl) * HD;
#pragma unroll
    for (int r = 0; r < 16; ++r) {
        float v[4], ss = 0.f;
#pragma unroll
        for (int d0 = 0; d0 < 4; ++d0) { v[d0] = o[d0][r] * rli[r]; ss += v[d0] * v[d0]; }
        ss += __shfl_xor(ss, 1); ss += __shfl_xor(ss, 2); ss += __shfl_xor(ss, 4); ss += __shfl_xor(ss, 8); ss += __shfl_xor(ss, 16);
        const float scl = 1.0f / sqrtf(ss * (1.0f / HD) + EPS);
        const int orow = crow(r, hi);
#pragma unroll
        for (int d0 = 0; d0 < 4; ++d0) { const float y = v[d0] * scl * gh[d0]; const float yn = __shfl_xor(y, 1);
            if ((r32 & 1) == 0) *(unsigned*)(Ow + (size_t)orow * DM + d0 * 32 + r32) = cvtpk(y, yn); }
    }
    __syncthreads();
#undef TILE_KB
#undef SLOAD
#undef SWRITE
}

__device__ __forceinline__ void attn_phase(const bf16_t* proj, bf16_t* obuf, const float* fcbuf, const float* bf_l, const float* ghead_l, unsigned* ctr, LAS char* lds) {
    LAS int* item_s = (LAS int*)(lds + AT_ITEM);
    for (;;) {
        if (threadIdx.x == 0) *item_s = (int)atomicAdd(ctr, 1u);
        __syncthreads();
        const int i = *item_s;
        __syncthreads();
        if (i >= 1024) break;
        const int qb = 7 - (i >> 7), bh = i & 127, hh = bh & 15, b = bh >> 4;
#ifndef NO_A
        if (hh < 6) attn_item<0>(proj, obuf, fcbuf, bf_l, ghead_l, b, hh, qb, lds);
#endif
#ifndef NO_B
        if (hh >= 6 && hh < 11) attn_item<1>(proj, obuf, fcbuf, bf_l, ghead_l, b, hh - 6, qb, lds);
#endif
#ifndef NO_C
        if (hh >= 11) attn_item<2>(proj, obuf, fcbuf, bf_l, ghead_l, b, hh - 11, qb, lds);
#endif
    }
}

__global__ void __launch_bounds__(NTHR) fwd(Params p) {
    extern __shared__ __attribute__((aligned(16))) unsigned char lds_raw[];
    LAS unsigned char* lds = (LAS unsigned char*)lds_raw;
    cg::grid_group grid = cg::this_grid();
    unsigned char* ws = p.ws;
    bf16_t* WinT = (bf16_t*)(ws + WS_WIN); bf16_t* WoT = (bf16_t*)(ws + WS_WO); bf16_t* WguT = (bf16_t*)(ws + WS_WGU); bf16_t* WdT = (bf16_t*)(ws + WS_WD);
    bf16_t* abuf = (bf16_t*)(ws + WS_ABUF); bf16_t* gu = (bf16_t*)(ws + WS_GU); bf16_t* proj = gu; bf16_t* hbuf = (bf16_t*)(ws + WS_H);
    float* fcbuf = (float*)(ws + WS_FC); unsigned* ctr = (unsigned*)(ws + WS_CTR);
    int ph = 0;
#define PH_BEGIN if (ph >= p.ph_lo && ph < p.ph_hi) { if (ph > p.ph_lo) grid.sync();
#define PH_END } ++ph;
    for (int l = 0; l < 2; ++l) {
        const float* xin = (l == 0) ? p.x : p.out;
        PH_BEGIN
            if (l == 0 && blockIdx.x == 0 && threadIdx.x < 64) ctr[threadIdx.x] = 0u;
            int gofs = 0;
            conv_matrix(p.w_in + (size_t)l * DM * NIN, NIN, DM, NQKV, WinT, (LAS float*)lds, gofs);
            conv_matrix(p.w_o + (size_t)l * DM * DM, DM, DM, DM, WoT, (LAS float*)lds, gofs);
            conv_matrix(p.w_gu + (size_t)l * DM * NGU, NGU, DM, NGU, WguT, (LAS float*)lds, gofs);
            conv_matrix(p.w_down + (size_t)l * DFF * DM, DM, DFF, DM, WdT, (LAS float*)lds, gofs);
            norm_phase<true, false>(xin, p.g_mix + l * DM, abuf, nullptr, p.w_in + (size_t)l * DM * NIN, fcbuf, (LAS float*)lds);
        PH_END
        PH_BEGIN
            pg8::Gemm g{abuf, WinT, MTOK, NQKV, DM}; pg8::StaticOrder S; S.init(MTOK, NQKV, gridDim.x, blockIdx.x);
            pg8::EpiBf16<0> E{proj, NQKV, nullptr, 0, 0};
#ifndef NO_GB
            pg8::gemm_phase<pg8::EpiBf16<0>, pg8::StaticOrder>(lds, g, S, E, nullptr);
#endif
        PH_END
        PH_BEGIN
            attn_phase(proj, abuf, fcbuf, p.b_f + l * 5, p.g_head + l * DM, ctr + l * 16, (LAS char*)lds);
        PH_END
        PH_BEGIN
            pg8::Gemm g{abuf, WoT, MTOK, DM, DM}; pg8::StaticOrder S; S.init(MTOK, DM, gridDim.x, blockIdx.x);
            pg8::EpiRes E{xin, p.out, DM};
#ifndef NO_GR
            pg8::gemm_phase<pg8::EpiRes, pg8::StaticOrder>(lds, g, S, E, nullptr);
#endif
        PH_END
        PH_BEGIN
            norm_phase<false, false>(p.out, p.g_ffn + l * DM, abuf, nullptr, nullptr, nullptr, (LAS float*)lds);
        PH_END
        PH_BEGIN
            pg8::Gemm g{abuf, WguT, MTOK, NGU, DM}; pg8::StaticOrder S; S.init(MTOK, NGU, gridDim.x, blockIdx.x);
            pg8::EpiBf16<0> E{gu, NGU, nullptr, 0, 0};
#ifndef NO_GB
            pg8::gemm_phase<pg8::EpiBf16<0>, pg8::StaticOrder>(lds, g, S, E, nullptr);
#endif
        PH_END
        PH_BEGIN
#ifndef NO_CA
            convact_phase(gu, hbuf, p.conv_w + (size_t)l * 3 * NGU, p.conv_b + (size_t)l * NGU);
#endif
        PH_END
        PH_BEGIN
            pg8::Gemm g{hbuf, WdT, MTOK, DM, DFF}; pg8::StaticOrder S; S.init(MTOK, DM, gridDim.x, blockIdx.x);
            pg8::EpiRes E{p.out, p.out, DM};
#ifndef NO_GR
            pg8::gemm_phase<pg8::EpiRes, pg8::StaticOrder>(lds, g, S, E, nullptr);
#endif
        PH_END
    }
    PH_BEGIN
        norm_phase<false, true>(p.out, p.g_final, nullptr, p.out, nullptr, nullptr, (LAS float*)lds);
    PH_END
#undef PH_BEGIN
#undef PH_END
}
}

extern "C" void kernel_launch(void* const* d_in, const int* in_sizes, int n_in, void* d_out, int out_size, void* d_ws, size_t ws_size, hipStream_t stream) {
    static int grid_blocks = 0;
    if (!grid_blocks) {
        if (n_in != 12 || ws_size < mk::WS_END) { fprintf(stderr, "kernel_launch: unexpected n_in %d or ws_size %zu (< %zu)\n", n_in, ws_size, (size_t)mk::WS_END); grid_blocks = -1; return; }
        int dev = 0, cus = 0, per_cu = 0;
        (void)hipGetDevice(&dev);
        if (hipDeviceGetAttribute(&cus, hipDeviceAttributeMultiprocessorCount, dev) != hipSuccess || cus <= 0) cus = 256;
        if (hipFuncSetAttribute((const void*)mk::fwd, hipFuncAttributeMaxDynamicSharedMemorySize, mk::LDS_BYTES) != hipSuccess) fprintf(stderr, "kernel_launch: hipFuncSetAttribute failed\n");
        if (hipOccupancyMaxActiveBlocksPerMultiprocessor(&per_cu, (const void*)mk::fwd, mk::NTHR, mk::LDS_BYTES) != hipSuccess || per_cu < 1) { per_cu = 1; (void)hipGetLastError(); }
        grid_blocks = cus * per_cu;
    }
    if (grid_blocks < 0) return;
    mk::Params p{};
    p.x = (const float*)d_in[0]; p.g_mix = (const float*)d_in[1]; p.w_in = (const float*)d_in[2]; p.b_f = (const float*)d_in[3]; p.g_head = (const float*)d_in[4];
    p.w_o = (const float*)d_in[5]; p.g_ffn = (const float*)d_in[6]; p.w_gu = (const float*)d_in[7]; p.conv_w = (const float*)d_in[8]; p.conv_b = (const float*)d_in[9];
    p.w_down = (const float*)d_in[10]; p.g_final = (const float*)d_in[11];
    p.out = (float*)d_out; p.ws = (unsigned char*)d_ws; p.ph_lo = 0; p.ph_hi = 1000;
    void* args[] = {&p};
    hipError_t e = hipLaunchCooperativeKernel((void*)mk::fwd, dim3(grid_blocks), dim3(mk::NTHR), args, mk::LDS_BYTES, stream);
    if (e != hipSuccess) fprintf(stderr, "cooperative launch failed: %s (grid %d)\n", hipGetErrorString(e), grid_blocks);
}
```

```cpp
#include <hip/hip_runtime.h>
#include <hip/hip_cooperative_groups.h>
#include <cstdio>
#include <cstdint>
namespace cg = cooperative_groups;
namespace pg8 {
#define PG8_LAS __attribute__((address_space(3)))
typedef unsigned short bf16_t;
typedef short bf16x8 __attribute__((ext_vector_type(8)));
typedef float f32x4 __attribute__((ext_vector_type(4)));
typedef unsigned u32x4 __attribute__((ext_vector_type(4)));
constexpr int BM = 256, BK = 64, HALF = 128, HTB = HALF * BK * 2  , STAGE_BYTES = 8 * HTB, NXCD = 8, WGM = 8;

__host__ __device__ __forceinline__ int lds_byte(int r, int c) { const int st = (r >> 4) * 2 + (c >> 5), rr = r & 15, cc = c & 31, ob = rr * 64 + cc * 2; return st * 1024 + (ob ^ (((ob >> 9) & 1) << 5)); }
__host__ __device__ __forceinline__ void stage_rc(int b, int& R, int& C) { const int st = b / 1024, sb = b % 1024, swz = sb ^ (((sb >> 9) & 1) << 5); R = (st >> 1) * 16 + swz / 64; C = (st & 1) * 32 + (swz % 64) / 2; }
__host__ __device__ __forceinline__ int perm32(int rho) { const int n = rho >> 4, i = rho & 15; return 8 * (i >> 2) + 4 * n + (i & 3); }

struct Unit { int pm, pn; };
struct Gemm { const bf16_t* A; const bf16_t* Bt; int M, N, K; };

struct StaticOrder {
    int nM, nN, nwg, G, c;
    __host__ __device__ void init(int M, int N, int G_, int c_) { nM = M / BM; nN = N / BM; nwg = nM * nN; G = G_; c = c_; }
    __host__ __device__ __forceinline__ bool next(int i, Unit& u) const {
        const long L = (long)i * G + c; if (L >= nwg) return false;
        int wgid = (int)L; { const int q = nwg / NXCD, r = nwg % NXCD, xcd = wgid % NXCD, off = wgid / NXCD; wgid = (xcd < r ? xcd * (q + 1) : r * (q + 1) + (xcd - r) * q) + off; }
        const int nig = WGM * nN, gid = wgid / nig, fm = gid * WGM, gsz = (nM - fm) < WGM ? (nM - fm) : WGM;
        u.pm = fm + ((wgid % nig) % gsz); u.pn = (wgid % nig) / gsz; return true;
    }
    __device__ __forceinline__ void a_ready(const Unit&) const {}
    __device__ __forceinline__ void done(const Unit&) const {}
};
struct CountedOrder : StaticOrder {
    const unsigned* ready; unsigned need; unsigned* tmo;
    __device__ __forceinline__ void a_ready(const Unit& u) const {
        if (threadIdx.x < 64) {
            const unsigned long long t0 = __builtin_amdgcn_s_memrealtime(); unsigned polls = 0;
            while ((unsigned)__builtin_amdgcn_readfirstlane(__hip_atomic_load(ready + 64 * u.pm, __ATOMIC_RELAXED, __HIP_MEMORY_SCOPE_AGENT)) < need) {
                if ((++polls & 255u) == 0u && __builtin_amdgcn_readfirstlane(__hip_atomic_load(tmo, __ATOMIC_RELAXED, __HIP_MEMORY_SCOPE_AGENT)) != 0u) break;
                if (__builtin_amdgcn_s_memrealtime() - t0 > 2000000ull) {
                    if (threadIdx.x == 0) { unsigned expect = 0u; __hip_atomic_compare_exchange_strong(tmo + 1, &expect, 0x600u | (unsigned)(u.pm & 0xff), __ATOMIC_RELAXED, __ATOMIC_RELAXED, __HIP_MEMORY_SCOPE_AGENT); __hip_atomic_store(tmo, 1u, __ATOMIC_RELAXED, __HIP_MEMORY_SCOPE_AGENT); }
                    break; }
                __builtin_amdgcn_s_sleep(2); }
            __builtin_amdgcn_fence(__ATOMIC_ACQUIRE, "agent");
            asm volatile("s_waitcnt vmcnt(0)" ::: "memory");
        }
#if !defined(BROKEN_HOOK_NO_BARRIER)
        asm volatile("" ::: "memory"); __builtin_amdgcn_s_barrier(); asm volatile("" ::: "memory");
#endif
    }
};

__device__ __forceinline__ unsigned cvt_pk_bf16(float lo, float hi) { unsigned r; asm volatile("v_cvt_pk_bf16_f32 %0, %1, %2" : "=v"(r) : "v"(lo), "v"(hi)); return r; }
typedef float f32x2 __attribute__((ext_vector_type(2)));
__device__ __forceinline__ f32x2 gelu_pk(f32x2 v) {
    const f32x2 av = __builtin_elementwise_abs(v), d = av * 0.2316418882f + 1.0f;
    f32x2 t; t.x = __builtin_amdgcn_rcpf(d.x); t.y = __builtin_amdgcn_rcpf(d.y);
    f32x2 q = t * 0.5307027145f + (-0.7265760135f); q = q * t + 0.7107068705f; q = q * t + (-0.142248368f); q = q * t + 0.127414796f; q = q * t;
    const f32x2 s = (v * v) * (-0.72134752044f);
    f32x2 e; e.x = __builtin_amdgcn_exp2f(s.x); e.y = __builtin_amdgcn_exp2f(s.y);
    const f32x2 m = v * (q * e), r = v - m;
    f32x2 o; o.x = v.x < 0.f ? m.x : r.x; o.y = v.y < 0.f ? m.y : r.y; return o;
}

struct EpiF32 {
    static constexpr bool PERM = false, AFTER_DRAIN = false;
    float* C; int ldc; const float* bias;
    __device__ __forceinline__ void operator()(const f32x4 (&acc)[2][2][4][2], const Unit& u, int wr, int wc, int fr, int fq) const {
        const int row0 = u.pm * BM + wr * 64 + fr, col0 = u.pn * BM + wc * 32 + 4 * fq;
        f32x4 bv[2][2];
#pragma unroll
        for (int bj = 0; bj < 2; ++bj)
#pragma unroll
            for (int n = 0; n < 2; ++n) bv[bj][n] = bias ? *(const f32x4*)(bias + col0 + bj * HALF + n * 16) : (f32x4){0.f, 0.f, 0.f, 0.f};
#pragma unroll
        for (int ai = 0; ai < 2; ++ai)
#pragma unroll
            for (int m = 0; m < 4; ++m) { float* rowp = C + (size_t)(row0 + ai * HALF + m * 16) * ldc + col0;
#pragma unroll
                for (int bj = 0; bj < 2; ++bj)
#pragma unroll
                    for (int n = 0; n < 2; ++n) *(f32x4*)(rowp + bj * HALF + n * 16) = acc[ai][bj][m][n] + bv[bj][n]; }
    }
};
template <int ACT  > struct EpiBf16 {
    static constexpr bool PERM = true, AFTER_DRAIN = false;
    bf16_t* O; int ldc; const float* bias; int split_cols; size_t split_stride;
    __device__ __forceinline__ void operator()(const f32x4 (&acc)[2][2][4][2], const Unit& u, int wr, int wc, int fr, int fq) const {
        const int row0 = u.pm * BM + wr * 64 + fr; int colt = u.pn * BM; bf16_t* base = O;
        if (split_cols) { const int t = colt / split_cols; base += (size_t)t * split_stride; colt -= t * split_cols; }
        const int col0 = colt + wc * 32 + 8 * fq, bcol0 = u.pn * BM + wc * 32 + 8 * fq;
        f32x4 bv[2][2];
#pragma unroll
        for (int bj = 0; bj < 2; ++bj)
#pragma unroll
            for (int n = 0; n < 2; ++n) bv[bj][n] = bias ? *(const f32x4*)(bias + bcol0 + bj * HALF + 4 * n) : (f32x4){0.f, 0.f, 0.f, 0.f};
#pragma unroll
        for (int ai = 0; ai < 2; ++ai)
#pragma unroll
            for (int m = 0; m < 4; ++m) { bf16_t* rowp = base + (size_t)(row0 + ai * HALF + m * 16) * ldc + col0;
#pragma unroll
                for (int bj = 0; bj < 2; ++bj) { f32x4 v0 = acc[ai][bj][m][0] + bv[bj][0], v1 = acc[ai][bj][m][1] + bv[bj][1];
                    if (ACT == 1) { f32x2 a = gelu_pk((f32x2){v0[0], v0[1]}), b = gelu_pk((f32x2){v0[2], v0[3]}), c = gelu_pk((f32x2){v1[0], v1[1]}), d = gelu_pk((f32x2){v1[2], v1[3]});
                        v0 = (f32x4){a.x, a.y, b.x, b.y}; v1 = (f32x4){c.x, c.y, d.x, d.y}; }
                    if (ACT == 2) {
#pragma unroll
                        for (int j = 0; j < 4; ++j) { v0[j] = 0.5f * v0[j] * (1.0f + erff(v0[j] * 0.70710678f)); v1[j] = 0.5f * v1[j] * (1.0f + erff(v1[j] * 0.70710678f)); } }
                    u32x4 w; w.x = cvt_pk_bf16(v0[0], v0[1]); w.y = cvt_pk_bf16(v0[2], v0[3]); w.z = cvt_pk_bf16(v1[0], v1[1]); w.w = cvt_pk_bf16(v1[2], v1[3]);
                    *(u32x4*)(rowp + bj * HALF) = w; } }
    }
};
struct EpiRes {
    static constexpr bool PERM = false, AFTER_DRAIN = false;
    const float* base; float* out; int ldc;
    __device__ __forceinline__ void operator()(const f32x4 (&acc)[2][2][4][2], const Unit& u, int wr, int wc, int fr, int fq) const {
        const int row0 = u.pm * BM + wr * 64 + fr, col0 = u.pn * BM + wc * 32 + 4 * fq;
#pragma unroll
        for (int ai = 0; ai < 2; ++ai) {
            f32x4 bv[4][2][2];
#pragma unroll
            for (int m = 0; m < 4; ++m) { const size_t off = (size_t)(row0 + ai * HALF + m * 16) * ldc + col0;
#pragma unroll
                for (int bj = 0; bj < 2; ++bj)
#pragma unroll
                    for (int n = 0; n < 2; ++n) bv[m][bj][n] = *(const f32x4*)(base + off + bj * HALF + n * 16); }
            asm volatile("" ::: "memory");
#pragma unroll
            for (int m = 0; m < 4; ++m) { const size_t off = (size_t)(row0 + ai * HALF + m * 16) * ldc + col0;
#pragma unroll
                for (int bj = 0; bj < 2; ++bj)
#pragma unroll
                    for (int n = 0; n < 2; ++n) *(f32x4*)(out + off + bj * HALF + n * 16) = acc[ai][bj][m][n] + bv[m][bj][n]; }
            asm volatile("" ::: "memory");
        }
    }
};
struct EpiResN {
    static constexpr bool PERM = true, AFTER_DRAIN = false;
    const float* base; float* out; bf16_t* xb; float* rowss; int ldc;
    __device__ __forceinline__ void operator()(const f32x4 (&acc)[2][2][4][2], const Unit& u, int wr, int wc, int fr, int fq) const {
        const int row0 = u.pm * BM + wr * 64 + fr, col0 = u.pn * BM + wc * 32 + 8 * fq;
#pragma unroll
        for (int ai = 0; ai < 2; ++ai)
#pragma unroll
          for (int mh = 0; mh < 2; ++mh) {
            f32x4 bv[2][2][2];
#pragma unroll
            for (int mm = 0; mm < 2; ++mm) { const size_t off = (size_t)(row0 + ai * HALF + (mh * 2 + mm) * 16) * ldc + col0;
#pragma unroll
                for (int bj = 0; bj < 2; ++bj)
#pragma unroll
                    for (int n = 0; n < 2; ++n) bv[mm][bj][n] = *(const f32x4*)(base + off + bj * HALF + n * 4); }
            asm volatile("" ::: "memory");
#pragma unroll
            for (int mm = 0; mm < 2; ++mm) { const int m = mh * 2 + mm; const int row = row0 + ai * HALF + m * 16; const size_t off = (size_t)row * ldc + col0; float ss = 0.f;
#pragma unroll
                for (int bj = 0; bj < 2; ++bj) {
                    const f32x4 v0 = acc[ai][bj][m][0] + bv[mm][bj][0], v1 = acc[ai][bj][m][1] + bv[mm][bj][1];
                    *(f32x4*)(out + off + bj * HALF) = v0; *(f32x4*)(out + off + bj * HALF + 4) = v1;
                    u32x4 w; w.x = cvt_pk_bf16(v0[0], v0[1]); w.y = cvt_pk_bf16(v0[2], v0[3]); w.z = cvt_pk_bf16(v1[0], v1[1]); w.w = cvt_pk_bf16(v1[2], v1[3]);
                    *(u32x4*)(xb + off + bj * HALF) = w;
                    { const f32x4 q4 = v0 * v0 + v1 * v1; ss += (q4[0] + q4[1]) + (q4[2] + q4[3]); } }
                ss += __shfl_xor(ss, 16); ss += __shfl_xor(ss, 32);
                if (fq == 0) atomicAdd(rowss + row, ss); }
            asm volatile("" ::: "memory");
          }
    }
};
struct EpiProj {
    static constexpr bool PERM = true, AFTER_DRAIN = false;
    bf16_t* O; int ldc; float* kn;
    __device__ __forceinline__ void operator()(const f32x4 (&acc)[2][2][4][2], const Unit& u, int wr, int wc, int fr, int fq) const {
        const int row0 = u.pm * BM + wr * 64 + fr, col0 = u.pn * BM + wc * 32 + 8 * fq;
        int slot0 = -1, slot1 = -1;
        if (u.pn >= 3 && u.pn <= 5) { slot0 = (u.pn - 3) * 2; slot1 = slot0 + 1; }
        else if (u.pn >= 19 && u.pn <= 21) { slot0 = 11 + (u.pn - 19) * 2; slot1 = slot0 + 1 <= 15 ? slot0 + 1 : -1; }
#pragma unroll
        for (int ai = 0; ai < 2; ++ai)
#pragma unroll
            for (int m = 0; m < 4; ++m) { const int row = row0 + ai * HALF + m * 16; bf16_t* rowp = O + (size_t)row * ldc + col0;
#pragma unroll
                for (int bj = 0; bj < 2; ++bj) { const f32x4 v0 = acc[ai][bj][m][0], v1 = acc[ai][bj][m][1];
                    u32x4 w; w.x = cvt_pk_bf16(v0[0], v0[1]); w.y = cvt_pk_bf16(v0[2], v0[3]); w.z = cvt_pk_bf16(v1[0], v1[1]); w.w = cvt_pk_bf16(v1[2], v1[3]);
                    *(u32x4*)(rowp + bj * HALF) = w;
                    const int slot = bj ? slot1 : slot0;
                    if (slot >= 0) { const f32x4 q4 = v0 * v0 + v1 * v1; float ss = (q4[0] + q4[1]) + (q4[2] + q4[3]);
                        ss += __shfl_xor(ss, 16); ss += __shfl_xor(ss, 32);
                        if (fq == 0) atomicAdd(kn + (size_t)row * 16 + slot, ss); } } }
    }
};
__device__ __forceinline__ float dpp_ror1(float x) { return __int_as_float(__builtin_amdgcn_update_dpp(__float_as_int(x), __float_as_int(x), 0x121, 0xf, 0xf, false)); }
__device__ __forceinline__ float dpp_ror2(float x) { return __int_as_float(__builtin_amdgcn_update_dpp(__float_as_int(x), __float_as_int(x), 0x122, 0xf, 0xf, false)); }
struct EpiConv {
    static constexpr bool PERM = true, AFTER_DRAIN = false;
    bf16_t* H; float* halo; const float* cw; const float* cb; int dff; const float* rowss; float inv_k, eps;
    __device__ __forceinline__ void operator()(const f32x4 (&acc)[2][2][4][2], const Unit& u, int wr, int wc, int fr, int fq) const {
        const int j0 = u.pn * 128 + wc * 32 + 8 * fq; const int ngu = 2 * dff;
#pragma unroll
        for (int ai = 0; ai < 2; ++ai) {
            const int chunk = u.pm * 4 + ai * 2 + wr; const int row0 = chunk * 64 + fr;
            float rs[4];
#pragma unroll
            for (int m = 0; m < 4; ++m) rs[m] = 1.0f / sqrtf(rowss[row0 + 16 * m] * inv_k + eps);
            if (fr < 2) { float* hp = halo + ((size_t)chunk * 4 + fr) * ngu + j0;
#pragma unroll
                for (int n = 0; n < 2; ++n) { *(f32x4*)(hp + 4 * n) = acc[ai][0][0][n] * rs[0]; *(f32x4*)(hp + dff + 4 * n) = acc[ai][1][0][n] * rs[0]; } }
            if (fr >= 14) { float* hp = halo + ((size_t)chunk * 4 + (fr - 12)) * ngu + j0;
#pragma unroll
                for (int n = 0; n < 2; ++n) { *(f32x4*)(hp + 4 * n) = acc[ai][0][3][n] * rs[3]; *(f32x4*)(hp + dff + 4 * n) = acc[ai][1][3][n] * rs[3]; } }
            u32x4 pk[4];
#pragma unroll
            for (int n = 0; n < 2; ++n) {
                const float* wp = cw + j0 + 4 * n;
                const f32x4 wg0 = *(const f32x4*)(wp), wg1 = *(const f32x4*)(wp + ngu), wg2 = *(const f32x4*)(wp + 2 * ngu);
                const f32x4 wu0 = *(const f32x4*)(wp + dff), wu1 = *(const f32x4*)(wp + ngu + dff), wu2 = *(const f32x4*)(wp + 2 * ngu + dff);
                const f32x4 bg = *(const f32x4*)(cb + j0 + 4 * n), bu = *(const f32x4*)(cb + dff + j0 + 4 * n);
#pragma unroll
                for (int m = 0; m < 4; ++m) {
                    const f32x4 cg = acc[ai][0][m][n] * rs[m], cu = acc[ai][1][m][n] * rs[m];
                    const f32x4 pg = m > 0 ? acc[ai][0][m - 1][n] * rs[m > 0 ? m - 1 : 0] : (f32x4){0.f, 0.f, 0.f, 0.f}, pu = m > 0 ? acc[ai][1][m - 1][n] * rs[m > 0 ? m - 1 : 0] : (f32x4){0.f, 0.f, 0.f, 0.f};
                    float hv[4];
#pragma unroll
                    for (int e = 0; e < 4; e += 2) {
                        const f32x2 g1 = {dpp_ror1(fr == 15 ? pg[e] : cg[e]), dpp_ror1(fr == 15 ? pg[e + 1] : cg[e + 1])}, g2 = {dpp_ror2(fr >= 14 ? pg[e] : cg[e]), dpp_ror2(fr >= 14 ? pg[e + 1] : cg[e + 1])};
                        const f32x2 u1 = {dpp_ror1(fr == 15 ? pu[e] : cu[e]), dpp_ror1(fr == 15 ? pu[e + 1] : cu[e + 1])}, u2 = {dpp_ror2(fr >= 14 ? pu[e] : cu[e]), dpp_ror2(fr >= 14 ? pu[e + 1] : cu[e + 1])};
                        const f32x2 c_g = {cg[e], cg[e + 1]}, c_u = {cu[e], cu[e + 1]};
                        const f32x2 G = (f32x2){bg[e], bg[e + 1]} + (f32x2){wg0[e], wg0[e + 1]} * g2 + (f32x2){wg1[e], wg1[e + 1]} * g1 + (f32x2){wg2[e], wg2[e + 1]} * c_g;
                        const f32x2 U = (f32x2){bu[e], bu[e + 1]} + (f32x2){wu0[e], wu0[e + 1]} * u2 + (f32x2){wu1[e], wu1[e + 1]} * u1 + (f32x2){wu2[e], wu2[e + 1]} * c_u;
                        const f32x2 t = G * (-1.4426950408889634f);
                        f32x2 d; d.x = __builtin_amdgcn_exp2f(t.x); d.y = __builtin_amdgcn_exp2f(t.y); d = d + 1.0f;
                        f32x2 r; r.x = __builtin_amdgcn_rcpf(d.x); r.y = __builtin_amdgcn_rcpf(d.y);
                        const f32x2 h2 = (G * r) * U;
                        hv[e] = h2.x; hv[e + 1] = h2.y;
                    }
                    if (n == 0) { pk[m].x = cvt_pk_bf16(hv[0], hv[1]); pk[m].y = cvt_pk_bf16(hv[2], hv[3]); }
                    else { pk[m].z = cvt_pk_bf16(hv[0], hv[1]); pk[m].w = cvt_pk_bf16(hv[2], hv[3]); }
                }
            }
#pragma unroll
            for (int m = 0; m < 4; ++m) if (m > 0 || fr >= 2) *(u32x4*)(H + (size_t)(row0 + 16 * m) * dff + j0) = pk[m];
        }
    }
};
template <class Epi, class Sched, bool STAMP = false>
__device__ __forceinline__ void gemm_phase(PG8_LAS unsigned char* lds, const Gemm g, const Sched& S, const Epi& E, unsigned long long* stamps) {
    int tid_l = threadIdx.x; asm volatile("" : "+v"(tid_l)); const int tid = tid_l, wid = __builtin_amdgcn_readfirstlane(tid >> 6), lane = tid & 63, wr = wid >> 2, wc = wid & 3, fr = lane & 15, fq = lane >> 4;
    const int K = g.K, nt = K / BK;
    int ts_lo = 0, ts_hi = 0, nts = 0; const unsigned long long rt_entry = STAMP ? (unsigned long long)wall_clock64() : 0ull;
#define PG8_STAMP() do { if (STAMP && wid == 0 && nts < 64) { const unsigned long long _c = (unsigned long long)clock64(); \
        ts_lo = (lane == nts) ? (int)(unsigned)_c : ts_lo; ts_hi = (lane == nts) ? (int)(unsigned)(_c >> 32) : ts_hi; ++nts; } } while (0)
    PG8_STAMP();
    unsigned voffA[2], voffB[2];
#pragma unroll
    for (int i = 0; i < 2; ++i) { int R, C; stage_rc(tid * 16 + i * 8192, R, C); const int Rb = Epi::PERM ? ((R & ~31) + perm32(R & 31)) : R;
        voffA[i] = (unsigned)(R * K + C) * 2u; voffB[i] = (unsigned)(Rb * K + C) * 2u; }
    const size_t kstep = (size_t)(BK * 2);
    const size_t hstep = (size_t)HALF * K * 2;
    const size_t tstep = 2 * hstep;
    const unsigned ldsw = (unsigned)wid * 1024u;
    const int aoff = lds_byte(wr * 64 + fr, fq * 8), boff = lds_byte(wc * 32 + fr, fq * 8);
#define PG8_SA(b, h) (((b) * 2 + (h)) * HTB)
#define PG8_SB(b, h) ((4 + (b) * 2 + (h)) * HTB)
#define PG8_STAGE(bufoff, gbase, voff) do { _Pragma("unroll") for (int _i = 0; _i < 2; ++_i) \
        __builtin_amdgcn_global_load_lds((const unsigned*)((const char*)(gbase) + (voff)[_i]), (PG8_LAS unsigned*)(lds + (bufoff) + ldsw + _i * 8192), 16, 0, 0); } while (0)
#define PG8_LDA(dst, b, h) do { _Pragma("unroll") for (int m = 0; m < 4; ++m) _Pragma("unroll") for (int k = 0; k < 2; ++k) dst[m][k] = *(const PG8_LAS bf16x8*)(lds + PG8_SA(b, h) + aoff + m * 2048 + k * 1024); } while (0)
#define PG8_LDB(dst, b, h) do { _Pragma("unroll") for (int n = 0; n < 2; ++n) _Pragma("unroll") for (int k = 0; k < 2; ++k) dst[n][k] = *(const PG8_LAS bf16x8*)(lds + PG8_SB(b, h) + boff + n * 2048 + k * 1024); } while (0)
#define PG8_MMA(ai, bj, At, Bt) do { __builtin_amdgcn_s_setprio(1); _Pragma("unroll") for (int m = 0; m < 4; ++m) _Pragma("unroll") for (int n = 0; n < 2; ++n) _Pragma("unroll") for (int k = 0; k < 2; ++k) \
        acc[ai][bj][m][n] = __builtin_amdgcn_mfma_f32_16x16x32_bf16(Bt[n][k], At[m][k], acc[ai][bj][m][n], 0, 0, 0); __builtin_amdgcn_s_setprio(0); } while (0)
#define PG8_WAIT_V(n) asm volatile("s_waitcnt vmcnt(" #n ")" ::: "memory")
#define PG8_WAIT_L(n) asm volatile("s_waitcnt lgkmcnt(" #n ")" ::: "memory")
#define PG8_BAR __builtin_amdgcn_s_barrier()
#define PG8_SCHED __builtin_amdgcn_sched_barrier(0)
    Unit cur, nxt; int ui = 0;
    if (!S.next(0, cur)) return;
    f32x4 acc[2][2][4][2];
#pragma unroll
    for (int a = 0; a < 2; ++a)
#pragma unroll
        for (int b = 0; b < 2; ++b)
#pragma unroll
            for (int m = 0; m < 4; ++m)
#pragma unroll
                for (int n = 0; n < 2; ++n) acc[a][b][m][n] = (f32x4){0.f, 0.f, 0.f, 0.f};
    bf16x8 At[4][2], B0[2][2], B1[2][2];
    const char* cA = (const char*)g.A + (size_t)cur.pm * tstep; const char* cB = (const char*)g.Bt + (size_t)cur.pn * tstep;
    S.a_ready(cur);
    PG8_STAGE(PG8_SB(0, 0), cB, voffB); PG8_STAGE(PG8_SA(0, 0), cA, voffA); PG8_STAGE(PG8_SB(0, 1), cB + hstep, voffB); PG8_STAGE(PG8_SA(0, 1), cA + hstep, voffA);
    if (wr == 1) PG8_BAR;
    PG8_WAIT_V(4); PG8_BAR;
    PG8_STAGE(PG8_SB(1, 0), cB + kstep, voffB); PG8_STAGE(PG8_SA(1, 0), cA + kstep, voffA); PG8_STAGE(PG8_SB(1, 1), cB + hstep + kstep, voffB);
    PG8_WAIT_V(6); PG8_BAR;
    PG8_STAMP();
    for (;;) {
        const bool has_next = S.next(ui + 1, nxt);
        const char* nA = has_next ? (const char*)g.A + (size_t)nxt.pm * tstep : cA; const char* nB = has_next ? (const char*)g.Bt + (size_t)nxt.pn * tstep : cB;
        for (int t = 0; t < nt; t += 2) {
            const bool last = (t == nt - 2);
            const char* a1 = cA + (size_t)(t + 1) * kstep;
            const char* a2 = last ? nA : cA + (size_t)(t + 2) * kstep; const char* b2 = last ? nB : cB + (size_t)(t + 2) * kstep;
            const char* a3 = a2 + kstep; const char* b3 = b2 + kstep;
            if (last && has_next) S.a_ready(nxt);
            PG8_LDB(B0, 0, 0); PG8_SCHED; PG8_LDA(At, 0, 0); PG8_STAGE(PG8_SA(1, 1), a1 + hstep, voffA);
            PG8_WAIT_L(8); PG8_BAR; PG8_WAIT_L(0); PG8_MMA(0, 0, At, B0); PG8_BAR; PG8_SCHED;
            PG8_LDB(B1, 0, 1); PG8_STAGE(PG8_SB(0, 0), b2, voffB);
            PG8_BAR; PG8_WAIT_L(0); PG8_MMA(0, 1, At, B1); PG8_BAR;
            PG8_LDA(At, 0, 1); PG8_STAGE(PG8_SA(0, 0), a2, voffA);
            PG8_BAR; PG8_WAIT_L(0); PG8_MMA(1, 0, At, B0); PG8_BAR; PG8_SCHED;
            PG8_STAGE(PG8_SB(0, 1), b2 + hstep, voffB);
            PG8_WAIT_V(6); PG8_BAR; PG8_MMA(1, 1, At, B1); PG8_BAR;
            PG8_LDB(B0, 1, 0); PG8_SCHED; PG8_LDA(At, 1, 0); PG8_STAGE(PG8_SA(0, 1), a2 + hstep, voffA);
            PG8_WAIT_L(8); PG8_BAR; PG8_WAIT_L(0); PG8_MMA(0, 0, At, B0); PG8_BAR; PG8_SCHED;
            PG8_LDB(B1, 1, 1); PG8_STAGE(PG8_SB(1, 0), b3, voffB);
            PG8_BAR; PG8_WAIT_L(0); PG8_MMA(0, 1, At, B1); PG8_BAR;
            PG8_LDA(At, 1, 1); PG8_STAGE(PG8_SA(1, 0), a3, voffA);
            PG8_BAR; PG8_WAIT_L(0); PG8_MMA(1, 0, At, B0); PG8_BAR; PG8_SCHED;
            PG8_STAGE(PG8_SB(1, 1), b3 + hstep, voffB);
            PG8_WAIT_V(6); PG8_BAR; PG8_MMA(1, 1, At, B1); PG8_BAR;
        }
        PG8_STAMP();
        if constexpr (!Epi::AFTER_DRAIN) { E(acc, cur, wr, wc, fr, fq); S.done(cur); }
        PG8_STAMP();
        if (!has_next) break;
#pragma unroll
        for (int a = 0; a < 2; ++a)
#pragma unroll
            for (int b = 0; b < 2; ++b)
#pragma unroll
                for (int m = 0; m < 4; ++m)
#pragma unroll
                    for (int n = 0; n < 2; ++n) acc[a][b][m][n] = (f32x4){0.f, 0.f, 0.f, 0.f};
        cur = nxt; cA = nA; cB = nB; ++ui;
    }
    PG8_WAIT_V(0);
    if (wr == 0) PG8_BAR;
    PG8_BAR;
    if constexpr (Epi::AFTER_DRAIN) { E.fused(acc, cur, wr, wc, fr, fq, lds, wid, lane); S.done(cur); }
    PG8_STAMP();
    if (STAMP && wid == 0) { stamps[lane] = lane < nts ? (((unsigned long long)(unsigned)ts_hi << 32) | (unsigned)ts_lo) : 0ull;
        if (lane == 62) stamps[62] = rt_entry; if (lane == 63) stamps[63] = (unsigned long long)wall_clock64(); }
#undef PG8_STAMP
#undef PG8_SA
#undef PG8_SB
#undef PG8_STAGE
#undef PG8_LDA
#undef PG8_LDB
#undef PG8_MMA
#undef PG8_WAIT_V
#undef PG8_WAIT_L
#undef PG8_BAR
#undef PG8_SCHED
}
}
#define XB_TMO      128
#define XB_XCNT(j)  (256  + 64 * (j))
#define XB_XSUB(j)  (1280 + 64 * (j))
#define XB_XGEN(j)  (2304 + 64 * (j))
#define XB_TOP      3328
#define XB_TOPGEN   3392
#define XCD_BAR_WORDS 3456
#define XB_SPIN_CAP (1u << 18)
#define LAS __attribute__((address_space(3)))

__device__ __forceinline__ unsigned xb_ld(unsigned* p)              { return __hip_atomic_load(p, __ATOMIC_RELAXED, __HIP_MEMORY_SCOPE_AGENT); }
__device__ __forceinline__ unsigned xb_add(unsigned* p, unsigned v) { return __hip_atomic_fetch_add(p, v, __ATOMIC_RELAXED, __HIP_MEMORY_SCOPE_AGENT); }
__device__ __forceinline__ unsigned xb_xcc_id() { return (unsigned)__builtin_amdgcn_s_getreg((3 << 11) | 20) & 0xFu; }
#define XB_SPIN(cond, bar) do { unsigned _sp = 0; while (cond) { __builtin_amdgcn_s_sleep(1); \
    if ((++_sp & 255u) == 0u) { if (xb_ld(&(bar)[XB_TMO])) break; if (_sp > XB_SPIN_CAP) { atomicAdd(&(bar)[XB_TMO], 1u); break; } } } } while (0)

struct XcdBarrier {
    unsigned* bar; unsigned x;
    volatile LAS unsigned* st;
};

__device__ __forceinline__ XcdBarrier xcd_barrier_post(unsigned* bar, volatile LAS unsigned* st) {
    XcdBarrier b; b.bar = bar; b.x = xb_xcc_id(); b.st = st;
    if (threadIdx.x == 0) (void)xb_add(&bar[XB_XCNT(b.x)], 1u);
    return b;
}
__device__ __forceinline__ void xcd_barrier_complete(unsigned* bar, unsigned x, unsigned& nloc, unsigned& nx) {
    const unsigned G = gridDim.x * gridDim.y * gridDim.z;
    unsigned sum, cnt, mine, sp = 0u;
    for (;;) {
        sum = 0u; cnt = 0u; mine = 0u;
#pragma unroll
        for (unsigned j = 0; j < 16; ++j) { const unsigned c = xb_ld(&bar[XB_XCNT(j)]); sum += c; cnt += (c > 0u) ? 1u : 0u; mine = (j == x) ? c : mine; }
        if (sum == G) break;
        __builtin_amdgcn_s_sleep(1);
        if ((++sp & 255u) == 0u) { if (xb_ld(&bar[XB_TMO])) break; if (sp > XB_SPIN_CAP) { atomicAdd(&bar[XB_TMO], 1u); break; } }
    }
    nloc = mine > 0u ? mine : 1u; nx = cnt > 0u ? cnt : 1u;
}

__device__ __forceinline__ void xcd_barrier(const XcdBarrier& b) {
    asm volatile("s_waitcnt vmcnt(0)" ::: "memory");
    __syncthreads();
    if (threadIdx.x == 0) {
        unsigned* bar = b.bar;
        __builtin_amdgcn_s_waitcnt(0);
        unsigned nloc = b.st[0], nx = b.st[1];
        if (nloc == 0u) { xcd_barrier_complete(bar, b.x, nloc, nx); b.st[0] = nloc; b.st[1] = nx; }
        const unsigned old = xb_add(&bar[XB_XSUB(b.x)], 1u);
        const unsigned gen = old / nloc;
        if (old + 1u == (gen + 1u) * nloc) {
            __builtin_amdgcn_fence(__ATOMIC_RELEASE, "agent");
            asm volatile("s_waitcnt vmcnt(0)" ::: "memory");
            const unsigned og = xb_add(&bar[XB_TOP], 1u);
            const unsigned tg = og / nx;
            if (og + 1u == (tg + 1u) * nx) xb_add(&bar[XB_TOPGEN], 1u);
            else XB_SPIN(xb_ld(&bar[XB_TOPGEN]) == tg, bar);
            __builtin_amdgcn_fence(__ATOMIC_ACQUIRE, "agent");
            xb_add(&bar[XB_XGEN(b.x)], 1u);
            asm volatile("s_waitcnt vmcnt(0)" ::: "memory");
        } else {
            XB_SPIN(xb_ld(&bar[XB_XGEN(b.x)]) == gen, bar);
            __builtin_amdgcn_fence(__ATOMIC_ACQUIRE, "agent");
            asm volatile("s_waitcnt vmcnt(0)" ::: "memory");
        }
    }
    __syncthreads();
}
namespace mk {
#define LAS __attribute__((address_space(3)))
typedef unsigned short bf16_t;
typedef short bf16x8 __attribute__((ext_vector_type(8)));
typedef short s16x4 __attribute__((ext_vector_type(4)));
typedef float f32x16 __attribute__((ext_vector_type(16)));
typedef float f32x4 __attribute__((ext_vector_type(4)));
typedef unsigned u32x4 __attribute__((ext_vector_type(4)));
typedef unsigned u32x2 __attribute__((ext_vector_type(2)));

constexpr int BATCH = 8, SEQ = 2048, DM = 2048, MTOK = BATCH * SEQ, NIN = 6149, NQKV = 6144, DFF = 5632, NGU = 2 * DFF, HD = 128, NTHR = 512;
constexpr float EPS = 1e-6f;
constexpr float LOG2E = 1.4426950408889634f;
constexpr float C2 = 0.08838834764831845f * LOG2E;
constexpr int LDS_STAGE = 131072, LDS_BYTES = LDS_STAGE + 16;

constexpr size_t SZ_WIN = (size_t)NQKV * DM * 2, SZ_WO = (size_t)DM * DM * 2, SZ_WGU = (size_t)NGU * DM * 2, SZ_WD = (size_t)DM * DFF * 2, SZ_WL = SZ_WIN + SZ_WO + SZ_WGU + SZ_WD;
constexpr size_t WS_W = 0;
constexpr size_t WS_ABUF = WS_W + 2 * SZ_WL, SZ_ABUF = (size_t)MTOK * DM * 2;
constexpr size_t WS_PROJ = WS_ABUF + SZ_ABUF, SZ_PROJ = (size_t)MTOK * NQKV * 2;
constexpr size_t WS_HALO = WS_PROJ + SZ_PROJ, SZ_HALO = (size_t)(MTOK / 64) * 4 * NGU * 4;
constexpr size_t WS_H = WS_HALO + SZ_HALO, SZ_H = (size_t)MTOK * DFF * 2;
constexpr size_t WS_FC = WS_H + SZ_H, SZ_FC = (size_t)MTOK * 8 * 4;
constexpr size_t WS_CTR = WS_FC + SZ_FC, WS_BAR = WS_CTR + 256, WS_RSS = WS_BAR + 3456 * 4, WS_KN = WS_RSS + (size_t)4 * MTOK * 4, WS_END = WS_KN + (size_t)2 * MTOK * 16 * 4;

struct Params { const float *x, *g_mix, *w_in, *b_f, *g_head, *w_o, *g_ffn, *w_gu, *conv_w, *conv_b, *w_down, *g_final; float* out; unsigned char* ws; int ph_lo, ph_hi; };

__device__ __forceinline__ unsigned cvtpk(float lo, float hi) { unsigned r; asm volatile("v_cvt_pk_bf16_f32 %0, %1, %2" : "=v"(r) : "v"(lo), "v"(hi)); return r; }

struct CvTile { const float* src; bf16_t* dst; const float* gk; int ldn, K; };
constexpr int CV_PER_LAYER = 3072 + 1024 + 5632 + 2816, CV_TOTAL = 2 * CV_PER_LAYER;
__device__ __forceinline__ CvTile cv_decode(const Params& p, unsigned char* ws, int g) {
    const int l2 = g / CV_PER_LAYER, r = g - l2 * CV_PER_LAYER;
    unsigned char* wl = ws + WS_W + (size_t)l2 * SZ_WL;
    CvTile t; t.gk = nullptr; int ntn, lt; const float* W; bf16_t* Bt; bool gup = false;
    if (r < 3072) { lt = r; ntn = NQKV / 64; W = p.w_in + (size_t)l2 * DM * NIN; t.ldn = NIN; t.K = DM; Bt = (bf16_t*)wl; }
    else if (r < 4096) { lt = r - 3072; ntn = DM / 64; W = p.w_o + (size_t)l2 * DM * DM; t.ldn = DM; t.K = DM; Bt = (bf16_t*)(wl + SZ_WIN); }
    else if (r < 9728) { lt = r - 4096; ntn = NGU / 64; W = p.w_gu + (size_t)l2 * DM * NGU; t.ldn = NGU; t.K = DM; Bt = (bf16_t*)(wl + SZ_WIN + SZ_WO); gup = true; t.gk = p.g_ffn + l2 * DM; }
    else { lt = r - 9728; ntn = DM / 64; W = p.w_down + (size_t)l2 * DFF * DM; t.ldn = DM; t.K = DFF; Bt = (bf16_t*)(wl + SZ_WIN + SZ_WO + SZ_WGU); }
    const int tn = lt % ntn, tk = lt / ntn, k0 = tk * 64, n0 = tn * 64;
    const int nd0 = !gup ? n0 : (n0 < DFF ? (n0 >> 7) * 256 + (n0 & 127) : ((n0 - DFF) >> 7) * 256 + 128 + ((n0 - DFF) & 127));
    t.src = W + (size_t)k0 * t.ldn + n0; t.dst = Bt + (size_t)nd0 * t.K + k0; if (t.gk) t.gk += k0;
    return t;
}
__device__ __forceinline__ void convert_weights(const Params& p, unsigned char* ws, LAS float* tile) {
    int tid_l = threadIdx.x; asm volatile("" : "+v"(tid_l)); const int tid = tid_l, G = gridDim.x;
    const int kk = tid >> 6, nn = tid & 63, n = tid >> 3, kc = (tid & 7) * 8;
    int g = blockIdx.x, it = 0;
    if (g >= CV_TOTAL) return;
    bool has1 = g + G < CV_TOTAL;
    CvTile c0 = cv_decode(p, ws, g), c1 = cv_decode(p, ws, has1 ? g + G : g);
    float v0[8], v1[8];
#pragma unroll
    for (int i = 0; i < 8; ++i) v0[i] = c0.src[(size_t)(i * 8 + kk) * c0.ldn + nn];
#pragma unroll
    for (int i = 0; i < 8; ++i) v1[i] = c1.src[(size_t)(i * 8 + kk) * c1.ldn + nn];
    for (;;) {
        const int gn = g + 2 * G; const bool more = gn < CV_TOTAL, more1 = gn + G < CV_TOTAL;
        CvTile n0 = c0, n1 = c1; float w0[8], w1[8];
        if (more) { n0 = cv_decode(p, ws, gn); n1 = cv_decode(p, ws, more1 ? gn + G : gn);
#pragma unroll
            for (int i = 0; i < 8; ++i) w0[i] = n0.src[(size_t)(i * 8 + kk) * n0.ldn + nn];
#pragma unroll
            for (int i = 0; i < 8; ++i) w1[i] = n1.src[(size_t)(i * 8 + kk) * n1.ldn + nn]; }
        LAS float* tb0 = tile + ((it & 1) * 2) * (64 * 65); LAS float* tb1 = tb0 + 64 * 65;
        if (c0.gk) {
#pragma unroll
            for (int i = 0; i < 8; ++i) v0[i] *= c0.gk[i * 8 + kk]; }
        if (c1.gk) {
#pragma unroll
            for (int i = 0; i < 8; ++i) v1[i] *= c1.gk[i * 8 + kk]; }
#pragma unroll
        for (int i = 0; i < 8; ++i) { tb0[(i * 8 + kk) * 65 + nn] = v0[i]; tb1[(i * 8 + kk) * 65 + nn] = v1[i]; }
        __syncthreads();
        { float f[8];
#pragma unroll
          for (int j = 0; j < 8; ++j) f[j] = tb0[(kc + j) * 65 + n];
          u32x4 w = {cvtpk(f[0], f[1]), cvtpk(f[2], f[3]), cvtpk(f[4], f[5]), cvtpk(f[6], f[7])};
          *(u32x4*)(c0.dst + (size_t)n * c0.K + kc) = w; }
        if (has1) { float f[8];
#pragma unroll
          for (int j = 0; j < 8; ++j) f[j] = tb1[(kc + j) * 65 + n];
          u32x4 w = {cvtpk(f[0], f[1]), cvtpk(f[2], f[3]), cvtpk(f[4], f[5]), cvtpk(f[6], f[7])};
          *(u32x4*)(c1.dst + (size_t)n * c1.K + kc) = w; }
        if (!more) break;
#pragma unroll
        for (int i = 0; i < 8; ++i) { v0[i] = w0[i]; v1[i] = w1[i]; }
        c0 = n0; c1 = n1; has1 = more1; g = gn; ++it;
    }
    __syncthreads();
}

template <bool FC, bool OUTF32>
__device__ __forceinline__ void norm_phase(const float* X, const float* __restrict__ g, bf16_t* hn, float* outf,
                                           const float* __restrict__ w_in_l, float* __restrict__ fcbuf, LAS float* wfc) {
    int tid_l = threadIdx.x; asm volatile("" : "+v"(tid_l)); const int tid = tid_l, wid = tid >> 6, lane = tid & 63;
    if (FC) { for (int i = tid; i < 5 * DM; i += NTHR) { const int d = i / 5, j = i - d * 5; wfc[j * DM + d] = w_in_l[(size_t)d * NIN + NQKV + j]; } __syncthreads(); }
    for (int row = blockIdx.x * 8 + wid; row < MTOK; row += gridDim.x * 8) {
        const float* xr = X + (size_t)row * DM;
        f32x4 v[8];
#pragma unroll
        for (int i = 0; i < 8; ++i) v[i] = *(const f32x4*)(xr + (i * 64 + lane) * 4);
        float ss = 0.f;
#pragma unroll
        for (int i = 0; i < 8; ++i) ss += v[i][0] * v[i][0] + v[i][1] * v[i][1] + v[i][2] * v[i][2] + v[i][3] * v[i][3];
#pragma unroll
        for (int o = 32; o >= 1; o >>= 1) ss += __shfl_xor(ss, o);
        const float rs = 1.0f / sqrtf(ss * (1.0f / DM) + EPS);
        float fc0 = 0.f, fc1 = 0.f, fc2 = 0.f, fc3 = 0.f, fc4 = 0.f;
#pragma unroll
        for (int i = 0; i < 8; ++i) {
            const int d = (i * 64 + lane) * 4;
            const f32x4 gv = *(const f32x4*)(g + d);
            const f32x4 y = v[i] * rs * gv;
            if (OUTF32) *(f32x4*)(outf + (size_t)row * DM + d) = y;
            else { u32x2 w = {cvtpk(y[0], y[1]), cvtpk(y[2], y[3])}; *(u32x2*)(hn + (size_t)row * DM + d) = w; }
            if (FC) {
                const f32x4 w0 = *(const LAS f32x4*)(wfc + 0 * DM + d), w1 = *(const LAS f32x4*)(wfc + 1 * DM + d), w2 = *(const LAS f32x4*)(wfc + 2 * DM + d),
                            w3 = *(const LAS f32x4*)(wfc + 3 * DM + d), w4 = *(const LAS f32x4*)(wfc + 4 * DM + d);
                fc0 += y[0] * w0[0] + y[1] * w0[1] + y[2] * w0[2] + y[3] * w0[3];
                fc1 += y[0] * w1[0] + y[1] * w1[1] + y[2] * w1[2] + y[3] * w1[3];
                fc2 += y[0] * w2[0] + y[1] * w2[1] + y[2] * w2[2] + y[3] * w2[3];
                fc3 += y[0] * w3[0] + y[1] * w3[1] + y[2] * w3[2] + y[3] * w3[3];
                fc4 += y[0] * w4[0] + y[1] * w4[1] + y[2] * w4[2] + y[3] * w4[3];
            }
        }
        if (FC) {
#pragma unroll
            for (int o = 32; o >= 1; o >>= 1) { fc0 += __shfl_xor(fc0, o); fc1 += __shfl_xor(fc1, o); fc2 += __shfl_xor(fc2, o); fc3 += __shfl_xor(fc3, o); fc4 += __shfl_xor(fc4, o); }
            if (lane == 0) { float* f = fcbuf + (size_t)row * 8; f[0] = fc0; f[1] = fc1; f[2] = fc2; f[3] = fc3; f[4] = fc4; }
        }
    }
}

__device__ __forceinline__ void fixup_phase(const float* __restrict__ halo, bf16_t* __restrict__ h, const float* __restrict__ cw, const float* __restrict__ cb) {
    constexpr int NCG = DFF / 4, NCHUNK = MTOK / 64;
    const int total = NCG * NCHUNK * 2;
    for (int u = blockIdx.x * NTHR + threadIdx.x; u < total; u += gridDim.x * NTHR) {
        const int cgi = u % NCG, rs = u / NCG, slot = rs & 1, chunk = rs >> 1, j = cgi * 4;
        const bool seq0 = (chunk & 31) == 0;
        const f32x4 z = {0.f, 0.f, 0.f, 0.f};
        const float* hc = halo + (size_t)chunk * 4 * NGU + j; const float* hp = hc - (size_t)4 * NGU;
        f32x4 g0, g1, g2, u0, u1, u2;
        if (slot == 0) { g0 = *(const f32x4*)(hc); u0 = *(const f32x4*)(hc + DFF);
            g1 = seq0 ? z : *(const f32x4*)(hp + 3 * NGU); u1 = seq0 ? z : *(const f32x4*)(hp + 3 * NGU + DFF);
            g2 = seq0 ? z : *(const f32x4*)(hp + 2 * NGU); u2 = seq0 ? z : *(const f32x4*)(hp + 2 * NGU + DFF); }
        else { g0 = *(const f32x4*)(hc + NGU); u0 = *(const f32x4*)(hc + NGU + DFF);
            g1 = *(const f32x4*)(hc); u1 = *(const f32x4*)(hc + DFF);
            g2 = seq0 ? z : *(const f32x4*)(hp + 3 * NGU); u2 = seq0 ? z : *(const f32x4*)(hp + 3 * NGU + DFF); }
        const f32x4 wg0 = *(const f32x4*)(cw + j), wg1 = *(const f32x4*)(cw + NGU + j), wg2 = *(const f32x4*)(cw + 2 * NGU + j);
        const f32x4 wu0 = *(const f32x4*)(cw + DFF + j), wu1 = *(const f32x4*)(cw + NGU + DFF + j), wu2 = *(const f32x4*)(cw + 2 * NGU + DFF + j);
        const f32x4 bg = *(const f32x4*)(cb + j), bu = *(const f32x4*)(cb + DFF + j);
        float hv[4];
#pragma unroll
        for (int e = 0; e < 4; ++e) { const float G = bg[e] + wg0[e] * g2[e] + wg1[e] * g1[e] + wg2[e] * g0[e]; const float U = bu[e] + wu0[e] * u2[e] + wu1[e] * u1[e] + wu2[e] * u0[e];
            hv[e] = G / (1.0f + __expf(-G)) * U; }
        u32x2 w = {cvtpk(hv[0], hv[1]), cvtpk(hv[2], hv[3])};
        *(u32x2*)(h + (size_t)(chunk * 64 + slot) * DFF + j) = w;
    }
}

constexpr int SHM_K = 16384, SHM_V = 16384;
constexpr int AT_WS = 65536, AT_TAB = AT_WS + 2048, AT_ITEM = AT_TAB + 9216;
#define KSWZ(row, colB) ((row) * 256 + ((colB) ^ (((row) & 7) << 4)))
#define SBAR() __builtin_amdgcn_sched_barrier(0)
__device__ __forceinline__ int v_st(int k, int c) { const int kk = (k & ~0xC) | ((k & 4) << 1) | ((k & 8) >> 1); return ((kk >> 3) * 4 + (c >> 5)) * 512 + ((kk & 7) * 32 + (c & 31)) * 2; }
__device__ __forceinline__ int v_rd_base(int lane) { return ((lane & 3) << 3) | (((lane >> 2) & 3) << 6) | (((lane >> 4) & 1) << 5) | (((lane >> 5) & 1) << 8); }
constexpr int v_rd_off(int d0, int ks, int half) { return d0 * 512 + ks * 4096 + half * 2048; }
__device__ __forceinline__ int crow(int r, int hi) { return (r & 3) + 8 * (r >> 2) + 4 * hi; }
__device__ __forceinline__ float pl32_max(float x) { auto rr = __builtin_amdgcn_permlane32_swap(__float_as_uint(x), __float_as_uint(x), false, false); return fmaxf(__uint_as_float(rr[0]), __uint_as_float(rr[1])); }
__device__ __forceinline__ float pl32_sum(float x) { auto rr = __builtin_amdgcn_permlane32_swap(__float_as_uint(x), __float_as_uint(x), false, false); return __uint_as_float(rr[0]) + __uint_as_float(rr[1]); }
__device__ __forceinline__ float pl32_other(float x, int hi) { auto rr = __builtin_amdgcn_permlane32_swap(__float_as_uint(x), __float_as_uint(x), false, false); return __uint_as_float(hi ? rr[0] : rr[1]); }

__device__ __forceinline__ void qkt(f32x16& p0, f32x16& p1, const LAS char* Kb, int r32, int hi, const bf16x8* qr) {
    p0 = f32x16{}; p1 = f32x16{};
    const LAS char* kb[4];
#pragma unroll
    for (int dd = 0; dd < 4; ++dd) kb[dd] = Kb + KSWZ(r32, (dd * 16 + hi * 8) * 2);
    __builtin_amdgcn_s_setprio(1);
#pragma unroll
    for (int d0 = 0; d0 < 8; ++d0) { const LAS char* a = kb[d0 & 3] + (d0 >> 2) * 128;
        bf16x8 b0 = *reinterpret_cast<const LAS bf16x8*>(a);
        bf16x8 b1 = *reinterpret_cast<const LAS bf16x8*>(a + 32 * 256);
        p0 = __builtin_amdgcn_mfma_f32_32x32x16_bf16(b0, qr[d0], p0, 0, 0, 0);
        p1 = __builtin_amdgcn_mfma_f32_32x32x16_bf16(b1, qr[d0], p1, 0, 0, 0); }
    __builtin_amdgcn_s_setprio(0);
}
__device__ __forceinline__ void pv_tile(f32x16* o, int vb0, bf16x8 pa0, bf16x8 pa1, bf16x8 pa2, bf16x8 pa3) {
#define TRRD(dst, off) asm volatile("ds_read_b64_tr_b16 %0, %1 offset:%2" : "=&v"(dst) : "v"(vb0), "i"(off) : "memory")
#define PV_D0(d0) do { s16x4 l0, l1, l2, l3, h0, h1, h2, h3; constexpr int b_ = v_rd_off(d0, 0, 0); \
        TRRD(l0, b_); TRRD(h0, b_ + 2048); TRRD(l1, b_ + 4096); TRRD(h1, b_ + 6144); TRRD(l2, b_ + 8192); TRRD(h2, b_ + 10240); TRRD(l3, b_ + 12288); TRRD(h3, b_ + 14336); \
        asm volatile("s_waitcnt lgkmcnt(0)" ::: "memory"); SBAR(); \
        o[d0] = __builtin_amdgcn_mfma_f32_32x32x16_bf16(pa0, (bf16x8){l0[0], l0[1], l0[2], l0[3], h0[0], h0[1], h0[2], h0[3]}, o[d0], 0, 0, 0); \
        o[d0] = __builtin_amdgcn_mfma_f32_32x32x16_bf16(pa1, (bf16x8){l1[0], l1[1], l1[2], l1[3], h1[0], h1[1], h1[2], h1[3]}, o[d0], 0, 0, 0); \
        o[d0] = __builtin_amdgcn_mfma_f32_32x32x16_bf16(pa2, (bf16x8){l2[0], l2[1], l2[2], l2[3], h2[0], h2[1], h2[2], h2[3]}, o[d0], 0, 0, 0); \
        o[d0] = __builtin_amdgcn_mfma_f32_32x32x16_bf16(pa3, (bf16x8){l3[0], l3[1], l3[2], l3[3], h3[0], h3[1], h3[2], h3[3]}, o[d0], 0, 0, 0); } while (0)
    __builtin_amdgcn_s_setprio(1);
    PV_D0(0); PV_D0(1); PV_D0(2); PV_D0(3);
    __builtin_amdgcn_s_setprio(0);
#undef PV_D0
#undef TRRD
}
#define PK4(P, B_, OUT) do { unsigned a0 = cvtpk(P[B_+0], P[B_+1]), a1 = cvtpk(P[B_+2], P[B_+3]); \
        unsigned b0 = cvtpk(P[B_+4], P[B_+5]), b1 = cvtpk(P[B_+6], P[B_+7]); \
        auto r0 = __builtin_amdgcn_permlane32_swap(a0, b0, false, false); auto r1 = __builtin_amdgcn_permlane32_swap(a1, b1, false, false); \
        u32x4 w = {r0[0], r1[0], r0[1], r1[1]}; OUT = *reinterpret_cast<bf16x8*>(&w); } while (0)

template <int TYPE>
__device__ __forceinline__ void attn_item(const bf16_t* __restrict__ proj, bf16_t* __restrict__ obuf, const float* __restrict__ fcbuf, const float* __restrict__ bf_l,
                                          const float* __restrict__ ghead_l, const float* __restrict__ kn, int b, int hl, int qb, LAS char* lds) {
    int tid_l = threadIdx.x; asm volatile("" : "+v"(tid_l)); const int tid = tid_l, wid = __builtin_amdgcn_readfirstlane(tid >> 6), lane = tid & 63, r32 = lane & 31, hi = lane >> 5;
    constexpr int LD = NQKV;
    constexpr int QC = TYPE == 0 ? 0 : (TYPE == 1 ? 2304 : 4224), KC = TYPE == 0 ? 768 : (TYPE == 1 ? 2944 : 4864), VC = TYPE == 0 ? 1536 : (TYPE == 1 ? 3584 : 5504);
    constexpr int HOFF = TYPE == 0 ? 0 : (TYPE == 1 ? 6 : 11);
    const int q0 = qb * 256, qlo = q0 + wid * 32, NT = 4 * (qb + 1);
    const bf16_t* Qp = proj + (size_t)(b * SEQ + qlo + r32) * LD + QC + hl * HD;
    const bf16_t* Kp = proj + (size_t)(b * SEQ) * LD + KC + hl * HD;
    const bf16_t* Vp = proj + (size_t)(b * SEQ) * LD + VC + hl * HD;
    LAS char* V_lds = lds; LAS char* K_lds = lds + 2 * SHM_V;
    LAS float* wsf = (LAS float*)(lds + AT_WS) + wid * 64;
    LAS float* tab = (LAS float*)(lds + AT_TAB);
    LAS int* dflag = (LAS int*)(lds + AT_ITEM + 16);
    const float NEGINF = -__builtin_inff();

    const float slope2 = exp2f(-8.0f * (float)(hl + 1) / 6.0f) * LOG2E;
    float kmax2 = 0.f;
    if (TYPE != 1) {
        LAS float* kred = (LAS float*)(lds + AT_ITEM + 128);
        float mx = 0.f;
        for (int s_ = tid; s_ < q0 + 256; s_ += NTHR) mx = fmaxf(mx, kn[(size_t)(b * SEQ + s_) * 16 + HOFF + hl]);
#pragma unroll
        for (int o_ = 32; o_ >= 1; o_ >>= 1) mx = fmaxf(mx, __shfl_xor(mx, o_));
        if (lane == 0) kred[wid] = mx;
        __syncthreads();
#pragma unroll
        for (int w = 0; w < 8; ++w) kmax2 = fmaxf(kmax2, kred[w]);
    }
    if (TYPE == 0) {
        for (int i = tid; i < 2304; i += NTHR) { const int d = i - 256; float v = NEGINF;
            if (d >= 0) { const int m = (d <= 128 ? 1 : 0) + (((d & 3) == 0 && d <= 512) ? 1 : 0) + ((d & 15) == 0 ? 1 : 0);
                if (m > 0) v = -slope2 * (float)d + (m == 1 ? 0.f : (m == 2 ? 1.0f : 1.5849625007211562f)); }
            tab[i] = v; }
    }
    if (TYPE == 2) {
        const float bf = bf_l[hl]; const int t0 = tid * 4; float lf[4];
#pragma unroll
        for (int j = 0; j < 4; ++j) { const float x = fcbuf[(size_t)(b * SEQ + t0 + j) * 8 + hl] + bf; lf[j] = (fminf(x, 0.f) - log1pf(expf(-fabsf(x)))) * LOG2E; }
        lf[1] += lf[0]; lf[2] += lf[1]; lf[3] += lf[2];
        const float tot = lf[3]; float incl = tot;
#pragma unroll
        for (int o = 1; o < 64; o <<= 1) { const float t = __shfl_up(incl, o); if (lane >= o) incl += t; }
        LAS float* wsum = (LAS float*)(lds + AT_WS);
        if (lane == 63) wsum[wid] = incl;
        __syncthreads();
        float pre = 0.f;
        for (int w = 0; w < wid; ++w) pre += wsum[w];
        const float ex = incl - tot + pre;
#pragma unroll
        for (int j = 0; j < 4; ++j) tab[t0 + j] = ex + lf[j];
    }
    bf16x8 qr[8];
#pragma unroll
    for (int d0 = 0; d0 < 8; ++d0) qr[d0] = *(const bf16x8*)(Qp + d0 * 16 + hi * 8);
    float Bq = 0.f;
    if (TYPE != 1) { float qs = 0.f;
#pragma unroll
        for (int d0 = 0; d0 < 8; ++d0)
#pragma unroll
            for (int e_ = 0; e_ < 8; ++e_) { const float f = __uint_as_float(((unsigned)(unsigned short)qr[d0][e_]) << 16); qs += f * f; }
        qs = pl32_sum(qs);
        Bq = sqrtf(qs) * sqrtf(kmax2) * (1.02f * C2) + 0.5f; }
    const int sr = tid >> 4, sc = (tid & 15) * 8;
    const int kws = KSWZ(sr, sc * 2), vst0 = v_st(sr, sc), vst1 = v_st(32 + sr, sc);
#define TILE_KB(it_) ((NT - 1 - (it_)) * 64)
    bf16x8 st_k0, st_k1, st_v0, st_v1;
#define SLOAD(kb_) do { st_k0 = *(const bf16x8*)(Kp + (size_t)((kb_) + sr) * LD + sc); st_k1 = *(const bf16x8*)(Kp + (size_t)((kb_) + 32 + sr) * LD + sc); \
                        st_v0 = *(const bf16x8*)(Vp + (size_t)((kb_) + sr) * LD + sc); st_v1 = *(const bf16x8*)(Vp + (size_t)((kb_) + 32 + sr) * LD + sc); } while (0)
#define SWRITE(bf_) do { *(LAS bf16x8*)(K_lds + (bf_) * SHM_K + kws) = st_k0; *(LAS bf16x8*)(K_lds + (bf_) * SHM_K + kws + 32 * 256) = st_k1; \
                         *(LAS bf16x8*)(V_lds + (bf_) * SHM_V + vst0) = st_v0; *(LAS bf16x8*)(V_lds + (bf_) * SHM_V + vst1) = st_v1; } while (0)
    SLOAD(TILE_KB(0)); SWRITE(0);
    __syncthreads();
    const int vbase = (int)(unsigned)(uintptr_t)V_lds + v_rd_base(lane);
    float m_reg = -1e30f, l_reg = 0.f, Rc = 1.f;
    bool wdone = false;
    float cq2 = 0.f; if (TYPE == 2) cq2 = tab[qlo + r32];
    f32x16 o[4] = {};
    for (int it = 0; it < NT; ++it) {
        const int cur = it & 1, kbase = TILE_KB(it);
        if (it + 1 < NT) { const int kb2 = TILE_KB(it + 1); SLOAD(kb2); }
        const bool act = !wdone && ((TYPE == 1) ? (kbase <= qlo + 30) : (kbase <= qlo + 31));
        if (act) {
            f32x16 p0, p1;
            qkt(p0, p1, K_lds + cur * SHM_K, r32, hi, qr);
            const int dq = qlo + r32 - 4 * hi - kbase;
            bf16x8 pa0, pa1, pa2, pa3;
            if (TYPE != 1) {
                if (TYPE == 0) {
                    const LAS float* tb = tab + (dq + 256 - 63);
                    f32x16 bz0, bz1;
#pragma unroll
                    for (int r = 0; r < 16; ++r) { const int c = (r & 3) + 8 * (r >> 2); bz0[r] = tb[63 - c]; bz1[r] = tb[31 - c]; }
                    p0 = p0 * C2 + bz0; p1 = p1 * C2 + bz1;
                } else {
                    f32x16 kz0, kz1;
#pragma unroll
                    for (int g = 0; g < 4; ++g) { const f32x4 ck0 = *(const LAS f32x4*)(tab + kbase + 8 * g + 4 * hi), ck1 = *(const LAS f32x4*)(tab + kbase + 32 + 8 * g + 4 * hi);
#pragma unroll
                        for (int j = 0; j < 4; ++j) { kz0[4 * g + j] = ck0[j]; kz1[4 * g + j] = ck1[j]; } }
                    p0 = p0 * C2 + (cq2 - kz0); p1 = p1 * C2 + (cq2 - kz1);
                    if (kbase + 63 > qlo) {
#pragma unroll
                        for (int r = 0; r < 16; ++r) { const int c = (r & 3) + 8 * (r >> 2); if (dq - c < 0) p0[r] = NEGINF; if (dq - c - 32 < 0) p1[r] = NEGINF; }
                    }
                }
                float pmax = p0[0];
#pragma unroll
                for (int r = 1; r < 16; ++r) pmax = fmaxf(pmax, p0[r]);
#pragma unroll
                for (int r = 0; r < 16; ++r) pmax = fmaxf(pmax, p1[r]);
                pmax = pl32_max(pmax);
                float mn, alpha;
                if (__all((pmax - m_reg) <= 11.5f)) { mn = m_reg; alpha = 1.f; }
                else { mn = fmaxf(m_reg, pmax); alpha = __builtin_amdgcn_exp2f(m_reg - mn); m_reg = mn; }
                float ps = 0.f;
                { const float nm = -mn; f32x16 nmv; for (int r = 0; r < 16; ++r) nmv[r] = nm; p0 = p0 + nmv; p1 = p1 + nmv; }
#pragma unroll
                for (int r = 0; r < 16; ++r) { p0[r] = __builtin_amdgcn_exp2f(p0[r]); p1[r] = __builtin_amdgcn_exp2f(p1[r]); }
                { const f32x16 sv = p0 + p1; const f32x4 s4 = (f32x4){sv[0], sv[1], sv[2], sv[3]} + (f32x4){sv[4], sv[5], sv[6], sv[7]} + (f32x4){sv[8], sv[9], sv[10], sv[11]} + (f32x4){sv[12], sv[13], sv[14], sv[15]};
                  ps = (s4[0] + s4[1]) + (s4[2] + s4[3]); }
                ps = pl32_sum(ps);
                l_reg = l_reg * alpha + ps;
                if (__any(alpha < 1.f)) {
                    if (hi == 0) wsf[32 + r32] = alpha;
                    asm volatile("s_waitcnt lgkmcnt(0)" ::: "memory");
#pragma unroll
                    for (int r = 0; r < 16; ++r) { const float a = wsf[32 + crow(r, hi)];
#pragma unroll
                        for (int d_ = 0; d_ < 4; ++d_) o[d_][r] *= a; }
                }
            } else {
                f32x16 l0, l1;
                const bool diag = (kbase + 63 >= qlo);
#pragma unroll
                for (int r = 0; r < 16; ++r) { const int c = (r & 3) + 8 * (r >> 2);
                    float u0 = __builtin_amdgcn_rcpf(1.0f + __builtin_amdgcn_exp2f(p0[r] * C2));
                    float u1 = __builtin_amdgcn_rcpf(1.0f + __builtin_amdgcn_exp2f(p1[r] * C2));
                    float s0 = 1.0f - u0, s1 = 1.0f - u1;
                    if (diag) { if (dq - c <= 0) { u0 = 1.f; s0 = 0.f; } if (dq - c - 32 <= 0) { u1 = 1.f; s1 = 0.f; } }
                    p0[r] = s0; p1[r] = s1; l0[r] = u0; l1[r] = u1; }
                float cs[2][4], pc[2][4];
#pragma unroll
                for (int g = 0; g < 4; ++g) { cs[0][g] = (l0[4 * g] * l0[4 * g + 1]) * (l0[4 * g + 2] * l0[4 * g + 3]); cs[1][g] = (l1[4 * g] * l1[4 * g + 1]) * (l1[4 * g + 2] * l1[4 * g + 3]); }
#pragma unroll
                for (int g = 0; g < 4; ++g) { pc[0][g] = pl32_other(cs[0][g], hi); pc[1][g] = pl32_other(cs[1][g], hi); }
                float run = Rc;
#pragma unroll
                for (int p = 1; p >= 0; --p)
#pragma unroll
                    for (int g = 3; g >= 0; --g) {
                        float acc = hi == 0 ? run * pc[p][g] : run;
                        run *= cs[p][g] * pc[p][g];
#pragma unroll
                        for (int j = 3; j >= 0; --j) { if (p == 0) { const float a = p0[4 * g + j] * acc; acc *= l0[4 * g + j]; p0[4 * g + j] = a; }
                                                       else { const float a = p1[4 * g + j] * acc; acc *= l1[4 * g + j]; p1[4 * g + j] = a; } }
                    }
                Rc = run;
            }
            PK4(p0, 0, pa0); PK4(p0, 8, pa1); PK4(p1, 0, pa2); PK4(p1, 8, pa3);
            pv_tile(o, vbase + cur * SHM_V, pa0, pa1, pa2, pa3);
        }
        if (it + 1 < NT) { SWRITE(cur ^ 1); }
        { bool drow;
          if (TYPE == 1) drow = Rc < 1e-30f;
          else {
              const float bmax = (TYPE == 0) ? (1.5849625f - slope2 * (float)(qlo + r32 - kbase + 1)) : (cq2 - tab[kbase > 0 ? kbase - 1 : 0]);
              drow = (Bq + bmax - m_reg) < -64.f; }
          const int dn = (wdone || __all(drow)) ? 1 : 0; wdone = dn != 0; if (lane == 0) dflag[(it & 1) * 8 + wid] = dn; }
        __syncthreads();
        { const LAS int* f = dflag + (it & 1) * 8; if ((f[0] & f[1] & f[2] & f[3] & f[4] & f[5] & f[6] & f[7]) != 0) break; }
    }
    float rli[16];
    if (TYPE != 1) {
        if (hi == 0) wsf[r32] = l_reg;
        asm volatile("s_waitcnt lgkmcnt(0)" ::: "memory");
#pragma unroll
        for (int r = 0; r < 16; ++r) rli[r] = 1.0f / wsf[crow(r, hi)];
    } else {
#pragma unroll
        for (int r = 0; r < 16; ++r) rli[r] = 1.0f;
    }
    float gh[4];
#pragma unroll
    for (int d0 = 0; d0 < 4; ++d0) gh[d0] = ghead_l[(HOFF + hl) * HD + d0 * 32 + r32];
    bf16_t* Ow = obuf + (size_t)(b * SEQ + qlo) * DM + (HOFF + hl) * HD;
#pragma unroll
    for (int r = 0; r < 16; ++r) {
        float v[4], ss = 0.f;
#pragma unroll
        for (int d0 = 0; d0 < 4; ++d0) { v[d0] = o[d0][r] * rli[r]; ss += v[d0] * v[d0]; }
        ss += __shfl_xor(ss, 1); ss += __shfl_xor(ss, 2); ss += __shfl_xor(ss, 4); ss += __shfl_xor(ss, 8); ss += __shfl_xor(ss, 16);
        const float scl = 1.0f / sqrtf(ss * (1.0f / HD) + EPS);
        const int orow = crow(r, hi);
#pragma unroll
        for (int d0 = 0; d0 < 4; ++d0) { const float y = v[d0] * scl * gh[d0]; const float yn = __shfl_xor(y, 1);
            if ((r32 & 1) == 0) *(unsigned*)(Ow + (size_t)orow * DM + d0 * 32 + r32) = cvtpk(y, yn); }
    }
    __syncthreads();
#undef TILE_KB
#undef SLOAD
#undef SWRITE
}

__device__ __forceinline__ void attn_phase(const bf16_t* proj, bf16_t* obuf, const float* fcbuf, const float* bf_l, const float* ghead_l, const float* kn, unsigned* ctr, LAS char* lds) {
    LAS int* item_s = (LAS int*)(lds + AT_ITEM);
    for (;;) {
        if (threadIdx.x == 0) *item_s = (int)atomicAdd(ctr, 1u);
        __syncthreads();
        const int i = *item_s;
        __syncthreads();
        if (i >= 1024) break;
        int qb, hh, b;
        if (i < 192) { qb = 7 - i / 24; const int r = i % 24; b = r / 3; hh = 3 + r % 3; }
        else if (i < 512) { const int j = i - 192; qb = 7 - j / 40; const int r = j % 40; b = r / 5; hh = 11 + r % 5; }
        else if (i < 704) { const int j = i - 512; qb = 7 - j / 24; const int r = j % 24; b = r / 3; hh = r % 3; }
        else { const int j = i - 704; qb = 7 - j / 40; const int r = j % 40; b = r / 5; hh = 6 + r % 5; }
        if (hh < 6) attn_item<0>(proj, obuf, fcbuf, bf_l, ghead_l, kn, b, hh, qb, lds);
        if (hh >= 6 && hh < 11) attn_item<1>(proj, obuf, fcbuf, bf_l, ghead_l, kn, b, hh - 6, qb, lds);
        if (hh >= 11) attn_item<2>(proj, obuf, fcbuf, bf_l, ghead_l, kn, b, hh - 11, qb, lds);
    }
}

__global__ void __launch_bounds__(NTHR) fwd(Params p) {
    extern __shared__ __attribute__((aligned(16))) unsigned char lds_raw[];
    LAS unsigned char* lds = (LAS unsigned char*)lds_raw;
    cg::grid_group grid = cg::this_grid();
    unsigned char* ws = p.ws;
    bf16_t* abuf = (bf16_t*)(ws + WS_ABUF); bf16_t* proj = (bf16_t*)(ws + WS_PROJ); bf16_t* hbuf = (bf16_t*)(ws + WS_H); float* halo = (float*)(ws + WS_HALO);
    float* fcbuf = (float*)(ws + WS_FC); unsigned* ctr = (unsigned*)(ws + WS_CTR); float* rss = (float*)(ws + WS_RSS); float* kn = (float*)(ws + WS_KN); bf16_t* xbf = proj;
    if (threadIdx.x < 4) ((LAS unsigned*)(lds + LDS_STAGE))[threadIdx.x] = 0u;
    __syncthreads();
    XcdBarrier xb; xb.bar = (unsigned*)(ws + WS_BAR); xb.x = xb_xcc_id(); xb.st = (volatile LAS unsigned*)(lds + LDS_STAGE);
    { unsigned* z = (unsigned*)(ws + WS_CTR); const size_t nz = (WS_END - WS_CTR) / 4;
      for (size_t i = (size_t)blockIdx.x * NTHR + threadIdx.x; i < nz; i += (size_t)gridDim.x * NTHR) z[i] = 0u; }
    int vc = blockIdx.x;
    int ph = 0;
#define PH_BEGIN if (ph >= p.ph_lo && ph < p.ph_hi) { if (ph > p.ph_lo) { if (ph == p.ph_lo + 1) { grid.sync(); \
            if (threadIdx.x == 0) xb.st[2] = xb_add(&xb.bar[XB_XCNT(xb.x)], 1u);     \
            __syncthreads(); } \
          else { xcd_barrier(xb); \
            if (ph == p.ph_lo + 2) { bool okc = true; for (int j = 0; j < 16; ++j) okc = okc && (xb_ld(&xb.bar[XB_XCNT(j)]) == (j < 8 ? 32u : 0u)); \
                if (okc) vc = 8 * (int)xb.st[2] + (int)xb.x; } } }
#define PH_END } ++ph;
    for (int l = 0; l < 2; ++l) {
        const float* xin = (l == 0) ? p.x : p.out;
        bf16_t* WinT = (bf16_t*)(ws + WS_W + (size_t)l * SZ_WL); bf16_t* WoT = (bf16_t*)((unsigned char*)WinT + SZ_WIN); bf16_t* WguT = (bf16_t*)((unsigned char*)WoT + SZ_WO); bf16_t* WdT = (bf16_t*)((unsigned char*)WguT + SZ_WGU);
        PH_BEGIN
            if (l == 0) {
                convert_weights(p, ws, (LAS float*)lds);
            }
            norm_phase<true, false>(xin, p.g_mix + l * DM, abuf, nullptr, p.w_in + (size_t)l * DM * NIN, fcbuf, (LAS float*)lds);
        PH_END
        PH_BEGIN
            pg8::Gemm g{abuf, WinT, MTOK, NQKV, DM}; pg8::StaticOrder S; S.init(MTOK, NQKV, gridDim.x, vc);
            pg8::EpiProj E{proj, NQKV, kn + (size_t)l * MTOK * 16};
            pg8::gemm_phase<pg8::EpiProj, pg8::StaticOrder>(lds, g, S, E, nullptr);
        PH_END
        PH_BEGIN
            attn_phase(proj, abuf, fcbuf, p.b_f + l * 5, p.g_head + l * DM, kn + (size_t)l * MTOK * 16, ctr + l * 16, (LAS char*)lds);
        PH_END
        PH_BEGIN
            pg8::Gemm g{abuf, WoT, MTOK, DM, DM}; pg8::StaticOrder S; S.init(MTOK, DM, gridDim.x, vc);
            pg8::EpiResN E{xin, p.out, xbf, rss + (size_t)l * MTOK, DM};
            pg8::gemm_phase<pg8::EpiResN, pg8::StaticOrder>(lds, g, S, E, nullptr);
        PH_END
        PH_BEGIN
            pg8::Gemm g{xbf, WguT, MTOK, NGU, DM}; pg8::StaticOrder S; S.init(MTOK, NGU, gridDim.x, vc);
            pg8::EpiConv E{hbuf, halo, p.conv_w + (size_t)l * 3 * NGU, p.conv_b + (size_t)l * NGU, DFF, rss + (size_t)l * MTOK, 1.0f / DM, EPS};
            pg8::gemm_phase<pg8::EpiConv, pg8::StaticOrder>(lds, g, S, E, nullptr);
        PH_END
        PH_BEGIN
            fixup_phase(halo, hbuf, p.conv_w + (size_t)l * 3 * NGU, p.conv_b + (size_t)l * NGU);
        PH_END
        PH_BEGIN
            pg8::Gemm g{hbuf, WdT, MTOK, DM, DFF}; pg8::StaticOrder S; S.init(MTOK, DM, gridDim.x, vc);
            pg8::EpiRes E{p.out, p.out, DM};
            pg8::gemm_phase<pg8::EpiRes, pg8::StaticOrder>(lds, g, S, E, nullptr);
        PH_END
    }
    PH_BEGIN
        norm_phase<false, true>(p.out, p.g_final, nullptr, p.out, nullptr, nullptr, (LAS float*)lds);
    PH_END
#undef PH_BEGIN
#undef PH_END
}
}

extern "C" void kernel_launch(void* const* d_in, const int* in_sizes, int n_in, void* d_out, int out_size, void* d_ws, size_t ws_size, hipStream_t stream) {
    static int grid_blocks = 0;
    if (!grid_blocks) {
        if (n_in != 12 || ws_size < mk::WS_END) { fprintf(stderr, "kernel_launch: unexpected n_in %d or ws_size %zu (< %zu)\n", n_in, ws_size, (size_t)mk::WS_END); grid_blocks = -1; return; }
        int dev = 0, cus = 0, per_cu = 0;
        (void)hipGetDevice(&dev);
        if (hipDeviceGetAttribute(&cus, hipDeviceAttributeMultiprocessorCount, dev) != hipSuccess || cus <= 0) cus = 256;
        if (hipFuncSetAttribute((const void*)mk::fwd, hipFuncAttributeMaxDynamicSharedMemorySize, mk::LDS_BYTES) != hipSuccess) fprintf(stderr, "kernel_launch: hipFuncSetAttribute failed\n");
        if (hipOccupancyMaxActiveBlocksPerMultiprocessor(&per_cu, (const void*)mk::fwd, mk::NTHR, mk::LDS_BYTES) != hipSuccess || per_cu < 1) { per_cu = 1; (void)hipGetLastError(); }
        grid_blocks = cus * per_cu;
    }
    if (grid_blocks < 0) return;
    mk::Params p{};
    p.x = (const float*)d_in[0]; p.g_mix = (const float*)d_in[1]; p.w_in = (const float*)d_in[2]; p.b_f = (const float*)d_in[3]; p.g_head = (const float*)d_in[4];
    p.w_o = (const float*)d_in[5]; p.g_ffn = (const float*)d_in[6]; p.w_gu = (const float*)d_in[7]; p.conv_w = (const float*)d_in[8]; p.conv_b = (const float*)d_in[9];
    p.w_down = (const float*)d_in[10]; p.g_final = (const float*)d_in[11];
    p.out = (float*)d_out; p.ws = (unsigned char*)d_ws; p.ph_lo = 0; p.ph_hi = 1000;
    void* args[] = {&p};
    hipError_t e = hipLaunchCooperativeKernel((void*)mk::fwd, dim3(grid_blocks), dim3(mk::NTHR), args, mk::LDS_BYTES, stream);
    if (e != hipSuccess) fprintf(stderr, "cooperative launch failed: %s (grid %d)\n", hipGetErrorString(e), grid_blocks);
}
```

```cpp
#include <hip/hip_runtime.h>
#include <hip/hip_cooperative_groups.h>
#include <cstdio>
#include <cstdint>
namespace cg = cooperative_groups;
namespace pg8 {
#define PG8_LAS __attribute__((address_space(3)))
typedef unsigned short bf16_t;
typedef short bf16x8 __attribute__((ext_vector_type(8)));
typedef float f32x4 __attribute__((ext_vector_type(4)));
typedef unsigned u32x4 __attribute__((ext_vector_type(4)));
constexpr int BM = 256, BK = 64, HALF = 128, HTB = HALF * BK * 2  , STAGE_BYTES = 8 * HTB, NXCD = 8, WGM = 8;

__host__ __device__ __forceinline__ int lds_byte(int r, int c) { const int st = (r >> 4) * 2 + (c >> 5), rr = r & 15, cc = c & 31, ob = rr * 64 + cc * 2; return st * 1024 + (ob ^ (((ob >> 9) & 1) << 5)); }
__host__ __device__ __forceinline__ void stage_rc(int b, int& R, int& C) { const int st = b / 1024, sb = b % 1024, swz = sb ^ (((sb >> 9) & 1) << 5); R = (st >> 1) * 16 + swz / 64; C = (st & 1) * 32 + (swz % 64) / 2; }
__host__ __device__ __forceinline__ int perm32(int rho) { const int n = rho >> 4, i = rho & 15; return 8 * (i >> 2) + 4 * n + (i & 3); }

struct Unit { int pm, pn; };
struct Gemm { const bf16_t* A; const bf16_t* Bt; int M, N, K; };

struct StaticOrder {
    int nM, nN, nwg, G, c;
    __host__ __device__ void init(int M, int N, int G_, int c_) { nM = M / BM; nN = N / BM; nwg = nM * nN; G = G_; c = c_; }
    __host__ __device__ __forceinline__ bool next(int i, Unit& u) const {
        const long L = (long)i * G + c; if (L >= nwg) return false;
        int wgid = (int)L; { const int q = nwg / NXCD, r = nwg % NXCD, xcd = wgid % NXCD, off = wgid / NXCD; wgid = (xcd < r ? xcd * (q + 1) : r * (q + 1) + (xcd - r) * q) + off; }
        const int nig = WGM * nN, gid = wgid / nig, fm = gid * WGM, gsz = (nM - fm) < WGM ? (nM - fm) : WGM;
        u.pm = fm + ((wgid % nig) % gsz); u.pn = (wgid % nig) / gsz; return true;
    }
    __device__ __forceinline__ void a_ready(const Unit&) const {}
    __device__ __forceinline__ void done(const Unit&) const {}
};
struct CountedOrder : StaticOrder {
    const unsigned* ready; unsigned need; unsigned* tmo;
    __device__ __forceinline__ void a_ready(const Unit& u) const {
        if (threadIdx.x < 64) {
            const unsigned long long t0 = __builtin_amdgcn_s_memrealtime(); unsigned polls = 0;
            while ((unsigned)__builtin_amdgcn_readfirstlane(__hip_atomic_load(ready + 64 * u.pm, __ATOMIC_RELAXED, __HIP_MEMORY_SCOPE_AGENT)) < need) {
                if ((++polls & 255u) == 0u && __builtin_amdgcn_readfirstlane(__hip_atomic_load(tmo, __ATOMIC_RELAXED, __HIP_MEMORY_SCOPE_AGENT)) != 0u) break;
                if (__builtin_amdgcn_s_memrealtime() - t0 > 2000000ull) {
                    if (threadIdx.x == 0) { unsigned expect = 0u; __hip_atomic_compare_exchange_strong(tmo + 1, &expect, 0x600u | (unsigned)(u.pm & 0xff), __ATOMIC_RELAXED, __ATOMIC_RELAXED, __HIP_MEMORY_SCOPE_AGENT); __hip_atomic_store(tmo, 1u, __ATOMIC_RELAXED, __HIP_MEMORY_SCOPE_AGENT); }
                    break; }
                __builtin_amdgcn_s_sleep(2); }
            __builtin_amdgcn_fence(__ATOMIC_ACQUIRE, "agent");
            asm volatile("s_waitcnt vmcnt(0)" ::: "memory");
        }
#if !defined(BROKEN_HOOK_NO_BARRIER)
        asm volatile("" ::: "memory"); __builtin_amdgcn_s_barrier(); asm volatile("" ::: "memory");
#endif
    }
};

__device__ __forceinline__ unsigned cvt_pk_bf16(float lo, float hi) { unsigned r; asm volatile("v_cvt_pk_bf16_f32 %0, %1, %2" : "=v"(r) : "v"(lo), "v"(hi)); return r; }
typedef float f32x2 __attribute__((ext_vector_type(2)));
__device__ __forceinline__ f32x2 gelu_pk(f32x2 v) {
    const f32x2 av = __builtin_elementwise_abs(v), d = av * 0.2316418882f + 1.0f;
    f32x2 t; t.x = __builtin_amdgcn_rcpf(d.x); t.y = __builtin_amdgcn_rcpf(d.y);
    f32x2 q = t * 0.5307027145f + (-0.7265760135f); q = q * t + 0.7107068705f; q = q * t + (-0.142248368f); q = q * t + 0.127414796f; q = q * t;
    const f32x2 s = (v * v) * (-0.72134752044f);
    f32x2 e; e.x = __builtin_amdgcn_exp2f(s.x); e.y = __builtin_amdgcn_exp2f(s.y);
    const f32x2 m = v * (q * e), r = v - m;
    f32x2 o; o.x = v.x < 0.f ? m.x : r.x; o.y = v.y < 0.f ? m.y : r.y; return o;
}

struct EpiF32 {
    static constexpr bool PERM = false, AFTER_DRAIN = false;
    float* C; int ldc; const float* bias;
    __device__ __forceinline__ void operator()(const f32x4 (&acc)[2][2][4][2], const Unit& u, int wr, int wc, int fr, int fq) const {
        const int row0 = u.pm * BM + wr * 64 + fr, col0 = u.pn * BM + wc * 32 + 4 * fq;
        f32x4 bv[2][2];
#pragma unroll
        for (int bj = 0; bj < 2; ++bj)
#pragma unroll
            for (int n = 0; n < 2; ++n) bv[bj][n] = bias ? *(const f32x4*)(bias + col0 + bj * HALF + n * 16) : (f32x4){0.f, 0.f, 0.f, 0.f};
#pragma unroll
        for (int ai = 0; ai < 2; ++ai)
#pragma unroll
            for (int m = 0; m < 4; ++m) { float* rowp = C + (size_t)(row0 + ai * HALF + m * 16) * ldc + col0;
#pragma unroll
                for (int bj = 0; bj < 2; ++bj)
#pragma unroll
                    for (int n = 0; n < 2; ++n) *(f32x4*)(rowp + bj * HALF + n * 16) = acc[ai][bj][m][n] + bv[bj][n]; }
    }
};
template <int ACT  > struct EpiBf16 {
    static constexpr bool PERM = true, AFTER_DRAIN = false;
    bf16_t* O; int ldc; const float* bias; int split_cols; size_t split_stride;
    __device__ __forceinline__ void operator()(const f32x4 (&acc)[2][2][4][2], const Unit& u, int wr, int wc, int fr, int fq) const {
        const int row0 = u.pm * BM + wr * 64 + fr; int colt = u.pn * BM; bf16_t* base = O;
        if (split_cols) { const int t = colt / split_cols; base += (size_t)t * split_stride; colt -= t * split_cols; }
        const int col0 = colt + wc * 32 + 8 * fq, bcol0 = u.pn * BM + wc * 32 + 8 * fq;
        f32x4 bv[2][2];
#pragma unroll
        for (int bj = 0; bj < 2; ++bj)
#pragma unroll
            for (int n = 0; n < 2; ++n) bv[bj][n] = bias ? *(const f32x4*)(bias + bcol0 + bj * HALF + 4 * n) : (f32x4){0.f, 0.f, 0.f, 0.f};
#pragma unroll
        for (int ai = 0; ai < 2; ++ai)
#pragma unroll
            for (int m = 0; m < 4; ++m) { bf16_t* rowp = base + (size_t)(row0 + ai * HALF + m * 16) * ldc + col0;
#pragma unroll
                for (int bj = 0; bj < 2; ++bj) { f32x4 v0 = acc[ai][bj][m][0] + bv[bj][0], v1 = acc[ai][bj][m][1] + bv[bj][1];
                    if (ACT == 1) { f32x2 a = gelu_pk((f32x2){v0[0], v0[1]}), b = gelu_pk((f32x2){v0[2], v0[3]}), c = gelu_pk((f32x2){v1[0], v1[1]}), d = gelu_pk((f32x2){v1[2], v1[3]});
                        v0 = (f32x4){a.x, a.y, b.x, b.y}; v1 = (f32x4){c.x, c.y, d.x, d.y}; }
                    if (ACT == 2) {
#pragma unroll
                        for (int j = 0; j < 4; ++j) { v0[j] = 0.5f * v0[j] * (1.0f + erff(v0[j] * 0.70710678f)); v1[j] = 0.5f * v1[j] * (1.0f + erff(v1[j] * 0.70710678f)); } }
                    u32x4 w; w.x = cvt_pk_bf16(v0[0], v0[1]); w.y = cvt_pk_bf16(v0[2], v0[3]); w.z = cvt_pk_bf16(v1[0], v1[1]); w.w = cvt_pk_bf16(v1[2], v1[3]);
                    *(u32x4*)(rowp + bj * HALF) = w; } }
    }
};
struct EpiRes {
    static constexpr bool PERM = false, AFTER_DRAIN = false;
    const float* base; float* out; int ldc;
    __device__ __forceinline__ void operator()(const f32x4 (&acc)[2][2][4][2], const Unit& u, int wr, int wc, int fr, int fq) const {
        const int row0 = u.pm * BM + wr * 64 + fr, col0 = u.pn * BM + wc * 32 + 4 * fq;
#pragma unroll
        for (int ai = 0; ai < 2; ++ai) {
            f32x4 bv[4][2][2];
#pragma unroll
            for (int m = 0; m < 4; ++m) { const size_t off = (size_t)(row0 + ai * HALF + m * 16) * ldc + col0;
#pragma unroll
                for (int bj = 0; bj < 2; ++bj)
#pragma unroll
                    for (int n = 0; n < 2; ++n) bv[m][bj][n] = *(const f32x4*)(base + off + bj * HALF + n * 16); }
            asm volatile("" ::: "memory");
#pragma unroll
            for (int m = 0; m < 4; ++m) { const size_t off = (size_t)(row0 + ai * HALF + m * 16) * ldc + col0;
#pragma unroll
                for (int bj = 0; bj < 2; ++bj)
#pragma unroll
                    for (int n = 0; n < 2; ++n) *(f32x4*)(out + off + bj * HALF + n * 16) = acc[ai][bj][m][n] + bv[m][bj][n]; }
            asm volatile("" ::: "memory");
        }
    }
};
struct EpiResN {
    static constexpr bool PERM = true, AFTER_DRAIN = false;
    const float* base; float* out; bf16_t* xb; float* rowss; int ldc;
    __device__ __forceinline__ void operator()(const f32x4 (&acc)[2][2][4][2], const Unit& u, int wr, int wc, int fr, int fq) const {
        const int row0 = u.pm * BM + wr * 64 + fr, col0 = u.pn * BM + wc * 32 + 8 * fq;
#pragma unroll
        for (int ai = 0; ai < 2; ++ai)
#pragma unroll
          for (int mh = 0; mh < 2; ++mh) {
            f32x4 bv[2][2][2];
#pragma unroll
            for (int mm = 0; mm < 2; ++mm) { const size_t off = (size_t)(row0 + ai * HALF + (mh * 2 + mm) * 16) * ldc + col0;
#pragma unroll
                for (int bj = 0; bj < 2; ++bj)
#pragma unroll
                    for (int n = 0; n < 2; ++n) bv[mm][bj][n] = *(const f32x4*)(base + off + bj * HALF + n * 4); }
            asm volatile("" ::: "memory");
#pragma unroll
            for (int mm = 0; mm < 2; ++mm) { const int m = mh * 2 + mm; const int row = row0 + ai * HALF + m * 16; const size_t off = (size_t)row * ldc + col0; float ss = 0.f;
#pragma unroll
                for (int bj = 0; bj < 2; ++bj) {
                    const f32x4 v0 = acc[ai][bj][m][0] + bv[mm][bj][0], v1 = acc[ai][bj][m][1] + bv[mm][bj][1];
                    *(f32x4*)(out + off + bj * HALF) = v0; *(f32x4*)(out + off + bj * HALF + 4) = v1;
                    u32x4 w; w.x = cvt_pk_bf16(v0[0], v0[1]); w.y = cvt_pk_bf16(v0[2], v0[3]); w.z = cvt_pk_bf16(v1[0], v1[1]); w.w = cvt_pk_bf16(v1[2], v1[3]);
                    *(u32x4*)(xb + off + bj * HALF) = w;
                    { const f32x4 q4 = v0 * v0 + v1 * v1; ss += (q4[0] + q4[1]) + (q4[2] + q4[3]); } }
                ss += __shfl_xor(ss, 16); ss += __shfl_xor(ss, 32);
                if (fq == 0) atomicAdd(rowss + row, ss); }
            asm volatile("" ::: "memory");
          }
    }
};
struct EpiProj {
    static constexpr bool PERM = true, AFTER_DRAIN = false;
    bf16_t* O; int ldc; float* kn;
    __device__ __forceinline__ void operator()(const f32x4 (&acc)[2][2][4][2], const Unit& u, int wr, int wc, int fr, int fq) const {
        const int row0 = u.pm * BM + wr * 64 + fr, col0 = u.pn * BM + wc * 32 + 8 * fq;
        int slot0 = -1, slot1 = -1;
        if (u.pn >= 3 && u.pn <= 5) { slot0 = (u.pn - 3) * 2; slot1 = slot0 + 1; }
        else if (u.pn >= 19 && u.pn <= 21) { slot0 = 11 + (u.pn - 19) * 2; slot1 = slot0 + 1 <= 15 ? slot0 + 1 : -1; }
#pragma unroll
        for (int ai = 0; ai < 2; ++ai)
#pragma unroll
            for (int m = 0; m < 4; ++m) { const int row = row0 + ai * HALF + m * 16; bf16_t* rowp = O + (size_t)row * ldc + col0;
#pragma unroll
                for (int bj = 0; bj < 2; ++bj) { const f32x4 v0 = acc[ai][bj][m][0], v1 = acc[ai][bj][m][1];
                    u32x4 w; w.x = cvt_pk_bf16(v0[0], v0[1]); w.y = cvt_pk_bf16(v0[2], v0[3]); w.z = cvt_pk_bf16(v1[0], v1[1]); w.w = cvt_pk_bf16(v1[2], v1[3]);
                    *(u32x4*)(rowp + bj * HALF) = w;
                    const int slot = bj ? slot1 : slot0;
                    if (slot >= 0) { const f32x4 q4 = v0 * v0 + v1 * v1; float ss = (q4[0] + q4[1]) + (q4[2] + q4[3]);
                        ss += __shfl_xor(ss, 16); ss += __shfl_xor(ss, 32);
                        if (fq == 0) atomicAdd(kn + (size_t)row * 16 + slot, ss); } } }
    }
};
__device__ __forceinline__ float dpp_ror1(float x) { return __int_as_float(__builtin_amdgcn_update_dpp(__float_as_int(x), __float_as_int(x), 0x121, 0xf, 0xf, false)); }
__device__ __forceinline__ float dpp_ror2(float x) { return __int_as_float(__builtin_amdgcn_update_dpp(__float_as_int(x), __float_as_int(x), 0x122, 0xf, 0xf, false)); }
struct EpiConv {
    static constexpr bool PERM = true, AFTER_DRAIN = false;
    bf16_t* H; float* halo; const float* cw; const float* cb; int dff; const float* rowss; float inv_k, eps;
    __device__ __forceinline__ void operator()(const f32x4 (&acc)[2][2][4][2], const Unit& u, int wr, int wc, int fr, int fq) const {
        const int j0 = u.pn * 128 + wc * 32 + 8 * fq; const int ngu = 2 * dff;
#pragma unroll
        for (int ai = 0; ai < 2; ++ai) {
            const int chunk = u.pm * 4 + ai * 2 + wr; const int row0 = chunk * 64 + fr;
            float rs[4];
#pragma unroll
            for (int m = 0; m < 4; ++m) rs[m] = 1.0f / sqrtf(rowss[row0 + 16 * m] * inv_k + eps);
            if (fr < 2) { float* hp = halo + ((size_t)chunk * 4 + fr) * ngu + j0;
#pragma unroll
                for (int n = 0; n < 2; ++n) { *(f32x4*)(hp + 4 * n) = acc[ai][0][0][n] * rs[0]; *(f32x4*)(hp + dff + 4 * n) = acc[ai][1][0][n] * rs[0]; } }
            if (fr >= 14) { float* hp = halo + ((size_t)chunk * 4 + (fr - 12)) * ngu + j0;
#pragma unroll
                for (int n = 0; n < 2; ++n) { *(f32x4*)(hp + 4 * n) = acc[ai][0][3][n] * rs[3]; *(f32x4*)(hp + dff + 4 * n) = acc[ai][1][3][n] * rs[3]; } }
            u32x4 pk[4];
#pragma unroll
            for (int n = 0; n < 2; ++n) {
                const float* wp = cw + j0 + 4 * n;
                const f32x4 wg0 = *(const f32x4*)(wp), wg1 = *(const f32x4*)(wp + ngu), wg2 = *(const f32x4*)(wp + 2 * ngu);
                const f32x4 wu0 = *(const f32x4*)(wp + dff), wu1 = *(const f32x4*)(wp + ngu + dff), wu2 = *(const f32x4*)(wp + 2 * ngu + dff);
                const f32x4 bg = *(const f32x4*)(cb + j0 + 4 * n), bu = *(const f32x4*)(cb + dff + j0 + 4 * n);
#pragma unroll
                for (int m = 0; m < 4; ++m) {
                    const f32x4 cg = acc[ai][0][m][n] * rs[m], cu = acc[ai][1][m][n] * rs[m];
                    const f32x4 pg = m > 0 ? acc[ai][0][m - 1][n] * rs[m > 0 ? m - 1 : 0] : (f32x4){0.f, 0.f, 0.f, 0.f}, pu = m > 0 ? acc[ai][1][m - 1][n] * rs[m > 0 ? m - 1 : 0] : (f32x4){0.f, 0.f, 0.f, 0.f};
                    float hv[4];
#pragma unroll
                    for (int e = 0; e < 4; e += 2) {
                        const f32x2 g1 = {dpp_ror1(fr == 15 ? pg[e] : cg[e]), dpp_ror1(fr == 15 ? pg[e + 1] : cg[e + 1])}, g2 = {dpp_ror2(fr >= 14 ? pg[e] : cg[e]), dpp_ror2(fr >= 14 ? pg[e + 1] : cg[e + 1])};
                        const f32x2 u1 = {dpp_ror1(fr == 15 ? pu[e] : cu[e]), dpp_ror1(fr == 15 ? pu[e + 1] : cu[e + 1])}, u2 = {dpp_ror2(fr >= 14 ? pu[e] : cu[e]), dpp_ror2(fr >= 14 ? pu[e + 1] : cu[e + 1])};
                        const f32x2 c_g = {cg[e], cg[e + 1]}, c_u = {cu[e], cu[e + 1]};
                        const f32x2 G = (f32x2){bg[e], bg[e + 1]} + (f32x2){wg0[e], wg0[e + 1]} * g2 + (f32x2){wg1[e], wg1[e + 1]} * g1 + (f32x2){wg2[e], wg2[e + 1]} * c_g;
                        const f32x2 U = (f32x2){bu[e], bu[e + 1]} + (f32x2){wu0[e], wu0[e + 1]} * u2 + (f32x2){wu1[e], wu1[e + 1]} * u1 + (f32x2){wu2[e], wu2[e + 1]} * c_u;
                        const f32x2 t = G * (-1.4426950408889634f);
                        f32x2 d; d.x = __builtin_amdgcn_exp2f(t.x); d.y = __builtin_amdgcn_exp2f(t.y); d = d + 1.0f;
                        f32x2 r; r.x = __builtin_amdgcn_rcpf(d.x); r.y = __builtin_amdgcn_rcpf(d.y);
                        const f32x2 h2 = (G * r) * U;
                        hv[e] = h2.x; hv[e + 1] = h2.y;
                    }
                    if (n == 0) { pk[m].x = cvt_pk_bf16(hv[0], hv[1]); pk[m].y = cvt_pk_bf16(hv[2], hv[3]); }
                    else { pk[m].z = cvt_pk_bf16(hv[0], hv[1]); pk[m].w = cvt_pk_bf16(hv[2], hv[3]); }
                }
            }
#pragma unroll
            for (int m = 0; m < 4; ++m) if (m > 0 || fr >= 2) *(u32x4*)(H + (size_t)(row0 + 16 * m) * dff + j0) = pk[m];
        }
    }
};
template <class Epi, class Sched, bool STAMP = false>
__device__ __forceinline__ void gemm_phase(PG8_LAS unsigned char* lds, const Gemm g, const Sched& S, const Epi& E, unsigned long long* stamps) {
    int tid_l = threadIdx.x; asm volatile("" : "+v"(tid_l)); const int tid = tid_l, wid = __builtin_amdgcn_readfirstlane(tid >> 6), lane = tid & 63, wr = wid >> 2, wc = wid & 3, fr = lane & 15, fq = lane >> 4;
    const int K = g.K, nt = K / BK;
    int ts_lo = 0, ts_hi = 0, nts = 0; const unsigned long long rt_entry = STAMP ? (unsigned long long)wall_clock64() : 0ull;
#define PG8_STAMP() do { if (STAMP && wid == 0 && nts < 64) { const unsigned long long _c = (unsigned long long)clock64(); \
        ts_lo = (lane == nts) ? (int)(unsigned)_c : ts_lo; ts_hi = (lane == nts) ? (int)(unsigned)(_c >> 32) : ts_hi; ++nts; } } while (0)
    PG8_STAMP();
    unsigned voffA[2], voffB[2];
#pragma unroll
    for (int i = 0; i < 2; ++i) { int R, C; stage_rc(tid * 16 + i * 8192, R, C); const int Rb = Epi::PERM ? ((R & ~31) + perm32(R & 31)) : R;
        voffA[i] = (unsigned)(R * K + C) * 2u; voffB[i] = (unsigned)(Rb * K + C) * 2u; }
    const size_t kstep = (size_t)(BK * 2);
    const size_t hstep = (size_t)HALF * K * 2;
    const size_t tstep = 2 * hstep;
    const unsigned ldsw = (unsigned)wid * 1024u;
    const int aoff = lds_byte(wr * 64 + fr, fq * 8), boff = lds_byte(wc * 32 + fr, fq * 8);
#define PG8_SA(b, h) (((b) * 2 + (h)) * HTB)
#define PG8_SB(b, h) ((4 + (b) * 2 + (h)) * HTB)
#define PG8_STAGE(bufoff, gbase, voff) do { _Pragma("unroll") for (int _i = 0; _i < 2; ++_i) \
        __builtin_amdgcn_global_load_lds((const unsigned*)((const char*)(gbase) + (voff)[_i]), (PG8_LAS unsigned*)(lds + (bufoff) + ldsw + _i * 8192), 16, 0, 0); } while (0)
#define PG8_LDA(dst, b, h) do { _Pragma("unroll") for (int m = 0; m < 4; ++m) _Pragma("unroll") for (int k = 0; k < 2; ++k) dst[m][k] = *(const PG8_LAS bf16x8*)(lds + PG8_SA(b, h) + aoff + m * 2048 + k * 1024); } while (0)
#define PG8_LDB(dst, b, h) do { _Pragma("unroll") for (int n = 0; n < 2; ++n) _Pragma("unroll") for (int k = 0; k < 2; ++k) dst[n][k] = *(const PG8_LAS bf16x8*)(lds + PG8_SB(b, h) + boff + n * 2048 + k * 1024); } while (0)
#define PG8_MMA(ai, bj, At, Bt) do { __builtin_amdgcn_s_setprio(1); _Pragma("unroll") for (int m = 0; m < 4; ++m) _Pragma("unroll") for (int n = 0; n < 2; ++n) _Pragma("unroll") for (int k = 0; k < 2; ++k) \
        acc[ai][bj][m][n] = __builtin_amdgcn_mfma_f32_16x16x32_bf16(Bt[n][k], At[m][k], acc[ai][bj][m][n], 0, 0, 0); __builtin_amdgcn_s_setprio(0); } while (0)
#define PG8_WAIT_V(n) asm volatile("s_waitcnt vmcnt(" #n ")" ::: "memory")
#define PG8_WAIT_L(n) asm volatile("s_waitcnt lgkmcnt(" #n ")" ::: "memory")
#define PG8_BAR __builtin_amdgcn_s_barrier()
#define PG8_SCHED __builtin_amdgcn_sched_barrier(0)
    Unit cur, nxt; int ui = 0;
    if (!S.next(0, cur)) return;
    f32x4 acc[2][2][4][2];
#pragma unroll
    for (int a = 0; a < 2; ++a)
#pragma unroll
        for (int b = 0; b < 2; ++b)
#pragma unroll
            for (int m = 0; m < 4; ++m)
#pragma unroll
                for (int n = 0; n < 2; ++n) acc[a][b][m][n] = (f32x4){0.f, 0.f, 0.f, 0.f};
    bf16x8 At[4][2], B0[2][2], B1[2][2];
    const char* cA = (const char*)g.A + (size_t)cur.pm * tstep; const char* cB = (const char*)g.Bt + (size_t)cur.pn * tstep;
    S.a_ready(cur);
    PG8_STAGE(PG8_SB(0, 0), cB, voffB); PG8_STAGE(PG8_SA(0, 0), cA, voffA); PG8_STAGE(PG8_SB(0, 1), cB + hstep, voffB); PG8_STAGE(PG8_SA(0, 1), cA + hstep, voffA);
    if (wr == 1) PG8_BAR;
    PG8_WAIT_V(4); PG8_BAR;
    PG8_STAGE(PG8_SB(1, 0), cB + kstep, voffB); PG8_STAGE(PG8_SA(1, 0), cA + kstep, voffA); PG8_STAGE(PG8_SB(1, 1), cB + hstep + kstep, voffB);
    PG8_WAIT_V(6); PG8_BAR;
    PG8_STAMP();
    for (;;) {
        const bool has_next = S.next(ui + 1, nxt);
        const char* nA = has_next ? (const char*)g.A + (size_t)nxt.pm * tstep : cA; const char* nB = has_next ? (const char*)g.Bt + (size_t)nxt.pn * tstep : cB;
        for (int t = 0; t < nt; t += 2) {
            const bool last = (t == nt - 2);
            const char* a1 = cA + (size_t)(t + 1) * kstep;
            const char* a2 = last ? nA : cA + (size_t)(t + 2) * kstep; const char* b2 = last ? nB : cB + (size_t)(t + 2) * kstep;
            const char* a3 = a2 + kstep; const char* b3 = b2 + kstep;
            if (last && has_next) S.a_ready(nxt);
            PG8_LDB(B0, 0, 0); PG8_SCHED; PG8_LDA(At, 0, 0); PG8_STAGE(PG8_SA(1, 1), a1 + hstep, voffA);
            PG8_WAIT_L(8); PG8_BAR; PG8_WAIT_L(0); PG8_MMA(0, 0, At, B0); PG8_BAR; PG8_SCHED;
            PG8_LDB(B1, 0, 1); PG8_STAGE(PG8_SB(0, 0), b2, voffB);
            PG8_BAR; PG8_WAIT_L(0); PG8_MMA(0, 1, At, B1); PG8_BAR;
            PG8_LDA(At, 0, 1); PG8_STAGE(PG8_SA(0, 0), a2, voffA);
            PG8_BAR; PG8_WAIT_L(0); PG8_MMA(1, 0, At, B0); PG8_BAR; PG8_SCHED;
            PG8_STAGE(PG8_SB(0, 1), b2 + hstep, voffB);
            PG8_WAIT_V(6); PG8_BAR; PG8_MMA(1, 1, At, B1); PG8_BAR;
            PG8_LDB(B0, 1, 0); PG8_SCHED; PG8_LDA(At, 1, 0); PG8_STAGE(PG8_SA(0, 1), a2 + hstep, voffA);
            PG8_WAIT_L(8); PG8_BAR; PG8_WAIT_L(0); PG8_MMA(0, 0, At, B0); PG8_BAR; PG8_SCHED;
            PG8_LDB(B1, 1, 1); PG8_STAGE(PG8_SB(1, 0), b3, voffB);
            PG8_BAR; PG8_WAIT_L(0); PG8_MMA(0, 1, At, B1); PG8_BAR;
            PG8_LDA(At, 1, 1); PG8_STAGE(PG8_SA(1, 0), a3, voffA);
            PG8_BAR; PG8_WAIT_L(0); PG8_MMA(1, 0, At, B0); PG8_BAR; PG8_SCHED;
            PG8_STAGE(PG8_SB(1, 1), b3 + hstep, voffB);
            PG8_WAIT_V(6); PG8_BAR; PG8_MMA(1, 1, At, B1); PG8_BAR;
        }
        PG8_STAMP();
        if constexpr (!Epi::AFTER_DRAIN) { E(acc, cur, wr, wc, fr, fq); S.done(cur); }
        PG8_STAMP();
        if (!has_next) break;
#pragma unroll
        for (int a = 0; a < 2; ++a)
#pragma unroll
            for (int b = 0; b < 2; ++b)
#pragma unroll
                for (int m = 0; m < 4; ++m)
#pragma unroll
                    for (int n = 0; n < 2; ++n) acc[a][b][m][n] = (f32x4){0.f, 0.f, 0.f, 0.f};
        cur = nxt; cA = nA; cB = nB; ++ui;
    }
    PG8_WAIT_V(0);
    if (wr == 0) PG8_BAR;
    PG8_BAR;
    if constexpr (Epi::AFTER_DRAIN) { E.fused(acc, cur, wr, wc, fr, fq, lds, wid, lane); S.done(cur); }
    PG8_STAMP();
    if (STAMP && wid == 0) { stamps[lane] = lane < nts ? (((unsigned long long)(unsigned)ts_hi << 32) | (unsigned)ts_lo) : 0ull;
        if (lane == 62) stamps[62] = rt_entry; if (lane == 63) stamps[63] = (unsigned long long)wall_clock64(); }
#undef PG8_STAMP
#undef PG8_SA
#undef PG8_SB
#undef PG8_STAGE
#undef PG8_LDA
#undef PG8_LDB
#undef PG8_MMA
#undef PG8_WAIT_V
#undef PG8_WAIT_L
#undef PG8_BAR
#undef PG8_SCHED
}
}
#define XB_TMO      128
#define XB_XCNT(j)  (256  + 64 * (j))
#define XB_XSUB(j)  (1280 + 64 * (j))
#define XB_XGEN(j)  (2304 + 64 * (j))
#define XB_TOP      3328
#define XB_TOPGEN   3392
#define XCD_BAR_WORDS 3456
#define XB_SPIN_CAP (1u << 18)
#define LAS __attribute__((address_space(3)))

__device__ __forceinline__ unsigned xb_ld(unsigned* p)              { return __hip_atomic_load(p, __ATOMIC_RELAXED, __HIP_MEMORY_SCOPE_AGENT); }
__device__ __forceinline__ unsigned xb_add(unsigned* p, unsigned v) { return __hip_atomic_fetch_add(p, v, __ATOMIC_RELAXED, __HIP_MEMORY_SCOPE_AGENT); }
__device__ __forceinline__ unsigned xb_xcc_id() { return (unsigned)__builtin_amdgcn_s_getreg((3 << 11) | 20) & 0xFu; }
#define XB_SPIN(cond, bar) do { unsigned _sp = 0; while (cond) { __builtin_amdgcn_s_sleep(1); \
    if ((++_sp & 255u) == 0u) { if (xb_ld(&(bar)[XB_TMO])) break; if (_sp > XB_SPIN_CAP) { atomicAdd(&(bar)[XB_TMO], 1u); break; } } } } while (0)

struct XcdBarrier {
    unsigned* bar; unsigned x;
    volatile LAS unsigned* st;
};

__device__ __forceinline__ XcdBarrier xcd_barrier_post(unsigned* bar, volatile LAS unsigned* st) {
    XcdBarrier b; b.bar = bar; b.x = xb_xcc_id(); b.st = st;
    if (threadIdx.x == 0) (void)xb_add(&bar[XB_XCNT(b.x)], 1u);
    return b;
}
__device__ __forceinline__ void xcd_barrier_complete(unsigned* bar, unsigned x, unsigned& nloc, unsigned& nx) {
    const unsigned G = gridDim.x * gridDim.y * gridDim.z;
    unsigned sum, cnt, mine, sp = 0u;
    for (;;) {
        sum = 0u; cnt = 0u; mine = 0u;
#pragma unroll
        for (unsigned j = 0; j < 16; ++j) { const unsigned c = xb_ld(&bar[XB_XCNT(j)]); sum += c; cnt += (c > 0u) ? 1u : 0u; mine = (j == x) ? c : mine; }
        if (sum == G) break;
        __builtin_amdgcn_s_sleep(1);
        if ((++sp & 255u) == 0u) { if (xb_ld(&bar[XB_TMO])) break; if (sp > XB_SPIN_CAP) { atomicAdd(&bar[XB_TMO], 1u); break; } }
    }
    nloc = mine > 0u ? mine : 1u; nx = cnt > 0u ? cnt : 1u;
}

__device__ __forceinline__ void xcd_barrier(const XcdBarrier& b) {
    asm volatile("s_waitcnt vmcnt(0)" ::: "memory");
    __syncthreads();
    if (threadIdx.x == 0) {
        unsigned* bar = b.bar;
        __builtin_amdgcn_s_waitcnt(0);
        unsigned nloc = b.st[0], nx = b.st[1];
        if (nloc == 0u) { xcd_barrier_complete(bar, b.x, nloc, nx); b.st[0] = nloc; b.st[1] = nx; }
        const unsigned old = xb_add(&bar[XB_XSUB(b.x)], 1u);
        const unsigned gen = old / nloc;
        if (old + 1u == (gen + 1u) * nloc) {
            __builtin_amdgcn_fence(__ATOMIC_RELEASE, "agent");
            asm volatile("s_waitcnt vmcnt(0)" ::: "memory");
            const unsigned og = xb_add(&bar[XB_TOP], 1u);
            const unsigned tg = og / nx;
            if (og + 1u == (tg + 1u) * nx) xb_add(&bar[XB_TOPGEN], 1u);
            else XB_SPIN(xb_ld(&bar[XB_TOPGEN]) == tg, bar);
            __builtin_amdgcn_fence(__ATOMIC_ACQUIRE, "agent");
            xb_add(&bar[XB_XGEN(b.x)], 1u);
            asm volatile("s_waitcnt vmcnt(0)" ::: "memory");
        } else {
            XB_SPIN(xb_ld(&bar[XB_XGEN(b.x)]) == gen, bar);
            __builtin_amdgcn_fence(__ATOMIC_ACQUIRE, "agent");
            asm volatile("s_waitcnt vmcnt(0)" ::: "memory");
        }
    }
    __syncthreads();
}
namespace mk {
#define LAS __attribute__((address_space(3)))
typedef unsigned short bf16_t;
typedef short bf16x8 __attribute__((ext_vector_type(8)));
typedef short s16x4 __attribute__((ext_vector_type(4)));
typedef float f32x16 __attribute__((ext_vector_type(16)));
typedef float f32x4 __attribute__((ext_vector_type(4)));
typedef unsigned u32x4 __attribute__((ext_vector_type(4)));
typedef unsigned u32x2 __attribute__((ext_vector_type(2)));

constexpr int BATCH = 8, SEQ = 2048, DM = 2048, MTOK = BATCH * SEQ, NIN = 6149, NQKV = 6144, DFF = 5632, NGU = 2 * DFF, HD = 128, NTHR = 512;
constexpr float EPS = 1e-6f;
constexpr float LOG2E = 1.4426950408889634f;
constexpr float C2 = 0.08838834764831845f * LOG2E;
constexpr int LDS_STAGE = 131072, LDS_BYTES = LDS_STAGE + 16;

constexpr size_t SZ_WIN = (size_t)NQKV * DM * 2, SZ_WO = (size_t)DM * DM * 2, SZ_WGU = (size_t)NGU * DM * 2, SZ_WD = (size_t)DM * DFF * 2, SZ_WL = SZ_WIN + SZ_WO + SZ_WGU + SZ_WD;
constexpr size_t WS_W = 0;
constexpr size_t WS_ABUF = WS_W + 2 * SZ_WL, SZ_ABUF = (size_t)MTOK * DM * 2;
constexpr size_t WS_PROJ = WS_ABUF + SZ_ABUF, SZ_PROJ = (size_t)MTOK * NQKV * 2;
constexpr size_t WS_HALO = WS_PROJ + SZ_PROJ, SZ_HALO = (size_t)(MTOK / 64) * 4 * NGU * 4;
constexpr size_t WS_H = WS_HALO + SZ_HALO, SZ_H = (size_t)MTOK * DFF * 2;
constexpr size_t WS_FC = WS_H + SZ_H, SZ_FC = (size_t)MTOK * 8 * 4;
constexpr size_t WS_CTR = WS_FC + SZ_FC, WS_BAR = WS_CTR + 256, WS_RSS = WS_BAR + 3456 * 4, WS_KN = WS_RSS + (size_t)4 * MTOK * 4, WS_END = WS_KN + (size_t)2 * MTOK * 16 * 4;

struct Params { const float *x, *g_mix, *w_in, *b_f, *g_head, *w_o, *g_ffn, *w_gu, *conv_w, *conv_b, *w_down, *g_final; float* out; unsigned char* ws; int ph_lo, ph_hi; };

__device__ __forceinline__ unsigned cvtpk(float lo, float hi) { unsigned r; asm volatile("v_cvt_pk_bf16_f32 %0, %1, %2" : "=v"(r) : "v"(lo), "v"(hi)); return r; }

struct CvTile { const float* src; bf16_t* dst; const float* gk; int ldn, K; };
constexpr int CV_PER_LAYER = 3072 + 1024 + 5632 + 2816, CV_TOTAL = 2 * CV_PER_LAYER;
__device__ __forceinline__ CvTile cv_decode(const Params& p, unsigned char* ws, int g) {
    const int l2 = g / CV_PER_LAYER, r = g - l2 * CV_PER_LAYER;
    unsigned char* wl = ws + WS_W + (size_t)l2 * SZ_WL;
    CvTile t; t.gk = nullptr; int ntn, lt; const float* W; bf16_t* Bt; bool gup = false;
    if (r < 3072) { lt = r; ntn = NQKV / 64; W = p.w_in + (size_t)l2 * DM * NIN; t.ldn = NIN; t.K = DM; Bt = (bf16_t*)wl; }
    else if (r < 4096) { lt = r - 3072; ntn = DM / 64; W = p.w_o + (size_t)l2 * DM * DM; t.ldn = DM; t.K = DM; Bt = (bf16_t*)(wl + SZ_WIN); }
    else if (r < 9728) { lt = r - 4096; ntn = NGU / 64; W = p.w_gu + (size_t)l2 * DM * NGU; t.ldn = NGU; t.K = DM; Bt = (bf16_t*)(wl + SZ_WIN + SZ_WO); gup = true; t.gk = p.g_ffn + l2 * DM; }
    else { lt = r - 9728; ntn = DM / 64; W = p.w_down + (size_t)l2 * DFF * DM; t.ldn = DM; t.K = DFF; Bt = (bf16_t*)(wl + SZ_WIN + SZ_WO + SZ_WGU); }
    const int tn = lt % ntn, tk = lt / ntn, k0 = tk * 64, n0 = tn * 64;
    const int nd0 = !gup ? n0 : (n0 < DFF ? (n0 >> 7) * 256 + (n0 & 127) : ((n0 - DFF) >> 7) * 256 + 128 + ((n0 - DFF) & 127));
    t.src = W + (size_t)k0 * t.ldn + n0; t.dst = Bt + (size_t)nd0 * t.K + k0; if (t.gk) t.gk += k0;
    return t;
}
constexpr int CVN = 3;
__device__ __forceinline__ void convert_weights(const Params& p, unsigned char* ws, LAS float* tile) {
    int tid_l = threadIdx.x; asm volatile("" : "+v"(tid_l)); const int tid = tid_l, G = gridDim.x;
    const int kk = tid >> 6, nn = tid & 63, n = tid >> 3, kc = (tid & 7) * 8;
    int g = blockIdx.x, it = 0;
    if (g >= CV_TOTAL) return;
    CvTile c[CVN]; bool has[CVN]; float v[CVN][8];
#pragma unroll
    for (int t = 0; t < CVN; ++t) { has[t] = g + t * G < CV_TOTAL; c[t] = cv_decode(p, ws, has[t] ? g + t * G : g);
#pragma unroll
        for (int i = 0; i < 8; ++i) v[t][i] = c[t].src[(size_t)(i * 8 + kk) * c[t].ldn + nn]; }
    for (;;) {
        const int gn = g + CVN * G; const bool more = gn < CV_TOTAL;
        CvTile cn[CVN]; bool hasn[CVN]; float w[CVN][8];
#pragma unroll
        for (int t = 0; t < CVN; ++t) { cn[t] = c[t]; hasn[t] = gn + t * G < CV_TOTAL; }
        if (more) {
#pragma unroll
            for (int t = 0; t < CVN; ++t) { cn[t] = cv_decode(p, ws, hasn[t] ? gn + t * G : gn);
#pragma unroll
                for (int i = 0; i < 8; ++i) w[t][i] = cn[t].src[(size_t)(i * 8 + kk) * cn[t].ldn + nn]; } }
        LAS float* tb = tile + ((it & 1) * CVN) * (64 * 65);
#pragma unroll
        for (int t = 0; t < CVN; ++t) {
            if (c[t].gk) {
#pragma unroll
                for (int i = 0; i < 8; ++i) v[t][i] *= c[t].gk[i * 8 + kk]; }
#pragma unroll
            for (int i = 0; i < 8; ++i) tb[t * (64 * 65) + (i * 8 + kk) * 65 + nn] = v[t][i]; }
        __syncthreads();
#pragma unroll
        for (int t = 0; t < CVN; ++t) if (has[t]) { float f[8];
#pragma unroll
            for (int j = 0; j < 8; ++j) f[j] = tb[t * (64 * 65) + (kc + j) * 65 + n];
            u32x4 wv = {cvtpk(f[0], f[1]), cvtpk(f[2], f[3]), cvtpk(f[4], f[5]), cvtpk(f[6], f[7])};
            *(u32x4*)(c[t].dst + (size_t)n * c[t].K + kc) = wv; }
        if (!more) break;
#pragma unroll
        for (int t = 0; t < CVN; ++t) { c[t] = cn[t]; has[t] = hasn[t];
#pragma unroll
            for (int i = 0; i < 8; ++i) v[t][i] = w[t][i]; }
        g = gn; ++it;
    }
    __syncthreads();
}

template <bool FC, bool OUTF32>
__device__ __forceinline__ void norm_phase(const float* X, const float* __restrict__ g, bf16_t* hn, float* outf,
                                           const float* __restrict__ w_in_l, float* __restrict__ fcbuf, LAS float* wfc) {
    int tid_l = threadIdx.x; asm volatile("" : "+v"(tid_l)); const int tid = tid_l, wid = tid >> 6, lane = tid & 63;
    if (FC) { for (int i = tid; i < 5 * DM; i += NTHR) { const int d = i / 5, j = i - d * 5; wfc[j * DM + d] = w_in_l[(size_t)d * NIN + NQKV + j]; } __syncthreads(); }
    for (int row = blockIdx.x * 8 + wid; row < MTOK; row += gridDim.x * 8) {
        const float* xr = X + (size_t)row * DM;
        f32x4 v[8];
#pragma unroll
        for (int i = 0; i < 8; ++i) v[i] = *(const f32x4*)(xr + (i * 64 + lane) * 4);
        float ss = 0.f;
#pragma unroll
        for (int i = 0; i < 8; ++i) ss += v[i][0] * v[i][0] + v[i][1] * v[i][1] + v[i][2] * v[i][2] + v[i][3] * v[i][3];
#pragma unroll
        for (int o = 32; o >= 1; o >>= 1) ss += __shfl_xor(ss, o);
        const float rs = 1.0f / sqrtf(ss * (1.0f / DM) + EPS);
        float fc0 = 0.f, fc1 = 0.f, fc2 = 0.f, fc3 = 0.f, fc4 = 0.f;
#pragma unroll
        for (int i = 0; i < 8; ++i) {
            const int d = (i * 64 + lane) * 4;
            const f32x4 gv = *(const f32x4*)(g + d);
            const f32x4 y = v[i] * rs * gv;
            if (OUTF32) *(f32x4*)(outf + (size_t)row * DM + d) = y;
            else { u32x2 w = {cvtpk(y[0], y[1]), cvtpk(y[2], y[3])}; *(u32x2*)(hn + (size_t)row * DM + d) = w; }
            if (FC) {
                const f32x4 w0 = *(const LAS f32x4*)(wfc + 0 * DM + d), w1 = *(const LAS f32x4*)(wfc + 1 * DM + d), w2 = *(const LAS f32x4*)(wfc + 2 * DM + d),
                            w3 = *(const LAS f32x4*)(wfc + 3 * DM + d), w4 = *(const LAS f32x4*)(wfc + 4 * DM + d);
                fc0 += y[0] * w0[0] + y[1] * w0[1] + y[2] * w0[2] + y[3] * w0[3];
                fc1 += y[0] * w1[0] + y[1] * w1[1] + y[2] * w1[2] + y[3] * w1[3];
                fc2 += y[0] * w2[0] + y[1] * w2[1] + y[2] * w2[2] + y[3] * w2[3];
                fc3 += y[0] * w3[0] + y[1] * w3[1] + y[2] * w3[2] + y[3] * w3[3];
                fc4 += y[0] * w4[0] + y[1] * w4[1] + y[2] * w4[2] + y[3] * w4[3];
            }
        }
        if (FC) {
#pragma unroll
            for (int o = 32; o >= 1; o >>= 1) { fc0 += __shfl_xor(fc0, o); fc1 += __shfl_xor(fc1, o); fc2 += __shfl_xor(fc2, o); fc3 += __shfl_xor(fc3, o); fc4 += __shfl_xor(fc4, o); }
            if (lane == 0) { float* f = fcbuf + (size_t)row * 8; f[0] = fc0; f[1] = fc1; f[2] = fc2; f[3] = fc3; f[4] = fc4; }
        }
    }
}

__device__ __forceinline__ void fixup_phase(const float* __restrict__ halo, bf16_t* __restrict__ h, const float* __restrict__ cw, const float* __restrict__ cb) {
    constexpr int NCG = DFF / 4, NCHUNK = MTOK / 64;
    const int total = NCG * NCHUNK * 2;
    for (int u = blockIdx.x * NTHR + threadIdx.x; u < total; u += gridDim.x * NTHR) {
        const int cgi = u % NCG, rs = u / NCG, slot = rs & 1, chunk = rs >> 1, j = cgi * 4;
        const bool seq0 = (chunk & 31) == 0;
        const f32x4 z = {0.f, 0.f, 0.f, 0.f};
        const float* hc = halo + (size_t)chunk * 4 * NGU + j; const float* hp = hc - (size_t)4 * NGU;
        f32x4 g0, g1, g2, u0, u1, u2;
        if (slot == 0) { g0 = *(const f32x4*)(hc); u0 = *(const f32x4*)(hc + DFF);
            g1 = seq0 ? z : *(const f32x4*)(hp + 3 * NGU); u1 = seq0 ? z : *(const f32x4*)(hp + 3 * NGU + DFF);
            g2 = seq0 ? z : *(const f32x4*)(hp + 2 * NGU); u2 = seq0 ? z : *(const f32x4*)(hp + 2 * NGU + DFF); }
        else { g0 = *(const f32x4*)(hc + NGU); u0 = *(const f32x4*)(hc + NGU + DFF);
            g1 = *(const f32x4*)(hc); u1 = *(const f32x4*)(hc + DFF);
            g2 = seq0 ? z : *(const f32x4*)(hp + 3 * NGU); u2 = seq0 ? z : *(const f32x4*)(hp + 3 * NGU + DFF); }
        const f32x4 wg0 = *(const f32x4*)(cw + j), wg1 = *(const f32x4*)(cw + NGU + j), wg2 = *(const f32x4*)(cw + 2 * NGU + j);
        const f32x4 wu0 = *(const f32x4*)(cw + DFF + j), wu1 = *(const f32x4*)(cw + NGU + DFF + j), wu2 = *(const f32x4*)(cw + 2 * NGU + DFF + j);
        const f32x4 bg = *(const f32x4*)(cb + j), bu = *(const f32x4*)(cb + DFF + j);
        float hv[4];
#pragma unroll
        for (int e = 0; e < 4; ++e) { const float G = bg[e] + wg0[e] * g2[e] + wg1[e] * g1[e] + wg2[e] * g0[e]; const float U = bu[e] + wu0[e] * u2[e] + wu1[e] * u1[e] + wu2[e] * u0[e];
            hv[e] = G / (1.0f + __expf(-G)) * U; }
        u32x2 w = {cvtpk(hv[0], hv[1]), cvtpk(hv[2], hv[3])};
        *(u32x2*)(h + (size_t)(chunk * 64 + slot) * DFF + j) = w;
    }
}

constexpr int SHM_K = 16384, SHM_V = 16384;
constexpr int AT_WS = 65536, AT_TAB = AT_WS + 2048, AT_ITEM = AT_TAB + 9216;
#define KSWZ(row, colB) ((row) * 256 + ((colB) ^ (((row) & 7) << 4)))
#define SBAR() __builtin_amdgcn_sched_barrier(0)
__device__ __forceinline__ int v_st(int k, int c) { const int kk = (k & ~0xC) | ((k & 4) << 1) | ((k & 8) >> 1); return ((kk >> 3) * 4 + (c >> 5)) * 512 + ((kk & 7) * 32 + (c & 31)) * 2; }
__device__ __forceinline__ int v_rd_base(int lane) { return ((lane & 3) << 3) | (((lane >> 2) & 3) << 6) | (((lane >> 4) & 1) << 5) | (((lane >> 5) & 1) << 8); }
constexpr int v_rd_off(int d0, int ks, int half) { return d0 * 512 + ks * 4096 + half * 2048; }
__device__ __forceinline__ int crow(int r, int hi) { return (r & 3) + 8 * (r >> 2) + 4 * hi; }
__device__ __forceinline__ float pl32_max(float x) { auto rr = __builtin_amdgcn_permlane32_swap(__float_as_uint(x), __float_as_uint(x), false, false); return fmaxf(__uint_as_float(rr[0]), __uint_as_float(rr[1])); }
__device__ __forceinline__ float pl32_sum(float x) { auto rr = __builtin_amdgcn_permlane32_swap(__float_as_uint(x), __float_as_uint(x), false, false); return __uint_as_float(rr[0]) + __uint_as_float(rr[1]); }
__device__ __forceinline__ float pl32_other(float x, int hi) { auto rr = __builtin_amdgcn_permlane32_swap(__float_as_uint(x), __float_as_uint(x), false, false); return __uint_as_float(hi ? rr[0] : rr[1]); }

__device__ __forceinline__ void qkt(f32x16& p0, f32x16& p1, const LAS char* Kb, int r32, int hi, const bf16x8* qr) {
    p0 = f32x16{}; p1 = f32x16{};
    const LAS char* kb[4];
#pragma unroll
    for (int dd = 0; dd < 4; ++dd) kb[dd] = Kb + KSWZ(r32, (dd * 16 + hi * 8) * 2);
    __builtin_amdgcn_s_setprio(1);
#pragma unroll
    for (int d0 = 0; d0 < 8; ++d0) { const LAS char* a = kb[d0 & 3] + (d0 >> 2) * 128;
        bf16x8 b0 = *reinterpret_cast<const LAS bf16x8*>(a);
        bf16x8 b1 = *reinterpret_cast<const LAS bf16x8*>(a + 32 * 256);
        p0 = __builtin_amdgcn_mfma_f32_32x32x16_bf16(b0, qr[d0], p0, 0, 0, 0);
        p1 = __builtin_amdgcn_mfma_f32_32x32x16_bf16(b1, qr[d0], p1, 0, 0, 0); }
    __builtin_amdgcn_s_setprio(0);
}
__device__ __forceinline__ void pv_tile(f32x16* o, int vb0, bf16x8 pa0, bf16x8 pa1, bf16x8 pa2, bf16x8 pa3) {
#define TRRD(dst, off) asm volatile("ds_read_b64_tr_b16 %0, %1 offset:%2" : "=&v"(dst) : "v"(vb0), "i"(off) : "memory")
#define PV_D0(d0) do { s16x4 l0, l1, l2, l3, h0, h1, h2, h3; constexpr int b_ = v_rd_off(d0, 0, 0); \
        TRRD(l0, b_); TRRD(h0, b_ + 2048); TRRD(l1, b_ + 4096); TRRD(h1, b_ + 6144); TRRD(l2, b_ + 8192); TRRD(h2, b_ + 10240); TRRD(l3, b_ + 12288); TRRD(h3, b_ + 14336); \
        asm volatile("s_waitcnt lgkmcnt(0)" ::: "memory"); SBAR(); \
        o[d0] = __builtin_amdgcn_mfma_f32_32x32x16_bf16(pa0, (bf16x8){l0[0], l0[1], l0[2], l0[3], h0[0], h0[1], h0[2], h0[3]}, o[d0], 0, 0, 0); \
        o[d0] = __builtin_amdgcn_mfma_f32_32x32x16_bf16(pa1, (bf16x8){l1[0], l1[1], l1[2], l1[3], h1[0], h1[1], h1[2], h1[3]}, o[d0], 0, 0, 0); \
        o[d0] = __builtin_amdgcn_mfma_f32_32x32x16_bf16(pa2, (bf16x8){l2[0], l2[1], l2[2], l2[3], h2[0], h2[1], h2[2], h2[3]}, o[d0], 0, 0, 0); \
        o[d0] = __builtin_amdgcn_mfma_f32_32x32x16_bf16(pa3, (bf16x8){l3[0], l3[1], l3[2], l3[3], h3[0], h3[1], h3[2], h3[3]}, o[d0], 0, 0, 0); } while (0)
    __builtin_amdgcn_s_setprio(1);
    PV_D0(0); PV_D0(1); PV_D0(2); PV_D0(3);
    __builtin_amdgcn_s_setprio(0);
#undef PV_D0
#undef TRRD
}
#define PK4(P, B_, OUT) do { unsigned a0 = cvtpk(P[B_+0], P[B_+1]), a1 = cvtpk(P[B_+2], P[B_+3]); \
        unsigned b0 = cvtpk(P[B_+4], P[B_+5]), b1 = cvtpk(P[B_+6], P[B_+7]); \
        auto r0 = __builtin_amdgcn_permlane32_swap(a0, b0, false, false); auto r1 = __builtin_amdgcn_permlane32_swap(a1, b1, false, false); \
        u32x4 w = {r0[0], r1[0], r0[1], r1[1]}; OUT = *reinterpret_cast<bf16x8*>(&w); } while (0)

template <int TYPE>
__device__ __forceinline__ void attn_item(const bf16_t* __restrict__ proj, bf16_t* __restrict__ obuf, const float* __restrict__ fcbuf, const float* __restrict__ bf_l,
                                          const float* __restrict__ ghead_l, const float* __restrict__ kn, int b, int hl, int qb, LAS char* lds) {
    int tid_l = threadIdx.x; asm volatile("" : "+v"(tid_l)); const int tid = tid_l, wid = __builtin_amdgcn_readfirstlane(tid >> 6), lane = tid & 63, r32 = lane & 31, hi = lane >> 5;
    constexpr int LD = NQKV;
    constexpr int QC = TYPE == 0 ? 0 : (TYPE == 1 ? 2304 : 4224), KC = TYPE == 0 ? 768 : (TYPE == 1 ? 2944 : 4864), VC = TYPE == 0 ? 1536 : (TYPE == 1 ? 3584 : 5504);
    constexpr int HOFF = TYPE == 0 ? 0 : (TYPE == 1 ? 6 : 11);
    const int q0 = qb * 256, qlo = q0 + wid * 32, NT = 4 * (qb + 1);
    const bf16_t* Qp = proj + (size_t)(b * SEQ + qlo + r32) * LD + QC + hl * HD;
    const bf16_t* Kp = proj + (size_t)(b * SEQ) * LD + KC + hl * HD;
    const bf16_t* Vp = proj + (size_t)(b * SEQ) * LD + VC + hl * HD;
    LAS char* V_lds = lds; LAS char* K_lds = lds + 2 * SHM_V;
    LAS float* wsf = (LAS float*)(lds + AT_WS) + wid * 64;
    LAS float* tab = (LAS float*)(lds + AT_TAB);
    LAS int* dflag = (LAS int*)(lds + AT_ITEM + 16);
    const float NEGINF = -__builtin_inff();

    const float slope2 = exp2f(-8.0f * (float)(hl + 1) / 6.0f) * LOG2E;
    float kmax2 = 0.f;
    if (TYPE != 1) {
        LAS float* kred = (LAS float*)(lds + AT_ITEM + 128);
        float mx = 0.f;
        for (int s_ = tid; s_ < q0 + 256; s_ += NTHR) mx = fmaxf(mx, kn[(size_t)(b * SEQ + s_) * 16 + HOFF + hl]);
#pragma unroll
        for (int o_ = 32; o_ >= 1; o_ >>= 1) mx = fmaxf(mx, __shfl_xor(mx, o_));
        if (lane == 0) kred[wid] = mx;
        __syncthreads();
#pragma unroll
        for (int w = 0; w < 8; ++w) kmax2 = fmaxf(kmax2, kred[w]);
    }
    if (TYPE == 0) {
        for (int i = tid; i < 2304; i += NTHR) { const int d = i - 256; float v = NEGINF;
            if (d >= 0) { const int m = (d <= 128 ? 1 : 0) + (((d & 3) == 0 && d <= 512) ? 1 : 0) + ((d & 15) == 0 ? 1 : 0);
                if (m > 0) v = -slope2 * (float)d + (m == 1 ? 0.f : (m == 2 ? 1.0f : 1.5849625007211562f)); }
            tab[i] = v; }
    }
    if (TYPE == 2) {
        const float bf = bf_l[hl]; const int t0 = tid * 4; float lf[4];
#pragma unroll
        for (int j = 0; j < 4; ++j) { const float x = fcbuf[(size_t)(b * SEQ + t0 + j) * 8 + hl] + bf; lf[j] = (fminf(x, 0.f) - log1pf(expf(-fabsf(x)))) * LOG2E; }
        lf[1] += lf[0]; lf[2] += lf[1]; lf[3] += lf[2];
        const float tot = lf[3]; float incl = tot;
#pragma unroll
        for (int o = 1; o < 64; o <<= 1) { const float t = __shfl_up(incl, o); if (lane >= o) incl += t; }
        LAS float* wsum = (LAS float*)(lds + AT_WS);
        if (lane == 63) wsum[wid] = incl;
        __syncthreads();
        float pre = 0.f;
        for (int w = 0; w < wid; ++w) pre += wsum[w];
        const float ex = incl - tot + pre;
#pragma unroll
        for (int j = 0; j < 4; ++j) tab[t0 + j] = ex + lf[j];
    }
    bf16x8 qr[8];
#pragma unroll
    for (int d0 = 0; d0 < 8; ++d0) qr[d0] = *(const bf16x8*)(Qp + d0 * 16 + hi * 8);
    float Bq = 0.f;
    if (TYPE != 1) { float qs = 0.f;
#pragma unroll
        for (int d0 = 0; d0 < 8; ++d0)
#pragma unroll
            for (int e_ = 0; e_ < 8; ++e_) { const float f = __uint_as_float(((unsigned)(unsigned short)qr[d0][e_]) << 16); qs += f * f; }
        qs = pl32_sum(qs);
        Bq = sqrtf(qs) * sqrtf(kmax2) * (1.02f * C2) + 0.5f; }
    const int sr = tid >> 4, sc = (tid & 15) * 8;
    const int kws = KSWZ(sr, sc * 2), vst0 = v_st(sr, sc), vst1 = v_st(32 + sr, sc);
#define TILE_KB(it_) ((NT - 1 - (it_)) * 64)
    bf16x8 st_k0, st_k1, st_v0, st_v1;
#define SLOAD(kb_) do { st_k0 = *(const bf16x8*)(Kp + (size_t)((kb_) + sr) * LD + sc); st_k1 = *(const bf16x8*)(Kp + (size_t)((kb_) + 32 + sr) * LD + sc); \
                        st_v0 = *(const bf16x8*)(Vp + (size_t)((kb_) + sr) * LD + sc); st_v1 = *(const bf16x8*)(Vp + (size_t)((kb_) + 32 + sr) * LD + sc); } while (0)
#define SWRITE(bf_) do { *(LAS bf16x8*)(K_lds + (bf_) * SHM_K + kws) = st_k0; *(LAS bf16x8*)(K_lds + (bf_) * SHM_K + kws + 32 * 256) = st_k1; \
                         *(LAS bf16x8*)(V_lds + (bf_) * SHM_V + vst0) = st_v0; *(LAS bf16x8*)(V_lds + (bf_) * SHM_V + vst1) = st_v1; } while (0)
    SLOAD(TILE_KB(0)); SWRITE(0);
    __syncthreads();
    const int vbase = (int)(unsigned)(uintptr_t)V_lds + v_rd_base(lane);
    float m_reg = -1e30f, l_reg = 0.f, Rc = 1.f;
    bool wdone = false;
    float cq2 = 0.f; if (TYPE == 2) cq2 = tab[qlo + r32];
    f32x16 o[4] = {};
    for (int it = 0; it < NT; ++it) {
        const int cur = it & 1, kbase = TILE_KB(it);
        if (it + 1 < NT) { const int kb2 = TILE_KB(it + 1); SLOAD(kb2); }
        const bool act = !wdone && ((TYPE == 1) ? (kbase <= qlo + 30) : (kbase <= qlo + 31));
        if (act) {
            f32x16 p0, p1;
            qkt(p0, p1, K_lds + cur * SHM_K, r32, hi, qr);
            const int dq = qlo + r32 - 4 * hi - kbase;
            bf16x8 pa0, pa1, pa2, pa3;
            if (TYPE != 1) {
                if (TYPE == 0) {
                    const LAS float* tb = tab + (dq + 256 - 63);
                    f32x16 bz0, bz1;
#pragma unroll
                    for (int r = 0; r < 16; ++r) { const int c = (r & 3) + 8 * (r >> 2); bz0[r] = tb[63 - c]; bz1[r] = tb[31 - c]; }
                    p0 = p0 * C2 + bz0; p1 = p1 * C2 + bz1;
                } else {
                    f32x16 kz0, kz1;
#pragma unroll
                    for (int g = 0; g < 4; ++g) { const f32x4 ck0 = *(const LAS f32x4*)(tab + kbase + 8 * g + 4 * hi), ck1 = *(const LAS f32x4*)(tab + kbase + 32 + 8 * g + 4 * hi);
#pragma unroll
                        for (int j = 0; j < 4; ++j) { kz0[4 * g + j] = ck0[j]; kz1[4 * g + j] = ck1[j]; } }
                    p0 = p0 * C2 + (cq2 - kz0); p1 = p1 * C2 + (cq2 - kz1);
                    if (kbase + 63 > qlo) {
#pragma unroll
                        for (int r = 0; r < 16; ++r) { const int c = (r & 3) + 8 * (r >> 2); if (dq - c < 0) p0[r] = NEGINF; if (dq - c - 32 < 0) p1[r] = NEGINF; }
                    }
                }
                float pmax = p0[0];
#pragma unroll
                for (int r = 1; r < 16; ++r) pmax = fmaxf(pmax, p0[r]);
#pragma unroll
                for (int r = 0; r < 16; ++r) pmax = fmaxf(pmax, p1[r]);
                pmax = pl32_max(pmax);
                float mn, alpha;
                if (__all((pmax - m_reg) <= 11.5f)) { mn = m_reg; alpha = 1.f; }
                else { mn = fmaxf(m_reg, pmax); alpha = __builtin_amdgcn_exp2f(m_reg - mn); m_reg = mn; }
                float ps = 0.f;
                { const float nm = -mn; f32x16 nmv; for (int r = 0; r < 16; ++r) nmv[r] = nm; p0 = p0 + nmv; p1 = p1 + nmv; }
#pragma unroll
                for (int r = 0; r < 16; ++r) { p0[r] = __builtin_amdgcn_exp2f(p0[r]); p1[r] = __builtin_amdgcn_exp2f(p1[r]); }
                { const f32x16 sv = p0 + p1; const f32x4 s4 = (f32x4){sv[0], sv[1], sv[2], sv[3]} + (f32x4){sv[4], sv[5], sv[6], sv[7]} + (f32x4){sv[8], sv[9], sv[10], sv[11]} + (f32x4){sv[12], sv[13], sv[14], sv[15]};
                  ps = (s4[0] + s4[1]) + (s4[2] + s4[3]); }
                ps = pl32_sum(ps);
                l_reg = l_reg * alpha + ps;
                if (__any(alpha < 1.f)) {
                    if (hi == 0) wsf[32 + r32] = alpha;
                    asm volatile("s_waitcnt lgkmcnt(0)" ::: "memory");
#pragma unroll
                    for (int r = 0; r < 16; ++r) { const float a = wsf[32 + crow(r, hi)];
#pragma unroll
                        for (int d_ = 0; d_ < 4; ++d_) o[d_][r] *= a; }
                }
            } else {
                f32x16 l0, l1;
                const bool diag = (kbase + 63 >= qlo);
#pragma unroll
                for (int r = 0; r < 16; ++r) { const int c = (r & 3) + 8 * (r >> 2);
                    float u0 = __builtin_amdgcn_rcpf(1.0f + __builtin_amdgcn_exp2f(p0[r] * C2));
                    float u1 = __builtin_amdgcn_rcpf(1.0f + __builtin_amdgcn_exp2f(p1[r] * C2));
                    float s0 = 1.0f - u0, s1 = 1.0f - u1;
                    if (diag) { if (dq - c <= 0) { u0 = 1.f; s0 = 0.f; } if (dq - c - 32 <= 0) { u1 = 1.f; s1 = 0.f; } }
                    p0[r] = s0; p1[r] = s1; l0[r] = u0; l1[r] = u1; }
                float cs[2][4], pc[2][4];
#pragma unroll
                for (int g = 0; g < 4; ++g) { cs[0][g] = (l0[4 * g] * l0[4 * g + 1]) * (l0[4 * g + 2] * l0[4 * g + 3]); cs[1][g] = (l1[4 * g] * l1[4 * g + 1]) * (l1[4 * g + 2] * l1[4 * g + 3]); }
#pragma unroll
                for (int g = 0; g < 4; ++g) { pc[0][g] = pl32_other(cs[0][g], hi); pc[1][g] = pl32_other(cs[1][g], hi); }
                float run = Rc;
#pragma unroll
                for (int p = 1; p >= 0; --p)
#pragma unroll
                    for (int g = 3; g >= 0; --g) {
                        float acc = hi == 0 ? run * pc[p][g] : run;
                        run *= cs[p][g] * pc[p][g];
#pragma unroll
                        for (int j = 3; j >= 0; --j) { if (p == 0) { const float a = p0[4 * g + j] * acc; acc *= l0[4 * g + j]; p0[4 * g + j] = a; }
                                                       else { const float a = p1[4 * g + j] * acc; acc *= l1[4 * g + j]; p1[4 * g + j] = a; } }
                    }
                Rc = run;
            }
            PK4(p0, 0, pa0); PK4(p0, 8, pa1); PK4(p1, 0, pa2); PK4(p1, 8, pa3);
            pv_tile(o, vbase + cur * SHM_V, pa0, pa1, pa2, pa3);
        }
        if (it + 1 < NT) { SWRITE(cur ^ 1); }
        { bool drow;
          if (TYPE == 1) drow = Rc < 1e-30f;
          else {
              const float bmax = (TYPE == 0) ? (1.5849625f - slope2 * (float)(qlo + r32 - kbase + 1)) : (cq2 - tab[kbase > 0 ? kbase - 1 : 0]);
              drow = (Bq + bmax - m_reg) < -64.f; }
          const int dn = (wdone || __all(drow)) ? 1 : 0; wdone = dn != 0; if (lane == 0) dflag[(it & 1) * 8 + wid] = dn; }
        __syncthreads();
        { const LAS int* f = dflag + (it & 1) * 8; if ((f[0] & f[1] & f[2] & f[3] & f[4] & f[5] & f[6] & f[7]) != 0) break; }
    }
    float rli[16];
    if (TYPE != 1) {
        if (hi == 0) wsf[r32] = l_reg;
        asm volatile("s_waitcnt lgkmcnt(0)" ::: "memory");
#pragma unroll
        for (int r = 0; r < 16; ++r) rli[r] = 1.0f / wsf[crow(r, hi)];
    } else {
#pragma unroll
        for (int r = 0; r < 16; ++r) rli[r] = 1.0f;
    }
    float gh[4];
#pragma unroll
    for (int d0 = 0; d0 < 4; ++d0) gh[d0] = ghead_l[(HOFF + hl) * HD + d0 * 32 + r32];
    bf16_t* Ow = obuf + (size_t)(b * SEQ + qlo) * DM + (HOFF + hl) * HD;
#pragma unroll
    for (int r = 0; r < 16; ++r) {
        float v[4], ss = 0.f;
#pragma unroll
        for (int d0 = 0; d0 < 4; ++d0) { v[d0] = o[d0][r] * rli[r]; ss += v[d0] * v[d0]; }
        ss += __shfl_xor(ss, 1); ss += __shfl_xor(ss, 2); ss += __shfl_xor(ss, 4); ss += __shfl_xor(ss, 8); ss += __shfl_xor(ss, 16);
        const float scl = 1.0f / sqrtf(ss * (1.0f / HD) + EPS);
        const int orow = crow(r, hi);
#pragma unroll
        for (int d0 = 0; d0 < 4; ++d0) { const float y = v[d0] * scl * gh[d0]; const float yn = __shfl_xor(y, 1);
            if ((r32 & 1) == 0) *(unsigned*)(Ow + (size_t)orow * DM + d0 * 32 + r32) = cvtpk(y, yn); }
    }
    __syncthreads();
#undef TILE_KB
#undef SLOAD
#undef SWRITE
}

__device__ __forceinline__ void attn_phase(const bf16_t* proj, bf16_t* obuf, const float* fcbuf, const float* bf_l, const float* ghead_l, const float* kn, unsigned* ctr, LAS char* lds) {
    LAS int* item_s = (LAS int*)(lds + AT_ITEM);
    for (;;) {
        if (threadIdx.x == 0) *item_s = (int)atomicAdd(ctr, 1u);
        __syncthreads();
        const int i = *item_s;
        __syncthreads();
        if (i >= 1024) break;
        int qb, hh, b;
        if (i < 192) { qb = 7 - i / 24; const int r = i % 24; b = r / 3; hh = 3 + r % 3; }
        else if (i < 512) { const int j = i - 192; qb = 7 - j / 40; const int r = j % 40; b = r / 5; hh = 11 + r % 5; }
        else if (i < 704) { const int j = i - 512; qb = 7 - j / 24; const int r = j % 24; b = r / 3; hh = r % 3; }
        else { const int j = i - 704; qb = 7 - j / 40; const int r = j % 40; b = r / 5; hh = 6 + r % 5; }
        if (hh < 6) attn_item<0>(proj, obuf, fcbuf, bf_l, ghead_l, kn, b, hh, qb, lds);
        if (hh >= 6 && hh < 11) attn_item<1>(proj, obuf, fcbuf, bf_l, ghead_l, kn, b, hh - 6, qb, lds);
        if (hh >= 11) attn_item<2>(proj, obuf, fcbuf, bf_l, ghead_l, kn, b, hh - 11, qb, lds);
    }
}

__global__ void __launch_bounds__(NTHR) fwd(Params p) {
    extern __shared__ __attribute__((aligned(16))) unsigned char lds_raw[];
    LAS unsigned char* lds = (LAS unsigned char*)lds_raw;
    cg::grid_group grid = cg::this_grid();
    unsigned char* ws = p.ws;
    bf16_t* abuf = (bf16_t*)(ws + WS_ABUF); bf16_t* proj = (bf16_t*)(ws + WS_PROJ); bf16_t* hbuf = (bf16_t*)(ws + WS_H); float* halo = (float*)(ws + WS_HALO);
    float* fcbuf = (float*)(ws + WS_FC); unsigned* ctr = (unsigned*)(ws + WS_CTR); float* rss = (float*)(ws + WS_RSS); float* kn = (float*)(ws + WS_KN); bf16_t* xbf = proj;
    if (threadIdx.x < 4) ((LAS unsigned*)(lds + LDS_STAGE))[threadIdx.x] = 0u;
    __syncthreads();
    XcdBarrier xb; xb.bar = (unsigned*)(ws + WS_BAR); xb.x = xb_xcc_id(); xb.st = (volatile LAS unsigned*)(lds + LDS_STAGE);
    { unsigned* z = (unsigned*)(ws + WS_CTR); const size_t nz = (WS_END - WS_CTR) / 4;
      for (size_t i = (size_t)blockIdx.x * NTHR + threadIdx.x; i < nz; i += (size_t)gridDim.x * NTHR) z[i] = 0u; }
    int vc = blockIdx.x;
    int ph = 0;
#define PH_BEGIN if (ph >= p.ph_lo && ph < p.ph_hi) { if (ph > p.ph_lo) { if (ph == p.ph_lo + 1) { grid.sync(); \
            if (threadIdx.x == 0) xb.st[2] = xb_add(&xb.bar[XB_XCNT(xb.x)], 1u);     \
            __syncthreads(); } \
          else { xcd_barrier(xb); \
            if (ph == p.ph_lo + 2) { bool okc = true; for (int j = 0; j < 16; ++j) okc = okc && (xb_ld(&xb.bar[XB_XCNT(j)]) == (j < 8 ? 32u : 0u)); \
                if (okc) vc = 8 * (int)xb.st[2] + (int)xb.x; } } }
#define PH_END } ++ph;
    for (int l = 0; l < 2; ++l) {
        const float* xin = (l == 0) ? p.x : p.out;
        bf16_t* WinT = (bf16_t*)(ws + WS_W + (size_t)l * SZ_WL); bf16_t* WoT = (bf16_t*)((unsigned char*)WinT + SZ_WIN); bf16_t* WguT = (bf16_t*)((unsigned char*)WoT + SZ_WO); bf16_t* WdT = (bf16_t*)((unsigned char*)WguT + SZ_WGU);
        PH_BEGIN
            if (l == 0) {
                convert_weights(p, ws, (LAS float*)lds);
            }
            norm_phase<true, false>(xin, p.g_mix + l * DM, abuf, nullptr, p.w_in + (size_t)l * DM * NIN, fcbuf, (LAS float*)lds);
        PH_END
        PH_BEGIN
            pg8::Gemm g{abuf, WinT, MTOK, NQKV, DM}; pg8::StaticOrder S; S.init(MTOK, NQKV, gridDim.x, vc);
            pg8::EpiProj E{proj, NQKV, kn + (size_t)l * MTOK * 16};
            pg8::gemm_phase<pg8::EpiProj, pg8::StaticOrder>(lds, g, S, E, nullptr);
        PH_END
        PH_BEGIN
            attn_phase(proj, abuf, fcbuf, p.b_f + l * 5, p.g_head + l * DM, kn + (size_t)l * MTOK * 16, ctr + l * 16, (LAS char*)lds);
        PH_END
        PH_BEGIN
            pg8::Gemm g{abuf, WoT, MTOK, DM, DM}; pg8::StaticOrder S; S.init(MTOK, DM, gridDim.x, vc);
            pg8::EpiResN E{xin, p.out, xbf, rss + (size_t)l * MTOK, DM};
            pg8::gemm_phase<pg8::EpiResN, pg8::StaticOrder>(lds, g, S, E, nullptr);
        PH_END
        PH_BEGIN
            pg8::Gemm g{xbf, WguT, MTOK, NGU, DM}; pg8::StaticOrder S; S.init(MTOK, NGU, gridDim.x, vc);
            pg8::EpiConv E{hbuf, halo, p.conv_w + (size_t)l * 3 * NGU, p.conv_b + (size_t)l * NGU, DFF, rss + (size_t)l * MTOK, 1.0f / DM, EPS};
            pg8::gemm_phase<pg8::EpiConv, pg8::StaticOrder>(lds, g, S, E, nullptr);
        PH_END
        PH_BEGIN
            fixup_phase(halo, hbuf, p.conv_w + (size_t)l * 3 * NGU, p.conv_b + (size_t)l * NGU);
        PH_END
        PH_BEGIN
            pg8::Gemm g{hbuf, WdT, MTOK, DM, DFF}; pg8::StaticOrder S; S.init(MTOK, DM, gridDim.x, vc);
            pg8::EpiRes E{p.out, p.out, DM};
            pg8::gemm_phase<pg8::EpiRes, pg8::StaticOrder>(lds, g, S, E, nullptr);
        PH_END
    }
    PH_BEGIN
        norm_phase<false, true>(p.out, p.g_final, nullptr, p.out, nullptr, nullptr, (LAS float*)lds);
    PH_END
#undef PH_BEGIN
#undef PH_END
}
}

extern "C" void kernel_launch(void* const* d_in, const int* in_sizes, int n_in, void* d_out, int out_size, void* d_ws, size_t ws_size, hipStream_t stream) {
    static int grid_blocks = 0;
    if (!grid_blocks) {
        if (n_in != 12 || ws_size < mk::WS_END) { fprintf(stderr, "kernel_launch: unexpected n_in %d or ws_size %zu (< %zu)\n", n_in, ws_size, (size_t)mk::WS_END); grid_blocks = -1; return; }
        int dev = 0, cus = 0, per_cu = 0;
        (void)hipGetDevice(&dev);
        if (hipDeviceGetAttribute(&cus, hipDeviceAttributeMultiprocessorCount, dev) != hipSuccess || cus <= 0) cus = 256;
        if (hipFuncSetAttribute((const void*)mk::fwd, hipFuncAttributeMaxDynamicSharedMemorySize, mk::LDS_BYTES) != hipSuccess) fprintf(stderr, "kernel_launch: hipFuncSetAttribute failed\n");
        if (hipOccupancyMaxActiveBlocksPerMultiprocessor(&per_cu, (const void*)mk::fwd, mk::NTHR, mk::LDS_BYTES) != hipSuccess || per_cu < 1) { per_cu = 1; (void)hipGetLastError(); }
        grid_blocks = cus * per_cu;
    }
    if (grid_blocks < 0) return;
    mk::Params p{};
    p.x = (const float*)d_in[0]; p.g_mix = (const float*)d_in[1]; p.w_in = (const float*)d_in[2]; p.b_f = (const float*)d_in[3]; p.g_head = (const float*)d_in[4];
    p.w_o = (const float*)d_in[5]; p.g_ffn = (const float*)d_in[6]; p.w_gu = (const float*)d_in[7]; p.conv_w = (const float*)d_in[8]; p.conv_b = (const float*)d_in[9];
    p.w_down = (const float*)d_in[10]; p.g_final = (const float*)d_in[11];
    p.out = (float*)d_out; p.ws = (unsigned char*)d_ws; p.ph_lo = 0; p.ph_hi = 1000;
    void* args[] = {&p};
    hipError_t e = hipLaunchCooperativeKernel((void*)mk::fwd, dim3(grid_blocks), dim3(mk::NTHR), args, mk::LDS_BYTES, stream);
    if (e != hipSuccess) fprintf(stderr, "cooperative launch failed: %s (grid %d)\n", hipGetErrorString(e), grid_blocks);
}
```

```cpp
#include <hip/hip_runtime.h>
#include <hip/hip_cooperative_groups.h>
#include <cstdio>
#include <cstdint>
namespace cg = cooperative_groups;
namespace pg8 {
#define PG8_LAS __attribute__((address_space(3)))
typedef unsigned short bf16_t;
typedef short bf16x8 __attribute__((ext_vector_type(8)));
typedef float f32x4 __attribute__((ext_vector_type(4)));
typedef unsigned u32x4 __attribute__((ext_vector_type(4)));
constexpr int BM = 256, BK = 64, HALF = 128, HTB = HALF * BK * 2  , STAGE_BYTES = 8 * HTB, NXCD = 8, WGM = 8;

__host__ __device__ __forceinline__ int lds_byte(int r, int c) { const int st = (r >> 4) * 2 + (c >> 5), rr = r & 15, cc = c & 31, ob = rr * 64 + cc * 2; return st * 1024 + (ob ^ (((ob >> 9) & 1) << 5)); }
__host__ __device__ __forceinline__ void stage_rc(int b, int& R, int& C) { const int st = b / 1024, sb = b % 1024, swz = sb ^ (((sb >> 9) & 1) << 5); R = (st >> 1) * 16 + swz / 64; C = (st & 1) * 32 + (swz % 64) / 2; }
__host__ __device__ __forceinline__ int perm32(int rho) { const int n = rho >> 4, i = rho & 15; return 8 * (i >> 2) + 4 * n + (i & 3); }

struct Unit { int pm, pn; };
struct Gemm { const bf16_t* A; const bf16_t* Bt; int M, N, K; };

struct StaticOrder {
    int nM, nN, nwg, G, c;
    __host__ __device__ void init(int M, int N, int G_, int c_) { nM = M / BM; nN = N / BM; nwg = nM * nN; G = G_; c = c_; }
    __host__ __device__ __forceinline__ bool next(int i, Unit& u) const {
        const long L = (long)i * G + c; if (L >= nwg) return false;
        int wgid = (int)L; { const int q = nwg / NXCD, r = nwg % NXCD, xcd = wgid % NXCD, off = wgid / NXCD; wgid = (xcd < r ? xcd * (q + 1) : r * (q + 1) + (xcd - r) * q) + off; }
        const int nig = WGM * nN, gid = wgid / nig, fm = gid * WGM, gsz = (nM - fm) < WGM ? (nM - fm) : WGM;
        u.pm = fm + ((wgid % nig) % gsz); u.pn = (wgid % nig) / gsz; return true;
    }
    __device__ __forceinline__ void a_ready(const Unit&) const {}
    __device__ __forceinline__ void done(const Unit&) const {}
};
struct CountedOrder : StaticOrder {
    const unsigned* ready; unsigned need; unsigned* tmo;
    __device__ __forceinline__ void a_ready(const Unit& u) const {
        if (threadIdx.x < 64) {
            const unsigned long long t0 = __builtin_amdgcn_s_memrealtime(); unsigned polls = 0;
            while ((unsigned)__builtin_amdgcn_readfirstlane(__hip_atomic_load(ready + 64 * u.pm, __ATOMIC_RELAXED, __HIP_MEMORY_SCOPE_AGENT)) < need) {
                if ((++polls & 255u) == 0u && __builtin_amdgcn_readfirstlane(__hip_atomic_load(tmo, __ATOMIC_RELAXED, __HIP_MEMORY_SCOPE_AGENT)) != 0u) break;
                if (__builtin_amdgcn_s_memrealtime() - t0 > 2000000ull) {
                    if (threadIdx.x == 0) { unsigned expect = 0u; __hip_atomic_compare_exchange_strong(tmo + 1, &expect, 0x600u | (unsigned)(u.pm & 0xff), __ATOMIC_RELAXED, __ATOMIC_RELAXED, __HIP_MEMORY_SCOPE_AGENT); __hip_atomic_store(tmo, 1u, __ATOMIC_RELAXED, __HIP_MEMORY_SCOPE_AGENT); }
                    break; }
                __builtin_amdgcn_s_sleep(2); }
            __builtin_amdgcn_fence(__ATOMIC_ACQUIRE, "agent");
            asm volatile("s_waitcnt vmcnt(0)" ::: "memory");
        }
#if !defined(BROKEN_HOOK_NO_BARRIER)
        asm volatile("" ::: "memory"); __builtin_amdgcn_s_barrier(); asm volatile("" ::: "memory");
#endif
    }
};

__device__ __forceinline__ unsigned cvt_pk_bf16(float lo, float hi) { unsigned r; asm volatile("v_cvt_pk_bf16_f32 %0, %1, %2" : "=v"(r) : "v"(lo), "v"(hi)); return r; }
typedef float f32x2 __attribute__((ext_vector_type(2)));
__device__ __forceinline__ f32x2 gelu_pk(f32x2 v) {
    const f32x2 av = __builtin_elementwise_abs(v), d = av * 0.2316418882f + 1.0f;
    f32x2 t; t.x = __builtin_amdgcn_rcpf(d.x); t.y = __builtin_amdgcn_rcpf(d.y);
    f32x2 q = t * 0.5307027145f + (-0.7265760135f); q = q * t + 0.7107068705f; q = q * t + (-0.142248368f); q = q * t + 0.127414796f; q = q * t;
    const f32x2 s = (v * v) * (-0.72134752044f);
    f32x2 e; e.x = __builtin_amdgcn_exp2f(s.x); e.y = __builtin_amdgcn_exp2f(s.y);
    const f32x2 m = v * (q * e), r = v - m;
    f32x2 o; o.x = v.x < 0.f ? m.x : r.x; o.y = v.y < 0.f ? m.y : r.y; return o;
}

struct EpiF32 {
    static constexpr bool PERM = false, AFTER_DRAIN = false;
    float* C; int ldc; const float* bias;
    __device__ __forceinline__ void operator()(const f32x4 (&acc)[2][2][4][2], const Unit& u, int wr, int wc, int fr, int fq) const {
        const int row0 = u.pm * BM + wr * 64 + fr, col0 = u.pn * BM + wc * 32 + 4 * fq;
        f32x4 bv[2][2];
#pragma unroll
        for (int bj = 0; bj < 2; ++bj)
#pragma unroll
            for (int n = 0; n < 2; ++n) bv[bj][n] = bias ? *(const f32x4*)(bias + col0 + bj * HALF + n * 16) : (f32x4){0.f, 0.f, 0.f, 0.f};
#pragma unroll
        for (int ai = 0; ai < 2; ++ai)
#pragma unroll
            for (int m = 0; m < 4; ++m) { float* rowp = C + (size_t)(row0 + ai * HALF + m * 16) * ldc + col0;
#pragma unroll
                for (int bj = 0; bj < 2; ++bj)
#pragma unroll
                    for (int n = 0; n < 2; ++n) *(f32x4*)(rowp + bj * HALF + n * 16) = acc[ai][bj][m][n] + bv[bj][n]; }
    }
};
template <int ACT  > struct EpiBf16 {
    static constexpr bool PERM = true, AFTER_DRAIN = false;
    bf16_t* O; int ldc; const float* bias; int split_cols; size_t split_stride;
    __device__ __forceinline__ void operator()(const f32x4 (&acc)[2][2][4][2], const Unit& u, int wr, int wc, int fr, int fq) const {
        const int row0 = u.pm * BM + wr * 64 + fr; int colt = u.pn * BM; bf16_t* base = O;
        if (split_cols) { const int t = colt / split_cols; base += (size_t)t * split_stride; colt -= t * split_cols; }
        const int col0 = colt + wc * 32 + 8 * fq, bcol0 = u.pn * BM + wc * 32 + 8 * fq;
        f32x4 bv[2][2];
#pragma unroll
        for (int bj = 0; bj < 2; ++bj)
#pragma unroll
            for (int n = 0; n < 2; ++n) bv[bj][n] = bias ? *(const f32x4*)(bias + bcol0 + bj * HALF + 4 * n) : (f32x4){0.f, 0.f, 0.f, 0.f};
#pragma unroll
        for (int ai = 0; ai < 2; ++ai)
#pragma unroll
            for (int m = 0; m < 4; ++m) { bf16_t* rowp = base + (size_t)(row0 + ai * HALF + m * 16) * ldc + col0;
#pragma unroll
                for (int bj = 0; bj < 2; ++bj) { f32x4 v0 = acc[ai][bj][m][0] + bv[bj][0], v1 = acc[ai][bj][m][1] + bv[bj][1];
                    if (ACT == 1) { f32x2 a = gelu_pk((f32x2){v0[0], v0[1]}), b = gelu_pk((f32x2){v0[2], v0[3]}), c = gelu_pk((f32x2){v1[0], v1[1]}), d = gelu_pk((f32x2){v1[2], v1[3]});
                        v0 = (f32x4){a.x, a.y, b.x, b.y}; v1 = (f32x4){c.x, c.y, d.x, d.y}; }
                    if (ACT == 2) {
#pragma unroll
                        for (int j = 0; j < 4; ++j) { v0[j] = 0.5f * v0[j] * (1.0f + erff(v0[j] * 0.70710678f)); v1[j] = 0.5f * v1[j] * (1.0f + erff(v1[j] * 0.70710678f)); } }
                    u32x4 w; w.x = cvt_pk_bf16(v0[0], v0[1]); w.y = cvt_pk_bf16(v0[2], v0[3]); w.z = cvt_pk_bf16(v1[0], v1[1]); w.w = cvt_pk_bf16(v1[2], v1[3]);
                    *(u32x4*)(rowp + bj * HALF) = w; } }
    }
};
struct EpiRes {
    static constexpr bool PERM = false, AFTER_DRAIN = false;
    const float* base; float* out; int ldc;
    __device__ __forceinline__ void operator()(const f32x4 (&acc)[2][2][4][2], const Unit& u, int wr, int wc, int fr, int fq) const {
        const int row0 = u.pm * BM + wr * 64 + fr, col0 = u.pn * BM + wc * 32 + 4 * fq;
#pragma unroll
        for (int ai = 0; ai < 2; ++ai) {
            f32x4 bv[4][2][2];
#pragma unroll
            for (int m = 0; m < 4; ++m) { const size_t off = (size_t)(row0 + ai * HALF + m * 16) * ldc + col0;
#pragma unroll
                for (int bj = 0; bj < 2; ++bj)
#pragma unroll
                    for (int n = 0; n < 2; ++n) bv[m][bj][n] = *(const f32x4*)(base + off + bj * HALF + n * 16); }
            asm volatile("" ::: "memory");
#pragma unroll
            for (int m = 0; m < 4; ++m) { const size_t off = (size_t)(row0 + ai * HALF + m * 16) * ldc + col0;
#pragma unroll
                for (int bj = 0; bj < 2; ++bj)
#pragma unroll
                    for (int n = 0; n < 2; ++n) *(f32x4*)(out + off + bj * HALF + n * 16) = acc[ai][bj][m][n] + bv[m][bj][n]; }
            asm volatile("" ::: "memory");
        }
    }
};
struct EpiResN {
    static constexpr bool PERM = true, AFTER_DRAIN = false;
    const float* base; float* out; bf16_t* xb; float* rowss; int ldc;
    __device__ __forceinline__ void operator()(const f32x4 (&acc)[2][2][4][2], const Unit& u, int wr, int wc, int fr, int fq) const {
        const int row0 = u.pm * BM + wr * 64 + fr, col0 = u.pn * BM + wc * 32 + 8 * fq;
#pragma unroll
        for (int ai = 0; ai < 2; ++ai)
#pragma unroll
          for (int mh = 0; mh < 2; ++mh) {
            f32x4 bv[2][2][2];
#pragma unroll
            for (int mm = 0; mm < 2; ++mm) { const size_t off = (size_t)(row0 + ai * HALF + (mh * 2 + mm) * 16) * ldc + col0;
#pragma unroll
                for (int bj = 0; bj < 2; ++bj)
#pragma unroll
                    for (int n = 0; n < 2; ++n) bv[mm][bj][n] = *(const f32x4*)(base + off + bj * HALF + n * 4); }
            asm volatile("" ::: "memory");
#pragma unroll
            for (int mm = 0; mm < 2; ++mm) { const int m = mh * 2 + mm; const int row = row0 + ai * HALF + m * 16; const size_t off = (size_t)row * ldc + col0; float ss = 0.f;
#pragma unroll
                for (int bj = 0; bj < 2; ++bj) {
                    const f32x4 v0 = acc[ai][bj][m][0] + bv[mm][bj][0], v1 = acc[ai][bj][m][1] + bv[mm][bj][1];
                    *(f32x4*)(out + off + bj * HALF) = v0; *(f32x4*)(out + off + bj * HALF + 4) = v1;
                    u32x4 w; w.x = cvt_pk_bf16(v0[0], v0[1]); w.y = cvt_pk_bf16(v0[2], v0[3]); w.z = cvt_pk_bf16(v1[0], v1[1]); w.w = cvt_pk_bf16(v1[2], v1[3]);
                    *(u32x4*)(xb + off + bj * HALF) = w;
                    { const f32x4 q4 = v0 * v0 + v1 * v1; ss += (q4[0] + q4[1]) + (q4[2] + q4[3]); } }
                ss += __shfl_xor(ss, 16); ss += __shfl_xor(ss, 32);
                if (fq == 0) atomicAdd(rowss + row, ss); }
            asm volatile("" ::: "memory");
          }
    }
};
struct EpiProj {
    static constexpr bool PERM = true, AFTER_DRAIN = false;
    bf16_t* O; int ldc; float* kn;
    __device__ __forceinline__ void operator()(const f32x4 (&acc)[2][2][4][2], const Unit& u, int wr, int wc, int fr, int fq) const {
        const int row0 = u.pm * BM + wr * 64 + fr, col0 = u.pn * BM + wc * 32 + 8 * fq;
        int slot0 = -1, slot1 = -1;
        if (u.pn >= 3 && u.pn <= 5) { slot0 = (u.pn - 3) * 2; slot1 = slot0 + 1; }
        else if (u.pn >= 19 && u.pn <= 21) { slot0 = 11 + (u.pn - 19) * 2; slot1 = slot0 + 1 <= 15 ? slot0 + 1 : -1; }
#pragma unroll
        for (int ai = 0; ai < 2; ++ai)
#pragma unroll
            for (int m = 0; m < 4; ++m) { const int row = row0 + ai * HALF + m * 16; bf16_t* rowp = O + (size_t)row * ldc + col0;
#pragma unroll
                for (int bj = 0; bj < 2; ++bj) { const f32x4 v0 = acc[ai][bj][m][0], v1 = acc[ai][bj][m][1];
                    u32x4 w; w.x = cvt_pk_bf16(v0[0], v0[1]); w.y = cvt_pk_bf16(v0[2], v0[3]); w.z = cvt_pk_bf16(v1[0], v1[1]); w.w = cvt_pk_bf16(v1[2], v1[3]);
                    *(u32x4*)(rowp + bj * HALF) = w;
                    const int slot = bj ? slot1 : slot0;
                    if (slot >= 0) { const f32x4 q4 = v0 * v0 + v1 * v1; float ss = (q4[0] + q4[1]) + (q4[2] + q4[3]);
                        ss += __shfl_xor(ss, 16); ss += __shfl_xor(ss, 32);
                        if (fq == 0) atomicAdd(kn + (size_t)row * 16 + slot, ss); } } }
    }
};
__device__ __forceinline__ float dpp_ror1(float x) { return __int_as_float(__builtin_amdgcn_update_dpp(__float_as_int(x), __float_as_int(x), 0x121, 0xf, 0xf, false)); }
__device__ __forceinline__ float dpp_ror2(float x) { return __int_as_float(__builtin_amdgcn_update_dpp(__float_as_int(x), __float_as_int(x), 0x122, 0xf, 0xf, false)); }
struct EpiConv {
    static constexpr bool PERM = true, AFTER_DRAIN = false;
    bf16_t* H; float* halo; const float* cw; const float* cb; int dff; const float* rowss; float inv_k, eps;
    __device__ __forceinline__ void operator()(const f32x4 (&acc)[2][2][4][2], const Unit& u, int wr, int wc, int fr, int fq) const {
        const int j0 = u.pn * 128 + wc * 32 + 8 * fq; const int ngu = 2 * dff;
        const int chunk0 = u.pm * 4 + wr;
        float rs[2][4];
#pragma unroll
        for (int ai = 0; ai < 2; ++ai)
#pragma unroll
            for (int m = 0; m < 4; ++m) rs[ai][m] = __builtin_amdgcn_rsqf(rowss[(chunk0 + 2 * ai) * 64 + fr + 16 * m] * inv_k + eps);
#pragma unroll
        for (int ai = 0; ai < 2; ++ai) { const int chunk = chunk0 + 2 * ai;
            if (fr < 2) { float* hp = halo + ((size_t)chunk * 4 + fr) * ngu + j0;
#pragma unroll
                for (int n = 0; n < 2; ++n) { *(f32x4*)(hp + 4 * n) = acc[ai][0][0][n] * rs[ai][0]; *(f32x4*)(hp + dff + 4 * n) = acc[ai][1][0][n] * rs[ai][0]; } }
            if (fr >= 14) { float* hp = halo + ((size_t)chunk * 4 + (fr - 12)) * ngu + j0;
#pragma unroll
                for (int n = 0; n < 2; ++n) { *(f32x4*)(hp + 4 * n) = acc[ai][0][3][n] * rs[ai][3]; *(f32x4*)(hp + dff + 4 * n) = acc[ai][1][3][n] * rs[ai][3]; } } }
        u32x4 pk[2][4];
#pragma unroll
        for (int n = 0; n < 2; ++n) {
            const float* wp = cw + j0 + 4 * n;
            const f32x4 wg0 = *(const f32x4*)(wp), wg1 = *(const f32x4*)(wp + ngu), wg2 = *(const f32x4*)(wp + 2 * ngu);
            const f32x4 wu0 = *(const f32x4*)(wp + dff), wu1 = *(const f32x4*)(wp + ngu + dff), wu2 = *(const f32x4*)(wp + 2 * ngu + dff);
            const f32x4 bg = *(const f32x4*)(cb + j0 + 4 * n), bu = *(const f32x4*)(cb + dff + j0 + 4 * n);
#pragma unroll
            for (int ai = 0; ai < 2; ++ai)
#pragma unroll
                for (int m = 0; m < 4; ++m) {
                    const f32x4 cg = acc[ai][0][m][n] * rs[ai][m], cu = acc[ai][1][m][n] * rs[ai][m];
                    const f32x4 pg = m > 0 ? acc[ai][0][m > 0 ? m - 1 : 0][n] * rs[ai][m > 0 ? m - 1 : 0] : (f32x4){0.f, 0.f, 0.f, 0.f}, pu = m > 0 ? acc[ai][1][m > 0 ? m - 1 : 0][n] * rs[ai][m > 0 ? m - 1 : 0] : (f32x4){0.f, 0.f, 0.f, 0.f};
                    float hv[4];
#pragma unroll
                    for (int e = 0; e < 4; e += 2) {
                        const f32x2 g1 = {dpp_ror1(fr == 15 ? pg[e] : cg[e]), dpp_ror1(fr == 15 ? pg[e + 1] : cg[e + 1])}, g2 = {dpp_ror2(fr >= 14 ? pg[e] : cg[e]), dpp_ror2(fr >= 14 ? pg[e + 1] : cg[e + 1])};
                        const f32x2 u1 = {dpp_ror1(fr == 15 ? pu[e] : cu[e]), dpp_ror1(fr == 15 ? pu[e + 1] : cu[e + 1])}, u2 = {dpp_ror2(fr >= 14 ? pu[e] : cu[e]), dpp_ror2(fr >= 14 ? pu[e + 1] : cu[e + 1])};
                        const f32x2 c_g = {cg[e], cg[e + 1]}, c_u = {cu[e], cu[e + 1]};
                        const f32x2 G = (f32x2){bg[e], bg[e + 1]} + (f32x2){wg0[e], wg0[e + 1]} * g2 + (f32x2){wg1[e], wg1[e + 1]} * g1 + (f32x2){wg2[e], wg2[e + 1]} * c_g;
                        const f32x2 U = (f32x2){bu[e], bu[e + 1]} + (f32x2){wu0[e], wu0[e + 1]} * u2 + (f32x2){wu1[e], wu1[e + 1]} * u1 + (f32x2){wu2[e], wu2[e + 1]} * c_u;
                        const f32x2 t = G * (-1.4426950408889634f);
                        f32x2 d; d.x = __builtin_amdgcn_exp2f(t.x); d.y = __builtin_amdgcn_exp2f(t.y); d = d + 1.0f;
                        f32x2 r; r.x = __builtin_amdgcn_rcpf(d.x); r.y = __builtin_amdgcn_rcpf(d.y);
                        const f32x2 h2 = (G * r) * U;
                        hv[e] = h2.x; hv[e + 1] = h2.y;
                    }
                    if (n == 0) { pk[ai][m].x = cvt_pk_bf16(hv[0], hv[1]); pk[ai][m].y = cvt_pk_bf16(hv[2], hv[3]); }
                    else { pk[ai][m].z = cvt_pk_bf16(hv[0], hv[1]); pk[ai][m].w = cvt_pk_bf16(hv[2], hv[3]); }
                }
        }
#pragma unroll
        for (int ai = 0; ai < 2; ++ai)
#pragma unroll
            for (int m = 0; m < 4; ++m) if (m > 0 || fr >= 2) *(u32x4*)(H + (size_t)((chunk0 + 2 * ai) * 64 + fr + 16 * m) * dff + j0) = pk[ai][m];
    }
};
template <class Epi, class Sched, bool STAMP = false>
__device__ __forceinline__ void gemm_phase(PG8_LAS unsigned char* lds, const Gemm g, const Sched& S, const Epi& E, unsigned long long* stamps) {
    int tid_l = threadIdx.x; asm volatile("" : "+v"(tid_l)); const int tid = tid_l, wid = __builtin_amdgcn_readfirstlane(tid >> 6), lane = tid & 63, wr = wid >> 2, wc = wid & 3, fr = lane & 15, fq = lane >> 4;
    const int K = g.K, nt = K / BK;
    int ts_lo = 0, ts_hi = 0, nts = 0; const unsigned long long rt_entry = STAMP ? (unsigned long long)wall_clock64() : 0ull;
#define PG8_STAMP() do { if (STAMP && wid == 0 && nts < 64) { const unsigned long long _c = (unsigned long long)clock64(); \
        ts_lo = (lane == nts) ? (int)(unsigned)_c : ts_lo; ts_hi = (lane == nts) ? (int)(unsigned)(_c >> 32) : ts_hi; ++nts; } } while (0)
    PG8_STAMP();
    unsigned voffA[2], voffB[2];
#pragma unroll
    for (int i = 0; i < 2; ++i) { int R, C; stage_rc(tid * 16 + i * 8192, R, C); const int Rb = Epi::PERM ? ((R & ~31) + perm32(R & 31)) : R;
        voffA[i] = (unsigned)(R * K + C) * 2u; voffB[i] = (unsigned)(Rb * K + C) * 2u; }
    const size_t kstep = (size_t)(BK * 2);
    const size_t hstep = (size_t)HALF * K * 2;
    const size_t tstep = 2 * hstep;
    const unsigned ldsw = (unsigned)wid * 1024u;
    const int aoff = lds_byte(wr * 64 + fr, fq * 8), boff = lds_byte(wc * 32 + fr, fq * 8);
#define PG8_SA(b, h) (((b) * 2 + (h)) * HTB)
#define PG8_SB(b, h) ((4 + (b) * 2 + (h)) * HTB)
#define PG8_STAGE(bufoff, gbase, voff) do { _Pragma("unroll") for (int _i = 0; _i < 2; ++_i) \
        __builtin_amdgcn_global_load_lds((const unsigned*)((const char*)(gbase) + (voff)[_i]), (PG8_LAS unsigned*)(lds + (bufoff) + ldsw + _i * 8192), 16, 0, 0); } while (0)
#define PG8_LDA(dst, b, h) do { _Pragma("unroll") for (int m = 0; m < 4; ++m) _Pragma("unroll") for (int k = 0; k < 2; ++k) dst[m][k] = *(const PG8_LAS bf16x8*)(lds + PG8_SA(b, h) + aoff + m * 2048 + k * 1024); } while (0)
#define PG8_LDB(dst, b, h) do { _Pragma("unroll") for (int n = 0; n < 2; ++n) _Pragma("unroll") for (int k = 0; k < 2; ++k) dst[n][k] = *(const PG8_LAS bf16x8*)(lds + PG8_SB(b, h) + boff + n * 2048 + k * 1024); } while (0)
#define PG8_MMA(ai, bj, At, Bt) do { __builtin_amdgcn_s_setprio(1); _Pragma("unroll") for (int m = 0; m < 4; ++m) _Pragma("unroll") for (int n = 0; n < 2; ++n) _Pragma("unroll") for (int k = 0; k < 2; ++k) \
        acc[ai][bj][m][n] = __builtin_amdgcn_mfma_f32_16x16x32_bf16(Bt[n][k], At[m][k], acc[ai][bj][m][n], 0, 0, 0); __builtin_amdgcn_s_setprio(0); } while (0)
#define PG8_WAIT_V(n) asm volatile("s_waitcnt vmcnt(" #n ")" ::: "memory")
#define PG8_WAIT_L(n) asm volatile("s_waitcnt lgkmcnt(" #n ")" ::: "memory")
#define PG8_BAR __builtin_amdgcn_s_barrier()
#define PG8_SCHED __builtin_amdgcn_sched_barrier(0)
    Unit cur, nxt; int ui = 0;
    if (!S.next(0, cur)) return;
    f32x4 acc[2][2][4][2];
#pragma unroll
    for (int a = 0; a < 2; ++a)
#pragma unroll
        for (int b = 0; b < 2; ++b)
#pragma unroll
            for (int m = 0; m < 4; ++m)
#pragma unroll
                for (int n = 0; n < 2; ++n) acc[a][b][m][n] = (f32x4){0.f, 0.f, 0.f, 0.f};
    bf16x8 At[4][2], B0[2][2], B1[2][2];
    const char* cA = (const char*)g.A + (size_t)cur.pm * tstep; const char* cB = (const char*)g.Bt + (size_t)cur.pn * tstep;
    S.a_ready(cur);
    PG8_STAGE(PG8_SB(0, 0), cB, voffB); PG8_STAGE(PG8_SA(0, 0), cA, voffA); PG8_STAGE(PG8_SB(0, 1), cB + hstep, voffB); PG8_STAGE(PG8_SA(0, 1), cA + hstep, voffA);
    if (wr == 1) PG8_BAR;
    PG8_WAIT_V(4); PG8_BAR;
    PG8_STAGE(PG8_SB(1, 0), cB + kstep, voffB); PG8_STAGE(PG8_SA(1, 0), cA + kstep, voffA); PG8_STAGE(PG8_SB(1, 1), cB + hstep + kstep, voffB);
    PG8_WAIT_V(6); PG8_BAR;
    PG8_STAMP();
    for (;;) {
        const bool has_next = S.next(ui + 1, nxt);
        const char* nA = has_next ? (const char*)g.A + (size_t)nxt.pm * tstep : cA; const char* nB = has_next ? (const char*)g.Bt + (size_t)nxt.pn * tstep : cB;
        for (int t = 0; t < nt; t += 2) {
            const bool last = (t == nt - 2);
            const char* a1 = cA + (size_t)(t + 1) * kstep;
            const char* a2 = last ? nA : cA + (size_t)(t + 2) * kstep; const char* b2 = last ? nB : cB + (size_t)(t + 2) * kstep;
            const char* a3 = a2 + kstep; const char* b3 = b2 + kstep;
            if (last && has_next) S.a_ready(nxt);
            PG8_LDB(B0, 0, 0); PG8_SCHED; PG8_LDA(At, 0, 0); PG8_STAGE(PG8_SA(1, 1), a1 + hstep, voffA);
            PG8_WAIT_L(8); PG8_BAR; PG8_WAIT_L(0); PG8_MMA(0, 0, At, B0); PG8_BAR; PG8_SCHED;
            PG8_LDB(B1, 0, 1); PG8_STAGE(PG8_SB(0, 0), b2, voffB);
            PG8_BAR; PG8_WAIT_L(0); PG8_MMA(0, 1, At, B1); PG8_BAR;
            PG8_LDA(At, 0, 1); PG8_STAGE(PG8_SA(0, 0), a2, voffA);
            PG8_BAR; PG8_WAIT_L(0); PG8_MMA(1, 0, At, B0); PG8_BAR; PG8_SCHED;
            PG8_STAGE(PG8_SB(0, 1), b2 + hstep, voffB);
            PG8_WAIT_V(6); PG8_BAR; PG8_MMA(1, 1, At, B1); PG8_BAR;
            PG8_LDB(B0, 1, 0); PG8_SCHED; PG8_LDA(At, 1, 0); PG8_STAGE(PG8_SA(0, 1), a2 + hstep, voffA);
            PG8_WAIT_L(8); PG8_BAR; PG8_WAIT_L(0); PG8_MMA(0, 0, At, B0); PG8_BAR; PG8_SCHED;
            PG8_LDB(B1, 1, 1); PG8_STAGE(PG8_SB(1, 0), b3, voffB);
            PG8_BAR; PG8_WAIT_L(0); PG8_MMA(0, 1, At, B1); PG8_BAR;
            PG8_LDA(At, 1, 1); PG8_STAGE(PG8_SA(1, 0), a3, voffA);
            PG8_BAR; PG8_WAIT_L(0); PG8_MMA(1, 0, At, B0); PG8_BAR; PG8_SCHED;
            PG8_STAGE(PG8_SB(1, 1), b3 + hstep, voffB);
            PG8_WAIT_V(6); PG8_BAR; PG8_MMA(1, 1, At, B1); PG8_BAR;
        }
        PG8_STAMP();
        if constexpr (!Epi::AFTER_DRAIN) { E(acc, cur, wr, wc, fr, fq); S.done(cur); }
        PG8_STAMP();
        if (!has_next) break;
#pragma unroll
        for (int a = 0; a < 2; ++a)
#pragma unroll
            for (int b = 0; b < 2; ++b)
#pragma unroll
                for (int m = 0; m < 4; ++m)
#pragma unroll
                    for (int n = 0; n < 2; ++n) acc[a][b][m][n] = (f32x4){0.f, 0.f, 0.f, 0.f};
        cur = nxt; cA = nA; cB = nB; ++ui;
    }
    PG8_WAIT_V(0);
    if (wr == 0) PG8_BAR;
    PG8_BAR;
    if constexpr (Epi::AFTER_DRAIN) { E.fused(acc, cur, wr, wc, fr, fq, lds, wid, lane); S.done(cur); }
    PG8_STAMP();
    if (STAMP && wid == 0) { stamps[lane] = lane < nts ? (((unsigned long long)(unsigned)ts_hi << 32) | (unsigned)ts_lo) : 0ull;
        if (lane == 62) stamps[62] = rt_entry; if (lane == 63) stamps[63] = (unsigned long long)wall_clock64(); }
#undef PG8_STAMP
#undef PG8_SA
#undef PG8_SB
#undef PG8_STAGE
#undef PG8_LDA
#undef PG8_LDB
#undef PG8_MMA
#undef PG8_WAIT_V
#undef PG8_WAIT_L
#undef PG8_BAR
#undef PG8_SCHED
}
}
#define XB_TMO      128
#define XB_XCNT(j)  (256  + 64 * (j))
#define XB_XSUB(j)  (1280 + 64 * (j))
#define XB_XGEN(j)  (2304 + 64 * (j))
#define XB_TOP      3328
#define XB_TOPGEN   3392
#define XCD_BAR_WORDS 3456
#define XB_SPIN_CAP (1u << 18)
#define LAS __attribute__((address_space(3)))

__device__ __forceinline__ unsigned xb_ld(unsigned* p)              { return __hip_atomic_load(p, __ATOMIC_RELAXED, __HIP_MEMORY_SCOPE_AGENT); }
__device__ __forceinline__ unsigned xb_add(unsigned* p, unsigned v) { return __hip_atomic_fetch_add(p, v, __ATOMIC_RELAXED, __HIP_MEMORY_SCOPE_AGENT); }
__device__ __forceinline__ unsigned xb_xcc_id() { return (unsigned)__builtin_amdgcn_s_getreg((3 << 11) | 20) & 0xFu; }
#define XB_SPIN(cond, bar) do { unsigned _sp = 0; while (cond) { __builtin_amdgcn_s_sleep(1); \
    if ((++_sp & 255u) == 0u) { if (xb_ld(&(bar)[XB_TMO])) break; if (_sp > XB_SPIN_CAP) { atomicAdd(&(bar)[XB_TMO], 1u); break; } } } } while (0)

struct XcdBarrier {
    unsigned* bar; unsigned x;
    volatile LAS unsigned* st;
};

__device__ __forceinline__ XcdBarrier xcd_barrier_post(unsigned* bar, volatile LAS unsigned* st) {
    XcdBarrier b; b.bar = bar; b.x = xb_xcc_id(); b.st = st;
    if (threadIdx.x == 0) (void)xb_add(&bar[XB_XCNT(b.x)], 1u);
    return b;
}
__device__ __forceinline__ void xcd_barrier_complete(unsigned* bar, unsigned x, unsigned& nloc, unsigned& nx) {
    const unsigned G = gridDim.x * gridDim.y * gridDim.z;
    unsigned sum, cnt, mine, sp = 0u;
    for (;;) {
        sum = 0u; cnt = 0u; mine = 0u;
#pragma unroll
        for (unsigned j = 0; j < 16; ++j) { const unsigned c = xb_ld(&bar[XB_XCNT(j)]); sum += c; cnt += (c > 0u) ? 1u : 0u; mine = (j == x) ? c : mine; }
        if (sum == G) break;
        __builtin_amdgcn_s_sleep(1);
        if ((++sp & 255u) == 0u) { if (xb_ld(&bar[XB_TMO])) break; if (sp > XB_SPIN_CAP) { atomicAdd(&bar[XB_TMO], 1u); break; } }
    }
    nloc = mine > 0u ? mine : 1u; nx = cnt > 0u ? cnt : 1u;
}

__device__ __forceinline__ void xcd_barrier(const XcdBarrier& b) {
    asm volatile("s_waitcnt vmcnt(0)" ::: "memory");
    __syncthreads();
    if (threadIdx.x == 0) {
        unsigned* bar = b.bar;
        __builtin_amdgcn_s_waitcnt(0);
        unsigned nloc = b.st[0], nx = b.st[1];
        if (nloc == 0u) { xcd_barrier_complete(bar, b.x, nloc, nx); b.st[0] = nloc; b.st[1] = nx; }
        const unsigned old = xb_add(&bar[XB_XSUB(b.x)], 1u);
        const unsigned gen = old / nloc;
        if (old + 1u == (gen + 1u) * nloc) {
            __builtin_amdgcn_fence(__ATOMIC_RELEASE, "agent");
            asm volatile("s_waitcnt vmcnt(0)" ::: "memory");
            const unsigned og = xb_add(&bar[XB_TOP], 1u);
            const unsigned tg = og / nx;
            if (og + 1u == (tg + 1u) * nx) xb_add(&bar[XB_TOPGEN], 1u);
            else XB_SPIN(xb_ld(&bar[XB_TOPGEN]) == tg, bar);
            __builtin_amdgcn_fence(__ATOMIC_ACQUIRE, "agent");
            xb_add(&bar[XB_XGEN(b.x)], 1u);
            asm volatile("s_waitcnt vmcnt(0)" ::: "memory");
        } else {
            XB_SPIN(xb_ld(&bar[XB_XGEN(b.x)]) == gen, bar);
            __builtin_amdgcn_fence(__ATOMIC_ACQUIRE, "agent");
            asm volatile("s_waitcnt vmcnt(0)" ::: "memory");
        }
    }
    __syncthreads();
}
namespace mk {
#define LAS __attribute__((address_space(3)))
typedef unsigned short bf16_t;
typedef short bf16x8 __attribute__((ext_vector_type(8)));
typedef short s16x4 __attribute__((ext_vector_type(4)));
typedef float f32x16 __attribute__((ext_vector_type(16)));
typedef float f32x4 __attribute__((ext_vector_type(4)));
typedef unsigned u32x4 __attribute__((ext_vector_type(4)));
typedef unsigned u32x2 __attribute__((ext_vector_type(2)));

constexpr int BATCH = 8, SEQ = 2048, DM = 2048, MTOK = BATCH * SEQ, NIN = 6149, NQKV = 6144, DFF = 5632, NGU = 2 * DFF, HD = 128, NTHR = 512;
constexpr float EPS = 1e-6f;
constexpr float LOG2E = 1.4426950408889634f;
constexpr float C2 = 0.08838834764831845f * LOG2E;
constexpr int LDS_STAGE = 131072, LDS_BYTES = LDS_STAGE + 16;

constexpr size_t SZ_WIN = (size_t)NQKV * DM * 2, SZ_WO = (size_t)DM * DM * 2, SZ_WGU = (size_t)NGU * DM * 2, SZ_WD = (size_t)DM * DFF * 2, SZ_WL = SZ_WIN + SZ_WO + SZ_WGU + SZ_WD;
constexpr size_t WS_W = 0;
constexpr size_t WS_ABUF = WS_W + 2 * SZ_WL, SZ_ABUF = (size_t)MTOK * DM * 2;
constexpr size_t WS_PROJ = WS_ABUF + SZ_ABUF, SZ_PROJ = (size_t)MTOK * NQKV * 2;
constexpr size_t WS_HALO = WS_PROJ + SZ_PROJ, SZ_HALO = (size_t)(MTOK / 64) * 4 * NGU * 4;
constexpr size_t WS_H = WS_HALO + SZ_HALO, SZ_H = (size_t)MTOK * DFF * 2;
constexpr size_t WS_FC = WS_H + SZ_H, SZ_FC = (size_t)MTOK * 8 * 4;
constexpr size_t WS_CTR = WS_FC + SZ_FC, WS_BAR = WS_CTR + 256, WS_RSS = WS_BAR + 3456 * 4, WS_KN = WS_RSS + (size_t)4 * MTOK * 4, WS_END = WS_KN + (size_t)2 * MTOK * 16 * 4;

struct Params { const float *x, *g_mix, *w_in, *b_f, *g_head, *w_o, *g_ffn, *w_gu, *conv_w, *conv_b, *w_down, *g_final; float* out; unsigned char* ws; int ph_lo, ph_hi; };

__device__ __forceinline__ unsigned cvtpk(float lo, float hi) { unsigned r; asm volatile("v_cvt_pk_bf16_f32 %0, %1, %2" : "=v"(r) : "v"(lo), "v"(hi)); return r; }

struct CvTile { const float* src; bf16_t* dst; const float* gk; int ldn, K; };
constexpr int CV_PER_LAYER = 3072 + 1024 + 5632 + 2816, CV_TOTAL = 2 * CV_PER_LAYER;
__device__ __forceinline__ CvTile cv_decode(const Params& p, unsigned char* ws, int g) {
    const int l2 = g / CV_PER_LAYER, r = g - l2 * CV_PER_LAYER;
    unsigned char* wl = ws + WS_W + (size_t)l2 * SZ_WL;
    CvTile t; t.gk = nullptr; int ntn, lt; const float* W; bf16_t* Bt; bool gup = false;
    if (r < 3072) { lt = r; ntn = NQKV / 64; W = p.w_in + (size_t)l2 * DM * NIN; t.ldn = NIN; t.K = DM; Bt = (bf16_t*)wl; }
    else if (r < 4096) { lt = r - 3072; ntn = DM / 64; W = p.w_o + (size_t)l2 * DM * DM; t.ldn = DM; t.K = DM; Bt = (bf16_t*)(wl + SZ_WIN); }
    else if (r < 9728) { lt = r - 4096; ntn = NGU / 64; W = p.w_gu + (size_t)l2 * DM * NGU; t.ldn = NGU; t.K = DM; Bt = (bf16_t*)(wl + SZ_WIN + SZ_WO); gup = true; t.gk = p.g_ffn + l2 * DM; }
    else { lt = r - 9728; ntn = DM / 64; W = p.w_down + (size_t)l2 * DFF * DM; t.ldn = DM; t.K = DFF; Bt = (bf16_t*)(wl + SZ_WIN + SZ_WO + SZ_WGU); }
    const int tn = lt % ntn, tk = lt / ntn, k0 = tk * 64, n0 = tn * 64;
    const int nd0 = !gup ? n0 : (n0 < DFF ? (n0 >> 7) * 256 + (n0 & 127) : ((n0 - DFF) >> 7) * 256 + 128 + ((n0 - DFF) & 127));
    t.src = W + (size_t)k0 * t.ldn + n0; t.dst = Bt + (size_t)nd0 * t.K + k0; if (t.gk) t.gk += k0;
    return t;
}
__device__ __forceinline__ void convert_weights(const Params& p, unsigned char* ws, LAS float* tile) {
    int tid_l = threadIdx.x; asm volatile("" : "+v"(tid_l)); const int tid = tid_l, G = gridDim.x;
    const int kk = tid >> 6, nn = tid & 63, n = tid >> 3, kc = (tid & 7) * 8;
    int g = blockIdx.x, it = 0;
    if (g >= CV_TOTAL) return;
    bool has1 = g + G < CV_TOTAL;
    CvTile c0 = cv_decode(p, ws, g), c1 = cv_decode(p, ws, has1 ? g + G : g);
    float v0[8], v1[8];
#pragma unroll
    for (int i = 0; i < 8; ++i) v0[i] = c0.src[(size_t)(i * 8 + kk) * c0.ldn + nn];
#pragma unroll
    for (int i = 0; i < 8; ++i) v1[i] = c1.src[(size_t)(i * 8 + kk) * c1.ldn + nn];
    for (;;) {
        const int gn = g + 2 * G; const bool more = gn < CV_TOTAL, more1 = gn + G < CV_TOTAL;
        CvTile n0 = c0, n1 = c1; float w0[8], w1[8];
        if (more) { n0 = cv_decode(p, ws, gn); n1 = cv_decode(p, ws, more1 ? gn + G : gn);
#pragma unroll
            for (int i = 0; i < 8; ++i) w0[i] = n0.src[(size_t)(i * 8 + kk) * n0.ldn + nn];
#pragma unroll
            for (int i = 0; i < 8; ++i) w1[i] = n1.src[(size_t)(i * 8 + kk) * n1.ldn + nn]; }
        LAS float* tb0 = tile + ((it & 1) * 2) * (64 * 65); LAS float* tb1 = tb0 + 64 * 65;
        if (c0.gk) {
#pragma unroll
            for (int i = 0; i < 8; ++i) v0[i] *= c0.gk[i * 8 + kk]; }
        if (c1.gk) {
#pragma unroll
            for (int i = 0; i < 8; ++i) v1[i] *= c1.gk[i * 8 + kk]; }
#pragma unroll
        for (int i = 0; i < 8; ++i) { tb0[(i * 8 + kk) * 65 + nn] = v0[i]; tb1[(i * 8 + kk) * 65 + nn] = v1[i]; }
        __syncthreads();
        { float f[8];
#pragma unroll
          for (int j = 0; j < 8; ++j) f[j] = tb0[(kc + j) * 65 + n];
          u32x4 w = {cvtpk(f[0], f[1]), cvtpk(f[2], f[3]), cvtpk(f[4], f[5]), cvtpk(f[6], f[7])};
          *(u32x4*)(c0.dst + (size_t)n * c0.K + kc) = w; }
        if (has1) { float f[8];
#pragma unroll
          for (int j = 0; j < 8; ++j) f[j] = tb1[(kc + j) * 65 + n];
          u32x4 w = {cvtpk(f[0], f[1]), cvtpk(f[2], f[3]), cvtpk(f[4], f[5]), cvtpk(f[6], f[7])};
          *(u32x4*)(c1.dst + (size_t)n * c1.K + kc) = w; }
        if (!more) break;
#pragma unroll
        for (int i = 0; i < 8; ++i) { v0[i] = w0[i]; v1[i] = w1[i]; }
        c0 = n0; c1 = n1; has1 = more1; g = gn; ++it;
    }
    __syncthreads();
}

template <bool FC, bool OUTF32>
__device__ __forceinline__ void norm_phase(const float* X, const float* __restrict__ g, bf16_t* hn, float* outf,
                                           const float* __restrict__ w_in_l, float* __restrict__ fcbuf, LAS float* wfc) {
    int tid_l = threadIdx.x; asm volatile("" : "+v"(tid_l)); const int tid = tid_l, wid = tid >> 6, lane = tid & 63;
    if (FC) { for (int i = tid; i < 5 * DM; i += NTHR) { const int d = i / 5, j = i - d * 5; wfc[j * DM + d] = w_in_l[(size_t)d * NIN + NQKV + j]; } __syncthreads(); }
    for (int row = blockIdx.x * 8 + wid; row < MTOK; row += gridDim.x * 8) {
        const float* xr = X + (size_t)row * DM;
        f32x4 v[8];
#pragma unroll
        for (int i = 0; i < 8; ++i) v[i] = *(const f32x4*)(xr + (i * 64 + lane) * 4);
        float ss = 0.f;
#pragma unroll
        for (int i = 0; i < 8; ++i) ss += v[i][0] * v[i][0] + v[i][1] * v[i][1] + v[i][2] * v[i][2] + v[i][3] * v[i][3];
#pragma unroll
        for (int o = 32; o >= 1; o >>= 1) ss += __shfl_xor(ss, o);
        const float rs = 1.0f / sqrtf(ss * (1.0f / DM) + EPS);
        float fc0 = 0.f, fc1 = 0.f, fc2 = 0.f, fc3 = 0.f, fc4 = 0.f;
#pragma unroll
        for (int i = 0; i < 8; ++i) {
            const int d = (i * 64 + lane) * 4;
            const f32x4 gv = *(const f32x4*)(g + d);
            const f32x4 y = v[i] * rs * gv;
            if (OUTF32) *(f32x4*)(outf + (size_t)row * DM + d) = y;
            else { u32x2 w = {cvtpk(y[0], y[1]), cvtpk(y[2], y[3])}; *(u32x2*)(hn + (size_t)row * DM + d) = w; }
            if (FC) {
                const f32x4 w0 = *(const LAS f32x4*)(wfc + 0 * DM + d), w1 = *(const LAS f32x4*)(wfc + 1 * DM + d), w2 = *(const LAS f32x4*)(wfc + 2 * DM + d),
                            w3 = *(const LAS f32x4*)(wfc + 3 * DM + d), w4 = *(const LAS f32x4*)(wfc + 4 * DM + d);
                fc0 += y[0] * w0[0] + y[1] * w0[1] + y[2] * w0[2] + y[3] * w0[3];
                fc1 += y[0] * w1[0] + y[1] * w1[1] + y[2] * w1[2] + y[3] * w1[3];
                fc2 += y[0] * w2[0] + y[1] * w2[1] + y[2] * w2[2] + y[3] * w2[3];
                fc3 += y[0] * w3[0] + y[1] * w3[1] + y[2] * w3[2] + y[3] * w3[3];
                fc4 += y[0] * w4[0] + y[1] * w4[1] + y[2] * w4[2] + y[3] * w4[3];
            }
        }
        if (FC) {
#pragma unroll
            for (int o = 32; o >= 1; o >>= 1) { fc0 += __shfl_xor(fc0, o); fc1 += __shfl_xor(fc1, o); fc2 += __shfl_xor(fc2, o); fc3 += __shfl_xor(fc3, o); fc4 += __shfl_xor(fc4, o); }
            if (lane == 0) { float* f = fcbuf + (size_t)row * 8; f[0] = fc0; f[1] = fc1; f[2] = fc2; f[3] = fc3; f[4] = fc4; }
        }
    }
}

__device__ __forceinline__ void fixup_phase(const float* __restrict__ halo, bf16_t* __restrict__ h, const float* __restrict__ cw, const float* __restrict__ cb) {
    constexpr int NCG = DFF / 4, NCHUNK = MTOK / 64;
    const int total = NCG * NCHUNK * 2;
    int tid_l = threadIdx.x; asm volatile("" : "+v"(tid_l));
    for (int u = blockIdx.x * NTHR + tid_l; u < total; u += gridDim.x * NTHR) {
        const int cgi = u % NCG, rs = u / NCG, slot = rs & 1, chunk = rs >> 1, j = cgi * 4;
        const bool seq0 = (chunk & 31) == 0;
        const f32x4 z = {0.f, 0.f, 0.f, 0.f};
        const float* hc = halo + (size_t)chunk * 4 * NGU + j; const float* hp = hc - (size_t)4 * NGU;
        f32x4 g0, g1, g2, u0, u1, u2;
        if (slot == 0) { g0 = *(const f32x4*)(hc); u0 = *(const f32x4*)(hc + DFF);
            g1 = seq0 ? z : *(const f32x4*)(hp + 3 * NGU); u1 = seq0 ? z : *(const f32x4*)(hp + 3 * NGU + DFF);
            g2 = seq0 ? z : *(const f32x4*)(hp + 2 * NGU); u2 = seq0 ? z : *(const f32x4*)(hp + 2 * NGU + DFF); }
        else { g0 = *(const f32x4*)(hc + NGU); u0 = *(const f32x4*)(hc + NGU + DFF);
            g1 = *(const f32x4*)(hc); u1 = *(const f32x4*)(hc + DFF);
            g2 = seq0 ? z : *(const f32x4*)(hp + 3 * NGU); u2 = seq0 ? z : *(const f32x4*)(hp + 3 * NGU + DFF); }
        const f32x4 wg0 = *(const f32x4*)(cw + j), wg1 = *(const f32x4*)(cw + NGU + j), wg2 = *(const f32x4*)(cw + 2 * NGU + j);
        const f32x4 wu0 = *(const f32x4*)(cw + DFF + j), wu1 = *(const f32x4*)(cw + NGU + DFF + j), wu2 = *(const f32x4*)(cw + 2 * NGU + DFF + j);
        const f32x4 bg = *(const f32x4*)(cb + j), bu = *(const f32x4*)(cb + DFF + j);
        float hv[4];
#pragma unroll
        for (int e = 0; e < 4; ++e) { const float G = bg[e] + wg0[e] * g2[e] + wg1[e] * g1[e] + wg2[e] * g0[e]; const float U = bu[e] + wu0[e] * u2[e] + wu1[e] * u1[e] + wu2[e] * u0[e];
            hv[e] = G / (1.0f + __expf(-G)) * U; }
        u32x2 w = {cvtpk(hv[0], hv[1]), cvtpk(hv[2], hv[3])};
        *(u32x2*)(h + (size_t)(chunk * 64 + slot) * DFF + j) = w;
    }
}

constexpr int SHM_K = 16384, SHM_V = 16384;
constexpr int AT_WS = 65536, AT_TAB = AT_WS + 2048, AT_ITEM = AT_TAB + 9216;
#define KSWZ(row, colB) ((row) * 256 + ((colB) ^ (((row) & 7) << 4)))
#define SBAR() __builtin_amdgcn_sched_barrier(0)
__device__ __forceinline__ int v_st(int k, int c) { const int kk = (k & ~0xC) | ((k & 4) << 1) | ((k & 8) >> 1); return ((kk >> 3) * 4 + (c >> 5)) * 512 + ((kk & 7) * 32 + (c & 31)) * 2; }
__device__ __forceinline__ int v_rd_base(int lane) { return ((lane & 3) << 3) | (((lane >> 2) & 3) << 6) | (((lane >> 4) & 1) << 5) | (((lane >> 5) & 1) << 8); }
constexpr int v_rd_off(int d0, int ks, int half) { return d0 * 512 + ks * 4096 + half * 2048; }
__device__ __forceinline__ int crow(int r, int hi) { return (r & 3) + 8 * (r >> 2) + 4 * hi; }
__device__ __forceinline__ float pl32_max(float x) { auto rr = __builtin_amdgcn_permlane32_swap(__float_as_uint(x), __float_as_uint(x), false, false); return fmaxf(__uint_as_float(rr[0]), __uint_as_float(rr[1])); }
__device__ __forceinline__ float pl32_sum(float x) { auto rr = __builtin_amdgcn_permlane32_swap(__float_as_uint(x), __float_as_uint(x), false, false); return __uint_as_float(rr[0]) + __uint_as_float(rr[1]); }
__device__ __forceinline__ float pl32_other(float x, int hi) { auto rr = __builtin_amdgcn_permlane32_swap(__float_as_uint(x), __float_as_uint(x), false, false); return __uint_as_float(hi ? rr[0] : rr[1]); }

__device__ __forceinline__ void qkt(f32x16& p0, f32x16& p1, const LAS char* Kb, int r32, int hi, const bf16x8* qr) {
    p0 = f32x16{}; p1 = f32x16{};
    const LAS char* kb[4];
#pragma unroll
    for (int dd = 0; dd < 4; ++dd) kb[dd] = Kb + KSWZ(r32, (dd * 16 + hi * 8) * 2);
    __builtin_amdgcn_s_setprio(1);
#pragma unroll
    for (int d0 = 0; d0 < 8; ++d0) { const LAS char* a = kb[d0 & 3] + (d0 >> 2) * 128;
        bf16x8 b0 = *reinterpret_cast<const LAS bf16x8*>(a);
        bf16x8 b1 = *reinterpret_cast<const LAS bf16x8*>(a + 32 * 256);
        p0 = __builtin_amdgcn_mfma_f32_32x32x16_bf16(b0, qr[d0], p0, 0, 0, 0);
        p1 = __builtin_amdgcn_mfma_f32_32x32x16_bf16(b1, qr[d0], p1, 0, 0, 0); }
    __builtin_amdgcn_s_setprio(0);
}
__device__ __forceinline__ void pv_tile(f32x16* o, int vb0, bf16x8 pa0, bf16x8 pa1, bf16x8 pa2, bf16x8 pa3) {
#define TRRD(dst, off) asm volatile("ds_read_b64_tr_b16 %0, %1 offset:%2" : "=&v"(dst) : "v"(vb0), "i"(off) : "memory")
#define PV_D0(d0) do { s16x4 l0, l1, l2, l3, h0, h1, h2, h3; constexpr int b_ = v_rd_off(d0, 0, 0); \
        TRRD(l0, b_); TRRD(h0, b_ + 2048); TRRD(l1, b_ + 4096); TRRD(h1, b_ + 6144); TRRD(l2, b_ + 8192); TRRD(h2, b_ + 10240); TRRD(l3, b_ + 12288); TRRD(h3, b_ + 14336); \
        asm volatile("s_waitcnt lgkmcnt(0)" ::: "memory"); SBAR(); \
        o[d0] = __builtin_amdgcn_mfma_f32_32x32x16_bf16(pa0, (bf16x8){l0[0], l0[1], l0[2], l0[3], h0[0], h0[1], h0[2], h0[3]}, o[d0], 0, 0, 0); \
        o[d0] = __builtin_amdgcn_mfma_f32_32x32x16_bf16(pa1, (bf16x8){l1[0], l1[1], l1[2], l1[3], h1[0], h1[1], h1[2], h1[3]}, o[d0], 0, 0, 0); \
        o[d0] = __builtin_amdgcn_mfma_f32_32x32x16_bf16(pa2, (bf16x8){l2[0], l2[1], l2[2], l2[3], h2[0], h2[1], h2[2], h2[3]}, o[d0], 0, 0, 0); \
        o[d0] = __builtin_amdgcn_mfma_f32_32x32x16_bf16(pa3, (bf16x8){l3[0], l3[1], l3[2], l3[3], h3[0], h3[1], h3[2], h3[3]}, o[d0], 0, 0, 0); } while (0)
    __builtin_amdgcn_s_setprio(1);
    PV_D0(0); PV_D0(1); PV_D0(2); PV_D0(3);
    __builtin_amdgcn_s_setprio(0);
#undef PV_D0
#undef TRRD
}
#define PK4(P, B_, OUT) do { unsigned a0 = cvtpk(P[B_+0], P[B_+1]), a1 = cvtpk(P[B_+2], P[B_+3]); \
        unsigned b0 = cvtpk(P[B_+4], P[B_+5]), b1 = cvtpk(P[B_+6], P[B_+7]); \
        auto r0 = __builtin_amdgcn_permlane32_swap(a0, b0, false, false); auto r1 = __builtin_amdgcn_permlane32_swap(a1, b1, false, false); \
        u32x4 w = {r0[0], r1[0], r0[1], r1[1]}; OUT = *reinterpret_cast<bf16x8*>(&w); } while (0)

template <int TYPE>
__device__ __forceinline__ void attn_item(const bf16_t* __restrict__ proj, bf16_t* __restrict__ obuf, const float* __restrict__ fcbuf, const float* __restrict__ bf_l,
                                          const float* __restrict__ ghead_l, const float* __restrict__ kn, int b, int hl, int qb, LAS char* lds) {
    int tid_l = threadIdx.x; asm volatile("" : "+v"(tid_l)); const int tid = tid_l, wid = __builtin_amdgcn_readfirstlane(tid >> 6), lane = tid & 63, r32 = lane & 31, hi = lane >> 5;
    constexpr int LD = NQKV;
    constexpr int QC = TYPE == 0 ? 0 : (TYPE == 1 ? 2304 : 4224), KC = TYPE == 0 ? 768 : (TYPE == 1 ? 2944 : 4864), VC = TYPE == 0 ? 1536 : (TYPE == 1 ? 3584 : 5504);
    constexpr int HOFF = TYPE == 0 ? 0 : (TYPE == 1 ? 6 : 11);
    const int q0 = qb * 256, qlo = q0 + wid * 32, NT = 4 * (qb + 1);
    const bf16_t* Qp = proj + (size_t)(b * SEQ + qlo + r32) * LD + QC + hl * HD;
    const bf16_t* Kp = proj + (size_t)(b * SEQ) * LD + KC + hl * HD;
    const bf16_t* Vp = proj + (size_t)(b * SEQ) * LD + VC + hl * HD;
    LAS char* V_lds = lds; LAS char* K_lds = lds + 2 * SHM_V;
    LAS float* wsf = (LAS float*)(lds + AT_WS) + wid * 64;
    LAS float* tab = (LAS float*)(lds + AT_TAB);
    LAS int* dflag = (LAS int*)(lds + AT_ITEM + 16);
    const float NEGINF = -__builtin_inff();

    const float slope2 = exp2f(-8.0f * (float)(hl + 1) / 6.0f) * LOG2E;
    float kmax2 = 0.f;
    if (TYPE != 1) {
        LAS float* kred = (LAS float*)(lds + AT_ITEM + 128);
        float mx = 0.f;
        for (int s_ = tid; s_ < q0 + 256; s_ += NTHR) mx = fmaxf(mx, kn[(size_t)(b * SEQ + s_) * 16 + HOFF + hl]);
#pragma unroll
        for (int o_ = 32; o_ >= 1; o_ >>= 1) mx = fmaxf(mx, __shfl_xor(mx, o_));
        if (lane == 0) kred[wid] = mx;
        __syncthreads();
#pragma unroll
        for (int w = 0; w < 8; ++w) kmax2 = fmaxf(kmax2, kred[w]);
    }
    if (TYPE == 0) {
        for (int i = tid; i < 2304; i += NTHR) { const int d = i - 256; float v = NEGINF;
            if (d >= 0) { const int m = (d <= 128 ? 1 : 0) + (((d & 3) == 0 && d <= 512) ? 1 : 0) + ((d & 15) == 0 ? 1 : 0);
                if (m > 0) v = -slope2 * (float)d + (m == 1 ? 0.f : (m == 2 ? 1.0f : 1.5849625007211562f)); }
            tab[i] = v; }
    }
    if (TYPE == 2) {
        const float bf = bf_l[hl]; const int t0 = tid * 4; float lf[4];
#pragma unroll
        for (int j = 0; j < 4; ++j) { const float x = fcbuf[(size_t)(b * SEQ + t0 + j) * 8 + hl] + bf; lf[j] = (fminf(x, 0.f) - log1pf(expf(-fabsf(x)))) * LOG2E; }
        lf[1] += lf[0]; lf[2] += lf[1]; lf[3] += lf[2];
        const float tot = lf[3]; float incl = tot;
#pragma unroll
        for (int o = 1; o < 64; o <<= 1) { const float t = __shfl_up(incl, o); if (lane >= o) incl += t; }
        LAS float* wsum = (LAS float*)(lds + AT_WS);
        if (lane == 63) wsum[wid] = incl;
        __syncthreads();
        float pre = 0.f;
        for (int w = 0; w < wid; ++w) pre += wsum[w];
        const float ex = incl - tot + pre;
#pragma unroll
        for (int j = 0; j < 4; ++j) tab[t0 + j] = ex + lf[j];
    }
    bf16x8 qr[8];
#pragma unroll
    for (int d0 = 0; d0 < 8; ++d0) qr[d0] = *(const bf16x8*)(Qp + d0 * 16 + hi * 8);
    float Bq = 0.f;
    if (TYPE != 1) { float qs = 0.f;
#pragma unroll
        for (int d0 = 0; d0 < 8; ++d0)
#pragma unroll
            for (int e_ = 0; e_ < 8; ++e_) { const float f = __uint_as_float(((unsigned)(unsigned short)qr[d0][e_]) << 16); qs += f * f; }
        qs = pl32_sum(qs);
        Bq = sqrtf(qs) * sqrtf(kmax2) * (1.02f * C2) + 0.5f; }
    const int sr = tid >> 4, sc = (tid & 15) * 8;
    const int kws = KSWZ(sr, sc * 2), vst0 = v_st(sr, sc), vst1 = v_st(32 + sr, sc);
#define TILE_KB(it_) ((NT - 1 - (it_)) * 64)
    bf16x8 st_k0, st_k1, st_v0, st_v1;
#define SLOAD(kb_) do { st_k0 = *(const bf16x8*)(Kp + (size_t)((kb_) + sr) * LD + sc); st_k1 = *(const bf16x8*)(Kp + (size_t)((kb_) + 32 + sr) * LD + sc); \
                        st_v0 = *(const bf16x8*)(Vp + (size_t)((kb_) + sr) * LD + sc); st_v1 = *(const bf16x8*)(Vp + (size_t)((kb_) + 32 + sr) * LD + sc); } while (0)
#define SWRITE(bf_) do { *(LAS bf16x8*)(K_lds + (bf_) * SHM_K + kws) = st_k0; *(LAS bf16x8*)(K_lds + (bf_) * SHM_K + kws + 32 * 256) = st_k1; \
                         *(LAS bf16x8*)(V_lds + (bf_) * SHM_V + vst0) = st_v0; *(LAS bf16x8*)(V_lds + (bf_) * SHM_V + vst1) = st_v1; } while (0)
    SLOAD(TILE_KB(0)); SWRITE(0);
    __syncthreads();
    const int vbase = (int)(unsigned)(uintptr_t)V_lds + v_rd_base(lane);
    float m_reg = -1e30f, l_reg = 0.f, Rc = 1.f;
    bool wdone = false;
    float cq2 = 0.f; if (TYPE == 2) cq2 = tab[qlo + r32];
    f32x16 o[4] = {};
    for (int it = 0; it < NT; ++it) {
        const int cur = it & 1, kbase = TILE_KB(it);
        if (it + 1 < NT) { const int kb2 = TILE_KB(it + 1); SLOAD(kb2); }
        const bool act = !wdone && ((TYPE == 1) ? (kbase <= qlo + 30) : (kbase <= qlo + 31));
        if (act) {
            f32x16 p0, p1;
            qkt(p0, p1, K_lds + cur * SHM_K, r32, hi, qr);
            const int dq = qlo + r32 - 4 * hi - kbase;
            bf16x8 pa0, pa1, pa2, pa3;
            if (TYPE != 1) {
                if (TYPE == 0) {
                    const LAS float* tb = tab + (dq + 256 - 63);
                    f32x16 bz0, bz1;
#pragma unroll
                    for (int r = 0; r < 16; ++r) { const int c = (r & 3) + 8 * (r >> 2); bz0[r] = tb[63 - c]; bz1[r] = tb[31 - c]; }
                    p0 = p0 * C2 + bz0; p1 = p1 * C2 + bz1;
                } else {
                    f32x16 kz0, kz1;
#pragma unroll
                    for (int g = 0; g < 4; ++g) { const f32x4 ck0 = *(const LAS f32x4*)(tab + kbase + 8 * g + 4 * hi), ck1 = *(const LAS f32x4*)(tab + kbase + 32 + 8 * g + 4 * hi);
#pragma unroll
                        for (int j = 0; j < 4; ++j) { kz0[4 * g + j] = ck0[j]; kz1[4 * g + j] = ck1[j]; } }
                    p0 = p0 * C2 + (cq2 - kz0); p1 = p1 * C2 + (cq2 - kz1);
                    if (kbase + 63 > qlo) {
#pragma unroll
                        for (int r = 0; r < 16; ++r) { const int c = (r & 3) + 8 * (r >> 2); if (dq - c < 0) p0[r] = NEGINF; if (dq - c - 32 < 0) p1[r] = NEGINF; }
                    }
                }
                float pmax = p0[0];
#pragma unroll
                for (int r = 1; r < 16; ++r) pmax = fmaxf(pmax, p0[r]);
#pragma unroll
                for (int r = 0; r < 16; ++r) pmax = fmaxf(pmax, p1[r]);
                pmax = pl32_max(pmax);
                float mn, alpha;
                if (__all((pmax - m_reg) <= 11.5f)) { mn = m_reg; alpha = 1.f; }
                else { mn = fmaxf(m_reg, pmax); alpha = __builtin_amdgcn_exp2f(m_reg - mn); m_reg = mn; }
                float ps = 0.f;
                { const float nm = -mn; f32x16 nmv; for (int r = 0; r < 16; ++r) nmv[r] = nm; p0 = p0 + nmv; p1 = p1 + nmv; }
#pragma unroll
                for (int r = 0; r < 16; ++r) { p0[r] = __builtin_amdgcn_exp2f(p0[r]); p1[r] = __builtin_amdgcn_exp2f(p1[r]); }
                { const f32x16 sv = p0 + p1; const f32x4 s4 = (f32x4){sv[0], sv[1], sv[2], sv[3]} + (f32x4){sv[4], sv[5], sv[6], sv[7]} + (f32x4){sv[8], sv[9], sv[10], sv[11]} + (f32x4){sv[12], sv[13], sv[14], sv[15]};
                  ps = (s4[0] + s4[1]) + (s4[2] + s4[3]); }
                ps = pl32_sum(ps);
                l_reg = l_reg * alpha + ps;
                if (__any(alpha < 1.f)) {
                    if (hi == 0) wsf[32 + r32] = alpha;
                    asm volatile("s_waitcnt lgkmcnt(0)" ::: "memory");
#pragma unroll
                    for (int r = 0; r < 16; ++r) { const float a = wsf[32 + crow(r, hi)];
#pragma unroll
                        for (int d_ = 0; d_ < 4; ++d_) o[d_][r] *= a; }
                }
            } else {
                f32x16 l0, l1;
                const bool diag = (kbase + 63 >= qlo);
#pragma unroll
                for (int r = 0; r < 16; ++r) { const int c = (r & 3) + 8 * (r >> 2);
                    float u0 = __builtin_amdgcn_rcpf(1.0f + __builtin_amdgcn_exp2f(p0[r] * C2));
                    float u1 = __builtin_amdgcn_rcpf(1.0f + __builtin_amdgcn_exp2f(p1[r] * C2));
                    float s0 = 1.0f - u0, s1 = 1.0f - u1;
                    if (diag) { if (dq - c <= 0) { u0 = 1.f; s0 = 0.f; } if (dq - c - 32 <= 0) { u1 = 1.f; s1 = 0.f; } }
                    p0[r] = s0; p1[r] = s1; l0[r] = u0; l1[r] = u1; }
                float cs[2][4], pc[2][4];
#pragma unroll
                for (int g = 0; g < 4; ++g) { cs[0][g] = (l0[4 * g] * l0[4 * g + 1]) * (l0[4 * g + 2] * l0[4 * g + 3]); cs[1][g] = (l1[4 * g] * l1[4 * g + 1]) * (l1[4 * g + 2] * l1[4 * g + 3]); }
#pragma unroll
                for (int g = 0; g < 4; ++g) { pc[0][g] = pl32_other(cs[0][g], hi); pc[1][g] = pl32_other(cs[1][g], hi); }
                float run = Rc;
#pragma unroll
                for (int p = 1; p >= 0; --p)
#pragma unroll
                    for (int g = 3; g >= 0; --g) {
                        float acc = hi == 0 ? run * pc[p][g] : run;
                        run *= cs[p][g] * pc[p][g];
#pragma unroll
                        for (int j = 3; j >= 0; --j) { if (p == 0) { const float a = p0[4 * g + j] * acc; acc *= l0[4 * g + j]; p0[4 * g + j] = a; }
                                                       else { const float a = p1[4 * g + j] * acc; acc *= l1[4 * g + j]; p1[4 * g + j] = a; } }
                    }
                Rc = run;
            }
            PK4(p0, 0, pa0); PK4(p0, 8, pa1); PK4(p1, 0, pa2); PK4(p1, 8, pa3);
            pv_tile(o, vbase + cur * SHM_V, pa0, pa1, pa2, pa3);
        }
        if (it + 1 < NT) { SWRITE(cur ^ 1); }
        { bool drow;
          if (TYPE == 1) drow = Rc < 1e-30f;
          else {
              const float bmax = (TYPE == 0) ? (1.5849625f - slope2 * (float)(qlo + r32 - kbase + 1)) : (cq2 - tab[kbase > 0 ? kbase - 1 : 0]);
              drow = (Bq + bmax - m_reg) < -64.f; }
          const int dn = (wdone || __all(drow)) ? 1 : 0; wdone = dn != 0; if (lane == 0) dflag[(it & 1) * 8 + wid] = dn; }
        __syncthreads();
        { const LAS int* f = dflag + (it & 1) * 8; if ((f[0] & f[1] & f[2] & f[3] & f[4] & f[5] & f[6] & f[7]) != 0) break; }
    }
    float rli[16];
    if (TYPE != 1) {
        if (hi == 0) wsf[r32] = l_reg;
        asm volatile("s_waitcnt lgkmcnt(0)" ::: "memory");
#pragma unroll
        for (int r = 0; r < 16; ++r) rli[r] = 1.0f / wsf[crow(r, hi)];
    } else {
#pragma unroll
        for (int r = 0; r < 16; ++r) rli[r] = 1.0f;
    }
    float gh[4];
#pragma unroll
    for (int d0 = 0; d0 < 4; ++d0) gh[d0] = ghead_l[(HOFF + hl) * HD + d0 * 32 + r32];
    bf16_t* Ow = obuf + (size_t)(b * SEQ + qlo) * DM + (HOFF + hl) * HD;
#pragma unroll
    for (int r = 0; r < 16; ++r) {
        float v[4], ss = 0.f;
#pragma unroll
        for (int d0 = 0; d0 < 4; ++d0) { v[d0] = o[d0][r] * rli[r]; ss += v[d0] * v[d0]; }
        ss += __shfl_xor(ss, 1); ss += __shfl_xor(ss, 2); ss += __shfl_xor(ss, 4); ss += __shfl_xor(ss, 8); ss += __shfl_xor(ss, 16);
        const float scl = 1.0f / sqrtf(ss * (1.0f / HD) + EPS);
        const int orow = crow(r, hi);
#pragma unroll
        for (int d0 = 0; d0 < 4; ++d0) { const float y = v[d0] * scl * gh[d0]; const float yn = __shfl_xor(y, 1);
            if ((r32 & 1) == 0) *(unsigned*)(Ow + (size_t)orow * DM + d0 * 32 + r32) = cvtpk(y, yn); }
    }
    __syncthreads();
#undef TILE_KB
#undef SLOAD
#undef SWRITE
}

__device__ __forceinline__ void attn_phase(const bf16_t* proj, bf16_t* obuf, const float* fcbuf, const float* bf_l, const float* ghead_l, const float* kn, unsigned* ctr, LAS char* lds) {
    LAS int* item_s = (LAS int*)(lds + AT_ITEM);
    for (;;) {
        if (threadIdx.x == 0) *item_s = (int)atomicAdd(ctr, 1u);
        __syncthreads();
        const int i = *item_s;
        __syncthreads();
        if (i >= 1024) break;
        int qb, hh, b;
        if (i < 192) { qb = 7 - i / 24; const int r = i % 24; b = r / 3; hh = 3 + r % 3; }
        else if (i < 512) { const int j = i - 192; qb = 7 - j / 40; const int r = j % 40; b = r / 5; hh = 11 + r % 5; }
        else if (i < 704) { const int j = i - 512; qb = 7 - j / 24; const int r = j % 24; b = r / 3; hh = r % 3; }
        else { const int j = i - 704; qb = 7 - j / 40; const int r = j % 40; b = r / 5; hh = 6 + r % 5; }
        if (hh < 6) attn_item<0>(proj, obuf, fcbuf, bf_l, ghead_l, kn, b, hh, qb, lds);
        if (hh >= 6 && hh < 11) attn_item<1>(proj, obuf, fcbuf, bf_l, ghead_l, kn, b, hh - 6, qb, lds);
        if (hh >= 11) attn_item<2>(proj, obuf, fcbuf, bf_l, ghead_l, kn, b, hh - 11, qb, lds);
    }
}

__global__ void __launch_bounds__(NTHR) fwd(Params p) {
    extern __shared__ __attribute__((aligned(16))) unsigned char lds_raw[];
    LAS unsigned char* lds = (LAS unsigned char*)lds_raw;
    cg::grid_group grid = cg::this_grid();
    unsigned char* ws = p.ws;
    bf16_t* abuf = (bf16_t*)(ws + WS_ABUF); bf16_t* proj = (bf16_t*)(ws + WS_PROJ); bf16_t* hbuf = (bf16_t*)(ws + WS_H); float* halo = (float*)(ws + WS_HALO);
    float* fcbuf = (float*)(ws + WS_FC); unsigned* ctr = (unsigned*)(ws + WS_CTR); float* rss = (float*)(ws + WS_RSS); float* kn = (float*)(ws + WS_KN); bf16_t* xbf = proj;
    if (threadIdx.x < 4) ((LAS unsigned*)(lds + LDS_STAGE))[threadIdx.x] = 0u;
    __syncthreads();
    XcdBarrier xb; xb.bar = (unsigned*)(ws + WS_BAR); xb.x = xb_xcc_id(); xb.st = (volatile LAS unsigned*)(lds + LDS_STAGE);
    { unsigned* z = (unsigned*)(ws + WS_CTR); const size_t nz = (WS_END - WS_CTR) / 4;
      for (size_t i = (size_t)blockIdx.x * NTHR + threadIdx.x; i < nz; i += (size_t)gridDim.x * NTHR) z[i] = 0u; }
    int vc = blockIdx.x;
    int ph = 0;
#define PH_BEGIN if (ph >= p.ph_lo && ph < p.ph_hi) { if (ph > p.ph_lo) { if (ph == p.ph_lo + 1) { grid.sync(); \
            if (threadIdx.x == 0) xb.st[2] = xb_add(&xb.bar[XB_XCNT(xb.x)], 1u);     \
            __syncthreads(); } \
          else { xcd_barrier(xb); \
            if (ph == p.ph_lo + 2) { bool okc = true; for (int j = 0; j < 16; ++j) okc = okc && (xb_ld(&xb.bar[XB_XCNT(j)]) == (j < 8 ? 32u : 0u)); \
                if (okc) vc = 8 * (int)xb.st[2] + (int)xb.x; } } }
#define PH_END } ++ph;
    for (int l = 0; l < 2; ++l) {
        const float* xin = (l == 0) ? p.x : p.out;
        bf16_t* WinT = (bf16_t*)(ws + WS_W + (size_t)l * SZ_WL); bf16_t* WoT = (bf16_t*)((unsigned char*)WinT + SZ_WIN); bf16_t* WguT = (bf16_t*)((unsigned char*)WoT + SZ_WO); bf16_t* WdT = (bf16_t*)((unsigned char*)WguT + SZ_WGU);
        PH_BEGIN
            if (l == 0) {
                convert_weights(p, ws, (LAS float*)lds);
            }
            norm_phase<true, false>(xin, p.g_mix + l * DM, abuf, nullptr, p.w_in + (size_t)l * DM * NIN, fcbuf, (LAS float*)lds);
        PH_END
        PH_BEGIN
            pg8::Gemm g{abuf, WinT, MTOK, NQKV, DM}; pg8::StaticOrder S; S.init(MTOK, NQKV, gridDim.x, vc);
            pg8::EpiProj E{proj, NQKV, kn + (size_t)l * MTOK * 16};
            pg8::gemm_phase<pg8::EpiProj, pg8::StaticOrder>(lds, g, S, E, nullptr);
        PH_END
        PH_BEGIN
            attn_phase(proj, abuf, fcbuf, p.b_f + l * 5, p.g_head + l * DM, kn + (size_t)l * MTOK * 16, ctr + l * 16, (LAS char*)lds);
        PH_END
        PH_BEGIN
            pg8::Gemm g{abuf, WoT, MTOK, DM, DM}; pg8::StaticOrder S; S.init(MTOK, DM, gridDim.x, vc);
            pg8::EpiResN E{xin, p.out, xbf, rss + (size_t)l * MTOK, DM};
            pg8::gemm_phase<pg8::EpiResN, pg8::StaticOrder>(lds, g, S, E, nullptr);
        PH_END
        PH_BEGIN
            pg8::Gemm g{xbf, WguT, MTOK, NGU, DM}; pg8::StaticOrder S; S.init(MTOK, NGU, gridDim.x, vc);
            pg8::EpiConv E{hbuf, halo, p.conv_w + (size_t)l * 3 * NGU, p.conv_b + (size_t)l * NGU, DFF, rss + (size_t)l * MTOK, 1.0f / DM, EPS};
            pg8::gemm_phase<pg8::EpiConv, pg8::StaticOrder>(lds, g, S, E, nullptr);
        PH_END
        PH_BEGIN
            fixup_phase(halo, hbuf, p.conv_w + (size_t)l * 3 * NGU, p.conv_b + (size_t)l * NGU);
        PH_END
        PH_BEGIN
            pg8::Gemm g{hbuf, WdT, MTOK, DM, DFF}; pg8::StaticOrder S; S.init(MTOK, DM, gridDim.x, vc);
            pg8::EpiRes E{p.out, p.out, DM};
            pg8::gemm_phase<pg8::EpiRes, pg8::StaticOrder>(lds, g, S, E, nullptr);
        PH_END
    }
    PH_BEGIN
        norm_phase<false, true>(p.out, p.g_final, nullptr, p.out, nullptr, nullptr, (LAS float*)lds);
    PH_END
#undef PH_BEGIN
#undef PH_END
}
}

extern "C" void kernel_launch(void* const* d_in, const int* in_sizes, int n_in, void* d_out, int out_size, void* d_ws, size_t ws_size, hipStream_t stream) {
    static int grid_blocks = 0;
    if (!grid_blocks) {
        if (n_in != 12 || ws_size < mk::WS_END) { fprintf(stderr, "kernel_launch: unexpected n_in %d or ws_size %zu (< %zu)\n", n_in, ws_size, (size_t)mk::WS_END); grid_blocks = -1; return; }
        int dev = 0, cus = 0, per_cu = 0;
        (void)hipGetDevice(&dev);
        if (hipDeviceGetAttribute(&cus, hipDeviceAttributeMultiprocessorCount, dev) != hipSuccess || cus <= 0) cus = 256;
        if (hipFuncSetAttribute((const void*)mk::fwd, hipFuncAttributeMaxDynamicSharedMemorySize, mk::LDS_BYTES) != hipSuccess) fprintf(stderr, "kernel_launch: hipFuncSetAttribute failed\n");
        if (hipOccupancyMaxActiveBlocksPerMultiprocessor(&per_cu, (const void*)mk::fwd, mk::NTHR, mk::LDS_BYTES) != hipSuccess || per_cu < 1) { per_cu = 1; (void)hipGetLastError(); }
        grid_blocks = cus * per_cu;
    }
    if (grid_blocks < 0) return;
    mk::Params p{};
    p.x = (const float*)d_in[0]; p.g_mix = (const float*)d_in[1]; p.w_in = (const float*)d_in[2]; p.b_f = (const float*)d_in[3]; p.g_head = (const float*)d_in[4];
    p.w_o = (const float*)d_in[5]; p.g_ffn = (const float*)d_in[6]; p.w_gu = (const float*)d_in[7]; p.conv_w = (const float*)d_in[8]; p.conv_b = (const float*)d_in[9];
    p.w_down = (const float*)d_in[10]; p.g_final = (const float*)d_in[11];
    p.out = (float*)d_out; p.ws = (unsigned char*)d_ws; p.ph_lo = 0; p.ph_hi = 1000;
    void* args[] = {&p};
    hipError_t e = hipLaunchCooperativeKernel((void*)mk::fwd, dim3(grid_blocks), dim3(mk::NTHR), args, mk::LDS_BYTES, stream);
    if (e != hipSuccess) fprintf(stderr, "cooperative launch failed: %s (grid %d)\n", hipGetErrorString(e), grid_blocks);
}
```

```cpp
#include <hip/hip_runtime.h>
#include <hip/hip_cooperative_groups.h>
#include <cstdio>
#include <cstdint>
namespace cg = cooperative_groups;
namespace pg8 {
#define PG8_LAS __attribute__((address_space(3)))
typedef unsigned short bf16_t;
typedef short bf16x8 __attribute__((ext_vector_type(8)));
typedef float f32x4 __attribute__((ext_vector_type(4)));
typedef unsigned u32x4 __attribute__((ext_vector_type(4)));
constexpr int BM = 256, BK = 64, HALF = 128, HTB = HALF * BK * 2  , STAGE_BYTES = 8 * HTB, NXCD = 8, WGM = 8;

__host__ __device__ __forceinline__ int lds_byte(int r, int c) { const int st = (r >> 4) * 2 + (c >> 5), rr = r & 15, cc = c & 31, ob = rr * 64 + cc * 2; return st * 1024 + (ob ^ (((ob >> 9) & 1) << 5)); }
__host__ __device__ __forceinline__ void stage_rc(int b, int& R, int& C) { const int st = b / 1024, sb = b % 1024, swz = sb ^ (((sb >> 9) & 1) << 5); R = (st >> 1) * 16 + swz / 64; C = (st & 1) * 32 + (swz % 64) / 2; }
__host__ __device__ __forceinline__ int perm32(int rho) { const int n = rho >> 4, i = rho & 15; return 8 * (i >> 2) + 4 * n + (i & 3); }

struct Unit { int pm, pn; };
struct Gemm { const bf16_t* A; const bf16_t* Bt; int M, N, K; };

struct StaticOrder {
    int nM, nN, nwg, G, c;
    __host__ __device__ void init(int M, int N, int G_, int c_) { nM = M / BM; nN = N / BM; nwg = nM * nN; G = G_; c = c_; }
    __host__ __device__ __forceinline__ bool next(int i, Unit& u) const {
        const long L = (long)i * G + c; if (L >= nwg) return false;
        int wgid = (int)L; { const int q = nwg / NXCD, r = nwg % NXCD, xcd = wgid % NXCD, off = wgid / NXCD; wgid = (xcd < r ? xcd * (q + 1) : r * (q + 1) + (xcd - r) * q) + off; }
        const int nig = WGM * nN, gid = wgid / nig, fm = gid * WGM, gsz = (nM - fm) < WGM ? (nM - fm) : WGM;
        u.pm = fm + ((wgid % nig) % gsz); u.pn = (wgid % nig) / gsz; return true;
    }
    __device__ __forceinline__ void a_ready(const Unit&) const {}
    __device__ __forceinline__ void done(const Unit&) const {}
};
struct CountedOrder : StaticOrder {
    const unsigned* ready; unsigned need; unsigned* tmo;
    __device__ __forceinline__ void a_ready(const Unit& u) const {
        if (threadIdx.x < 64) {
            const unsigned long long t0 = __builtin_amdgcn_s_memrealtime(); unsigned polls = 0;
            while ((unsigned)__builtin_amdgcn_readfirstlane(__hip_atomic_load(ready + 64 * u.pm, __ATOMIC_RELAXED, __HIP_MEMORY_SCOPE_AGENT)) < need) {
                if ((++polls & 255u) == 0u && __builtin_amdgcn_readfirstlane(__hip_atomic_load(tmo, __ATOMIC_RELAXED, __HIP_MEMORY_SCOPE_AGENT)) != 0u) break;
                if (__builtin_amdgcn_s_memrealtime() - t0 > 2000000ull) {
                    if (threadIdx.x == 0) { unsigned expect = 0u; __hip_atomic_compare_exchange_strong(tmo + 1, &expect, 0x600u | (unsigned)(u.pm & 0xff), __ATOMIC_RELAXED, __ATOMIC_RELAXED, __HIP_MEMORY_SCOPE_AGENT); __hip_atomic_store(tmo, 1u, __ATOMIC_RELAXED, __HIP_MEMORY_SCOPE_AGENT); }
                    break; }
                __builtin_amdgcn_s_sleep(2); }
            __builtin_amdgcn_fence(__ATOMIC_ACQUIRE, "agent");
            asm volatile("s_waitcnt vmcnt(0)" ::: "memory");
        }
#if !defined(BROKEN_HOOK_NO_BARRIER)
        asm volatile("" ::: "memory"); __builtin_amdgcn_s_barrier(); asm volatile("" ::: "memory");
#endif
    }
};

__device__ __forceinline__ unsigned cvt_pk_bf16(float lo, float hi) { unsigned r; asm volatile("v_cvt_pk_bf16_f32 %0, %1, %2" : "=v"(r) : "v"(lo), "v"(hi)); return r; }
typedef float f32x2 __attribute__((ext_vector_type(2)));
__device__ __forceinline__ f32x2 gelu_pk(f32x2 v) {
    const f32x2 av = __builtin_elementwise_abs(v), d = av * 0.2316418882f + 1.0f;
    f32x2 t; t.x = __builtin_amdgcn_rcpf(d.x); t.y = __builtin_amdgcn_rcpf(d.y);
    f32x2 q = t * 0.5307027145f + (-0.7265760135f); q = q * t + 0.7107068705f; q = q * t + (-0.142248368f); q = q * t + 0.127414796f; q = q * t;
    const f32x2 s = (v * v) * (-0.72134752044f);
    f32x2 e; e.x = __builtin_amdgcn_exp2f(s.x); e.y = __builtin_amdgcn_exp2f(s.y);
    const f32x2 m = v * (q * e), r = v - m;
    f32x2 o; o.x = v.x < 0.f ? m.x : r.x; o.y = v.y < 0.f ? m.y : r.y; return o;
}

struct EpiF32 {
    static constexpr bool PERM = false, AFTER_DRAIN = false;
    float* C; int ldc; const float* bias;
    __device__ __forceinline__ void operator()(const f32x4 (&acc)[2][2][4][2], const Unit& u, int wr, int wc, int fr, int fq) const {
        const int row0 = u.pm * BM + wr * 64 + fr, col0 = u.pn * BM + wc * 32 + 4 * fq;
        f32x4 bv[2][2];
#pragma unroll
        for (int bj = 0; bj < 2; ++bj)
#pragma unroll
            for (int n = 0; n < 2; ++n) bv[bj][n] = bias ? *(const f32x4*)(bias + col0 + bj * HALF + n * 16) : (f32x4){0.f, 0.f, 0.f, 0.f};
#pragma unroll
        for (int ai = 0; ai < 2; ++ai)
#pragma unroll
            for (int m = 0; m < 4; ++m) { float* rowp = C + (size_t)(row0 + ai * HALF + m * 16) * ldc + col0;
#pragma unroll
                for (int bj = 0; bj < 2; ++bj)
#pragma unroll
                    for (int n = 0; n < 2; ++n) *(f32x4*)(rowp + bj * HALF + n * 16) = acc[ai][bj][m][n] + bv[bj][n]; }
    }
};
template <int ACT  > struct EpiBf16 {
    static constexpr bool PERM = true, AFTER_DRAIN = false;
    bf16_t* O; int ldc; const float* bias; int split_cols; size_t split_stride;
    __device__ __forceinline__ void operator()(const f32x4 (&acc)[2][2][4][2], const Unit& u, int wr, int wc, int fr, int fq) const {
        const int row0 = u.pm * BM + wr * 64 + fr; int colt = u.pn * BM; bf16_t* base = O;
        if (split_cols) { const int t = colt / split_cols; base += (size_t)t * split_stride; colt -= t * split_cols; }
        const int col0 = colt + wc * 32 + 8 * fq, bcol0 = u.pn * BM + wc * 32 + 8 * fq;
        f32x4 bv[2][2];
#pragma unroll
        for (int bj = 0; bj < 2; ++bj)
#pragma unroll
            for (int n = 0; n < 2; ++n) bv[bj][n] = bias ? *(const f32x4*)(bias + bcol0 + bj * HALF + 4 * n) : (f32x4){0.f, 0.f, 0.f, 0.f};
#pragma unroll
        for (int ai = 0; ai < 2; ++ai)
#pragma unroll
            for (int m = 0; m < 4; ++m) { bf16_t* rowp = base + (size_t)(row0 + ai * HALF + m * 16) * ldc + col0;
#pragma unroll
                for (int bj = 0; bj < 2; ++bj) { f32x4 v0 = acc[ai][bj][m][0] + bv[bj][0], v1 = acc[ai][bj][m][1] + bv[bj][1];
                    if (ACT == 1) { f32x2 a = gelu_pk((f32x2){v0[0], v0[1]}), b = gelu_pk((f32x2){v0[2], v0[3]}), c = gelu_pk((f32x2){v1[0], v1[1]}), d = gelu_pk((f32x2){v1[2], v1[3]});
                        v0 = (f32x4){a.x, a.y, b.x, b.y}; v1 = (f32x4){c.x, c.y, d.x, d.y}; }
                    if (ACT == 2) {
#pragma unroll
                        for (int j = 0; j < 4; ++j) { v0[j] = 0.5f * v0[j] * (1.0f + erff(v0[j] * 0.70710678f)); v1[j] = 0.5f * v1[j] * (1.0f + erff(v1[j] * 0.70710678f)); } }
                    u32x4 w; w.x = cvt_pk_bf16(v0[0], v0[1]); w.y = cvt_pk_bf16(v0[2], v0[3]); w.z = cvt_pk_bf16(v1[0], v1[1]); w.w = cvt_pk_bf16(v1[2], v1[3]);
                    *(u32x4*)(rowp + bj * HALF) = w; } }
    }
};
struct EpiRes {
    static constexpr bool PERM = false, AFTER_DRAIN = false, APERM = false;
    const float* base; float* out; int ldc;
    __device__ __forceinline__ void operator()(const f32x4 (&acc)[2][2][4][2], const Unit& u, int wr, int wc, int fr, int fq) const {
        const int row0 = u.pm * BM + wr * 64 + fr, col0 = u.pn * BM + wc * 32 + 4 * fq;
#pragma unroll
        for (int ai = 0; ai < 2; ++ai) {
            f32x4 bv[4][2][2];
#pragma unroll
            for (int m = 0; m < 4; ++m) { const size_t off = (size_t)(row0 + ai * HALF + m * 16) * ldc + col0;
#pragma unroll
                for (int bj = 0; bj < 2; ++bj)
#pragma unroll
                    for (int n = 0; n < 2; ++n) bv[m][bj][n] = *(const f32x4*)(base + off + bj * HALF + n * 16); }
            asm volatile("" ::: "memory");
#pragma unroll
            for (int m = 0; m < 4; ++m) { const size_t off = (size_t)(row0 + ai * HALF + m * 16) * ldc + col0;
#pragma unroll
                for (int bj = 0; bj < 2; ++bj)
#pragma unroll
                    for (int n = 0; n < 2; ++n) *(f32x4*)(out + off + bj * HALF + n * 16) = acc[ai][bj][m][n] + bv[m][bj][n]; }
            asm volatile("" ::: "memory");
        }
    }
};
struct EpiResN {
    static constexpr bool PERM = true, AFTER_DRAIN = false, APERM = false;
    const float* base; float* out; bf16_t* xb; float* rowss; int ldc;
    __device__ __forceinline__ void operator()(const f32x4 (&acc)[2][2][4][2], const Unit& u, int wr, int wc, int fr, int fq) const {
        const int row0 = u.pm * BM + wr * 64 + fr, col0 = u.pn * BM + wc * 32 + 8 * fq;
#pragma unroll
        for (int ai = 0; ai < 2; ++ai)
#pragma unroll
          for (int mh = 0; mh < 2; ++mh) {
            f32x4 bv[2][2][2];
#pragma unroll
            for (int mm = 0; mm < 2; ++mm) { const size_t off = (size_t)(row0 + ai * HALF + (mh * 2 + mm) * 16) * ldc + col0;
#pragma unroll
                for (int bj = 0; bj < 2; ++bj)
#pragma unroll
                    for (int n = 0; n < 2; ++n) bv[mm][bj][n] = *(const f32x4*)(base + off + bj * HALF + n * 4); }
            asm volatile("" ::: "memory");
#pragma unroll
            for (int mm = 0; mm < 2; ++mm) { const int m = mh * 2 + mm; const int row = row0 + ai * HALF + m * 16; const size_t off = (size_t)row * ldc + col0; float ss = 0.f;
#pragma unroll
                for (int bj = 0; bj < 2; ++bj) {
                    const f32x4 v0 = acc[ai][bj][m][0] + bv[mm][bj][0], v1 = acc[ai][bj][m][1] + bv[mm][bj][1];
                    *(f32x4*)(out + off + bj * HALF) = v0; *(f32x4*)(out + off + bj * HALF + 4) = v1;
                    u32x4 w; w.x = cvt_pk_bf16(v0[0], v0[1]); w.y = cvt_pk_bf16(v0[2], v0[3]); w.z = cvt_pk_bf16(v1[0], v1[1]); w.w = cvt_pk_bf16(v1[2], v1[3]);
                    *(u32x4*)(xb + off + bj * HALF) = w;
                    { const f32x4 q4 = v0 * v0 + v1 * v1; ss += (q4[0] + q4[1]) + (q4[2] + q4[3]); } }
                ss += __shfl_xor(ss, 16); ss += __shfl_xor(ss, 32);
                if (fq == 0) atomicAdd(rowss + row, ss); }
            asm volatile("" ::: "memory");
          }
    }
};
struct EpiProj {
    static constexpr bool PERM = true, AFTER_DRAIN = false, APERM = false;
    bf16_t* O; int ldc; float* kn;
    __device__ __forceinline__ void operator()(const f32x4 (&acc)[2][2][4][2], const Unit& u, int wr, int wc, int fr, int fq) const {
        const int row0 = u.pm * BM + wr * 64 + fr, col0 = u.pn * BM + wc * 32 + 8 * fq;
        int slot0 = -1, slot1 = -1;
        if (u.pn >= 3 && u.pn <= 5) { slot0 = (u.pn - 3) * 2; slot1 = slot0 + 1; }
        else if (u.pn >= 19 && u.pn <= 21) { slot0 = 11 + (u.pn - 19) * 2; slot1 = slot0 + 1 <= 15 ? slot0 + 1 : -1; }
#pragma unroll
        for (int ai = 0; ai < 2; ++ai)
#pragma unroll
            for (int m = 0; m < 4; ++m) { const int row = row0 + ai * HALF + m * 16; bf16_t* rowp = O + (size_t)row * ldc + col0;
#pragma unroll
                for (int bj = 0; bj < 2; ++bj) { const f32x4 v0 = acc[ai][bj][m][0], v1 = acc[ai][bj][m][1];
                    u32x4 w; w.x = cvt_pk_bf16(v0[0], v0[1]); w.y = cvt_pk_bf16(v0[2], v0[3]); w.z = cvt_pk_bf16(v1[0], v1[1]); w.w = cvt_pk_bf16(v1[2], v1[3]);
                    *(u32x4*)(rowp + bj * HALF) = w;
                    const int slot = bj ? slot1 : slot0;
                    if (slot >= 0) { const f32x4 q4 = v0 * v0 + v1 * v1; float ss = (q4[0] + q4[1]) + (q4[2] + q4[3]);
                        ss += __shfl_xor(ss, 16); ss += __shfl_xor(ss, 32);
                        if (fq == 0) atomicAdd(kn + (size_t)row * 16 + slot, ss); } } }
    }
};
__device__ __forceinline__ float dpp_ror1(float x) { return __int_as_float(__builtin_amdgcn_update_dpp(__float_as_int(x), __float_as_int(x), 0x121, 0xf, 0xf, false)); }
__device__ __forceinline__ float dpp_ror2(float x) { return __int_as_float(__builtin_amdgcn_update_dpp(__float_as_int(x), __float_as_int(x), 0x122, 0xf, 0xf, false)); }
__device__ __forceinline__ float dpp_shr1z(float x) { return __int_as_float(__builtin_amdgcn_update_dpp(__float_as_int(x), __float_as_int(x), 0x111, 0xf, 0xf, true)); }
struct EpiConv {
    static constexpr bool PERM = true, AFTER_DRAIN = false, APERM = true;
    bf16_t* H; float* halo; const float* cw; const float* cb; int dff; const float* rowss; float inv_k, eps;
    __device__ __forceinline__ void operator()(const f32x4 (&acc)[2][2][4][2], const Unit& u, int wr, int wc, int fr, int fq) const {
        const int j0 = u.pn * 128 + wc * 32 + 8 * fq; const int ngu = 2 * dff;
        const int chunk0 = u.pm * 4 + wr;
        float rs[2][4];
#pragma unroll
        for (int ai = 0; ai < 2; ++ai)
#pragma unroll
            for (int m = 0; m < 4; ++m) rs[ai][m] = __builtin_amdgcn_rsqf(rowss[(chunk0 + 2 * ai) * 64 + 4 * fr + m] * inv_k + eps);
#pragma unroll
        for (int ai = 0; ai < 2; ++ai) { const int chunk = chunk0 + 2 * ai;
            if (fr == 0) {
#pragma unroll
                for (int m = 0; m < 2; ++m) { float* hp = halo + ((size_t)chunk * 4 + m) * ngu + j0;
#pragma unroll
                    for (int n = 0; n < 2; ++n) { *(f32x4*)(hp + 4 * n) = acc[ai][0][m][n] * rs[ai][m]; *(f32x4*)(hp + dff + 4 * n) = acc[ai][1][m][n] * rs[ai][m]; } } }
            if (fr == 15) {
#pragma unroll
                for (int m = 2; m < 4; ++m) { float* hp = halo + ((size_t)chunk * 4 + m) * ngu + j0;
#pragma unroll
                    for (int n = 0; n < 2; ++n) { *(f32x4*)(hp + 4 * n) = acc[ai][0][m][n] * rs[ai][m]; *(f32x4*)(hp + dff + 4 * n) = acc[ai][1][m][n] * rs[ai][m]; } } } }
        u32x4 pk[2][4];
#pragma unroll
        for (int n = 0; n < 2; ++n) {
            const float* wp = cw + j0 + 4 * n;
            const f32x4 wg0 = *(const f32x4*)(wp), wg1 = *(const f32x4*)(wp + ngu), wg2 = *(const f32x4*)(wp + 2 * ngu);
            const f32x4 wu0 = *(const f32x4*)(wp + dff), wu1 = *(const f32x4*)(wp + ngu + dff), wu2 = *(const f32x4*)(wp + 2 * ngu + dff);
            const f32x4 bg = *(const f32x4*)(cb + j0 + 4 * n), bu = *(const f32x4*)(cb + dff + j0 + 4 * n);
#pragma unroll
            for (int ai = 0; ai < 2; ++ai) {
                f32x4 xg[4], xu[4];
#pragma unroll
                for (int m = 0; m < 4; ++m) { xg[m] = acc[ai][0][m][n] * rs[ai][m]; xu[m] = acc[ai][1][m][n] * rs[ai][m]; }
                f32x4 sg3, sg2, su3, su2;
#pragma unroll
                for (int e = 0; e < 4; ++e) { sg3[e] = dpp_shr1z(xg[3][e]); sg2[e] = dpp_shr1z(xg[2][e]); su3[e] = dpp_shr1z(xu[3][e]); su2[e] = dpp_shr1z(xu[2][e]); }
#pragma unroll
                for (int m = 0; m < 4; ++m) {
                    const f32x4 g1 = m == 0 ? sg3 : xg[m > 0 ? m - 1 : 0], g2 = m == 0 ? sg2 : (m == 1 ? sg3 : xg[m > 1 ? m - 2 : 0]);
                    const f32x4 u1 = m == 0 ? su3 : xu[m > 0 ? m - 1 : 0], u2 = m == 0 ? su2 : (m == 1 ? su3 : xu[m > 1 ? m - 2 : 0]);
                    const f32x4 G = bg + wg0 * g2 + wg1 * g1 + wg2 * xg[m];
                    const f32x4 U = bu + wu0 * u2 + wu1 * u1 + wu2 * xu[m];
                    const f32x4 t = G * (-1.4426950408889634f);
                    f32x4 d; d[0] = __builtin_amdgcn_exp2f(t[0]); d[1] = __builtin_amdgcn_exp2f(t[1]); d[2] = __builtin_amdgcn_exp2f(t[2]); d[3] = __builtin_amdgcn_exp2f(t[3]); d = d + 1.0f;
                    f32x4 r; r[0] = __builtin_amdgcn_rcpf(d[0]); r[1] = __builtin_amdgcn_rcpf(d[1]); r[2] = __builtin_amdgcn_rcpf(d[2]); r[3] = __builtin_amdgcn_rcpf(d[3]);
                    const f32x4 hv = (G * r) * U;
                    if (n == 0) { pk[ai][m].x = cvt_pk_bf16(hv[0], hv[1]); pk[ai][m].y = cvt_pk_bf16(hv[2], hv[3]); }
                    else { pk[ai][m].z = cvt_pk_bf16(hv[0], hv[1]); pk[ai][m].w = cvt_pk_bf16(hv[2], hv[3]); }
                }
            }
        }
#pragma unroll
        for (int ai = 0; ai < 2; ++ai)
#pragma unroll
            for (int m = 0; m < 4; ++m) if (fr > 0 || m >= 2) *(u32x4*)(H + (size_t)((chunk0 + 2 * ai) * 64 + 4 * fr + m) * dff + j0) = pk[ai][m];
    }
};
template <class Epi, class Sched, bool STAMP = false>
__device__ __forceinline__ void gemm_phase(PG8_LAS unsigned char* lds, const Gemm g, const Sched& S, const Epi& E, unsigned long long* stamps) {
    int tid_l = threadIdx.x; asm volatile("" : "+v"(tid_l)); const int tid = tid_l, wid = __builtin_amdgcn_readfirstlane(tid >> 6), lane = tid & 63, wr = wid >> 2, wc = wid & 3, fr = lane & 15, fq = lane >> 4;
    const int K = g.K, nt = K / BK;
    int ts_lo = 0, ts_hi = 0, nts = 0; const unsigned long long rt_entry = STAMP ? (unsigned long long)wall_clock64() : 0ull;
#define PG8_STAMP() do { if (STAMP && wid == 0 && nts < 64) { const unsigned long long _c = (unsigned long long)clock64(); \
        ts_lo = (lane == nts) ? (int)(unsigned)_c : ts_lo; ts_hi = (lane == nts) ? (int)(unsigned)(_c >> 32) : ts_hi; ++nts; } } while (0)
    PG8_STAMP();
    unsigned voffA[2], voffB[2];
#pragma unroll
    for (int i = 0; i < 2; ++i) { int R, C; stage_rc(tid * 16 + i * 8192, R, C); const int Rb = Epi::PERM ? ((R & ~31) + perm32(R & 31)) : R;
        const int Ra = Epi::APERM ? ((R & ~63) + 4 * (R & 15) + ((R >> 4) & 3)) : R;
        voffA[i] = (unsigned)(Ra * K + C) * 2u; voffB[i] = (unsigned)(Rb * K + C) * 2u; }
    const size_t kstep = (size_t)(BK * 2);
    const size_t hstep = (size_t)HALF * K * 2;
    const size_t tstep = 2 * hstep;
    const unsigned ldsw = (unsigned)wid * 1024u;
    const int aoff = lds_byte(wr * 64 + fr, fq * 8), boff = lds_byte(wc * 32 + fr, fq * 8);
#define PG8_SA(b, h) (((b) * 2 + (h)) * HTB)
#define PG8_SB(b, h) ((4 + (b) * 2 + (h)) * HTB)
#define PG8_STAGE(bufoff, gbase, voff) do { _Pragma("unroll") for (int _i = 0; _i < 2; ++_i) \
        __builtin_amdgcn_global_load_lds((const unsigned*)((const char*)(gbase) + (voff)[_i]), (PG8_LAS unsigned*)(lds + (bufoff) + ldsw + _i * 8192), 16, 0, 0); } while (0)
#define PG8_LDA(dst, b, h) do { _Pragma("unroll") for (int m = 0; m < 4; ++m) _Pragma("unroll") for (int k = 0; k < 2; ++k) dst[m][k] = *(const PG8_LAS bf16x8*)(lds + PG8_SA(b, h) + aoff + m * 2048 + k * 1024); } while (0)
#define PG8_LDB(dst, b, h) do { _Pragma("unroll") for (int n = 0; n < 2; ++n) _Pragma("unroll") for (int k = 0; k < 2; ++k) dst[n][k] = *(const PG8_LAS bf16x8*)(lds + PG8_SB(b, h) + boff + n * 2048 + k * 1024); } while (0)
#define PG8_MMA(ai, bj, At, Bt) do { __builtin_amdgcn_s_setprio(1); _Pragma("unroll") for (int m = 0; m < 4; ++m) _Pragma("unroll") for (int n = 0; n < 2; ++n) _Pragma("unroll") for (int k = 0; k < 2; ++k) \
        acc[ai][bj][m][n] = __builtin_amdgcn_mfma_f32_16x16x32_bf16(Bt[n][k], At[m][k], acc[ai][bj][m][n], 0, 0, 0); __builtin_amdgcn_s_setprio(0); } while (0)
#define PG8_WAIT_V(n) asm volatile("s_waitcnt vmcnt(" #n ")" ::: "memory")
#define PG8_WAIT_L(n) asm volatile("s_waitcnt lgkmcnt(" #n ")" ::: "memory")
#define PG8_BAR __builtin_amdgcn_s_barrier()
#define PG8_SCHED __builtin_amdgcn_sched_barrier(0)
    Unit cur, nxt; int ui = 0;
    if (!S.next(0, cur)) return;
    f32x4 acc[2][2][4][2];
#pragma unroll
    for (int a = 0; a < 2; ++a)
#pragma unroll
        for (int b = 0; b < 2; ++b)
#pragma unroll
            for (int m = 0; m < 4; ++m)
#pragma unroll
                for (int n = 0; n < 2; ++n) acc[a][b][m][n] = (f32x4){0.f, 0.f, 0.f, 0.f};
    bf16x8 At[4][2], B0[2][2], B1[2][2];
    const char* cA = (const char*)g.A + (size_t)cur.pm * tstep; const char* cB = (const char*)g.Bt + (size_t)cur.pn * tstep;
    S.a_ready(cur);
    PG8_STAGE(PG8_SB(0, 0), cB, voffB); PG8_STAGE(PG8_SA(0, 0), cA, voffA); PG8_STAGE(PG8_SB(0, 1), cB + hstep, voffB); PG8_STAGE(PG8_SA(0, 1), cA + hstep, voffA);
    if (wr == 1) PG8_BAR;
    PG8_WAIT_V(4); PG8_BAR;
    PG8_STAGE(PG8_SB(1, 0), cB + kstep, voffB); PG8_STAGE(PG8_SA(1, 0), cA + kstep, voffA); PG8_STAGE(PG8_SB(1, 1), cB + hstep + kstep, voffB);
    PG8_WAIT_V(6); PG8_BAR;
    PG8_STAMP();
    for (;;) {
        const bool has_next = S.next(ui + 1, nxt);
        const char* nA = has_next ? (const char*)g.A + (size_t)nxt.pm * tstep : cA; const char* nB = has_next ? (const char*)g.Bt + (size_t)nxt.pn * tstep : cB;
        for (int t = 0; t < nt; t += 2) {
            const bool last = (t == nt - 2);
            const char* a1 = cA + (size_t)(t + 1) * kstep;
            const char* a2 = last ? nA : cA + (size_t)(t + 2) * kstep; const char* b2 = last ? nB : cB + (size_t)(t + 2) * kstep;
            const char* a3 = a2 + kstep; const char* b3 = b2 + kstep;
            if (last && has_next) S.a_ready(nxt);
            PG8_LDB(B0, 0, 0); PG8_SCHED; PG8_LDA(At, 0, 0); PG8_STAGE(PG8_SA(1, 1), a1 + hstep, voffA);
            PG8_WAIT_L(8); PG8_BAR; PG8_WAIT_L(0); PG8_MMA(0, 0, At, B0); PG8_BAR; PG8_SCHED;
            PG8_LDB(B1, 0, 1); PG8_STAGE(PG8_SB(0, 0), b2, voffB);
            PG8_BAR; PG8_WAIT_L(0); PG8_MMA(0, 1, At, B1); PG8_BAR;
            PG8_LDA(At, 0, 1); PG8_STAGE(PG8_SA(0, 0), a2, voffA);
            PG8_BAR; PG8_WAIT_L(0); PG8_MMA(1, 0, At, B0); PG8_BAR; PG8_SCHED;
            PG8_STAGE(PG8_SB(0, 1), b2 + hstep, voffB);
            PG8_WAIT_V(6); PG8_BAR; PG8_MMA(1, 1, At, B1); PG8_BAR;
            PG8_LDB(B0, 1, 0); PG8_SCHED; PG8_LDA(At, 1, 0); PG8_STAGE(PG8_SA(0, 1), a2 + hstep, voffA);
            PG8_WAIT_L(8); PG8_BAR; PG8_WAIT_L(0); PG8_MMA(0, 0, At, B0); PG8_BAR; PG8_SCHED;
            PG8_LDB(B1, 1, 1); PG8_STAGE(PG8_SB(1, 0), b3, voffB);
            PG8_BAR; PG8_WAIT_L(0); PG8_MMA(0, 1, At, B1); PG8_BAR;
            PG8_LDA(At, 1, 1); PG8_STAGE(PG8_SA(1, 0), a3, voffA);
            PG8_BAR; PG8_WAIT_L(0); PG8_MMA(1, 0, At, B0); PG8_BAR; PG8_SCHED;
            PG8_STAGE(PG8_SB(1, 1), b3 + hstep, voffB);
            PG8_WAIT_V(6); PG8_BAR; PG8_MMA(1, 1, At, B1); PG8_BAR;
        }
        PG8_STAMP();
        if constexpr (!Epi::AFTER_DRAIN) { E(acc, cur, wr, wc, fr, fq); S.done(cur); }
        PG8_STAMP();
        if (!has_next) break;
#pragma unroll
        for (int a = 0; a < 2; ++a)
#pragma unroll
            for (int b = 0; b < 2; ++b)
#pragma unroll
                for (int m = 0; m < 4; ++m)
#pragma unroll
                    for (int n = 0; n < 2; ++n) acc[a][b][m][n] = (f32x4){0.f, 0.f, 0.f, 0.f};
        cur = nxt; cA = nA; cB = nB; ++ui;
    }
    PG8_WAIT_V(0);
    if (wr == 0) PG8_BAR;
    PG8_BAR;
    if constexpr (Epi::AFTER_DRAIN) { E.fused(acc, cur, wr, wc, fr, fq, lds, wid, lane); S.done(cur); }
    PG8_STAMP();
    if (STAMP && wid == 0) { stamps[lane] = lane < nts ? (((unsigned long long)(unsigned)ts_hi << 32) | (unsigned)ts_lo) : 0ull;
        if (lane == 62) stamps[62] = rt_entry; if (lane == 63) stamps[63] = (unsigned long long)wall_clock64(); }
#undef PG8_STAMP
#undef PG8_SA
#undef PG8_SB
#undef PG8_STAGE
#undef PG8_LDA
#undef PG8_LDB
#undef PG8_MMA
#undef PG8_WAIT_V
#undef PG8_WAIT_L
#undef PG8_BAR
#undef PG8_SCHED
}
}
#define XB_TMO      128
#define XB_XCNT(j)  (256  + 64 * (j))
#define XB_XSUB(j)  (1280 + 64 * (j))
#define XB_XGEN(j)  (2304 + 64 * (j))
#define XB_TOP      3328
#define XB_TOPGEN   3392
#define XCD_BAR_WORDS 3456
#define XB_SPIN_CAP (1u << 18)
#define LAS __attribute__((address_space(3)))

__device__ __forceinline__ unsigned xb_ld(unsigned* p)              { return __hip_atomic_load(p, __ATOMIC_RELAXED, __HIP_MEMORY_SCOPE_AGENT); }
__device__ __forceinline__ unsigned xb_add(unsigned* p, unsigned v) { return __hip_atomic_fetch_add(p, v, __ATOMIC_RELAXED, __HIP_MEMORY_SCOPE_AGENT); }
__device__ __forceinline__ unsigned xb_xcc_id() { return (unsigned)__builtin_amdgcn_s_getreg((3 << 11) | 20) & 0xFu; }
#define XB_SPIN(cond, bar) do { unsigned _sp = 0; while (cond) { __builtin_amdgcn_s_sleep(1); \
    if ((++_sp & 255u) == 0u) { if (xb_ld(&(bar)[XB_TMO])) break; if (_sp > XB_SPIN_CAP) { atomicAdd(&(bar)[XB_TMO], 1u); break; } } } } while (0)

struct XcdBarrier {
    unsigned* bar; unsigned x;
    volatile LAS unsigned* st;
};

__device__ __forceinline__ XcdBarrier xcd_barrier_post(unsigned* bar, volatile LAS unsigned* st) {
    XcdBarrier b; b.bar = bar; b.x = xb_xcc_id(); b.st = st;
    if (threadIdx.x == 0) (void)xb_add(&bar[XB_XCNT(b.x)], 1u);
    return b;
}
__device__ __forceinline__ void xcd_barrier_complete(unsigned* bar, unsigned x, unsigned& nloc, unsigned& nx) {
    const unsigned G = gridDim.x * gridDim.y * gridDim.z;
    unsigned sum, cnt, mine, sp = 0u;
    for (;;) {
        sum = 0u; cnt = 0u; mine = 0u;
#pragma unroll
        for (unsigned j = 0; j < 16; ++j) { const unsigned c = xb_ld(&bar[XB_XCNT(j)]); sum += c; cnt += (c > 0u) ? 1u : 0u; mine = (j == x) ? c : mine; }
        if (sum == G) break;
        __builtin_amdgcn_s_sleep(1);
        if ((++sp & 255u) == 0u) { if (xb_ld(&bar[XB_TMO])) break; if (sp > XB_SPIN_CAP) { atomicAdd(&bar[XB_TMO], 1u); break; } }
    }
    nloc = mine > 0u ? mine : 1u; nx = cnt > 0u ? cnt : 1u;
}

__device__ __forceinline__ void xcd_barrier(const XcdBarrier& b) {
    asm volatile("s_waitcnt vmcnt(0)" ::: "memory");
    __syncthreads();
    if (threadIdx.x == 0) {
        unsigned* bar = b.bar;
        __builtin_amdgcn_s_waitcnt(0);
        unsigned nloc = b.st[0], nx = b.st[1];
        if (nloc == 0u) { xcd_barrier_complete(bar, b.x, nloc, nx); b.st[0] = nloc; b.st[1] = nx; }
        const unsigned old = xb_add(&bar[XB_XSUB(b.x)], 1u);
        const unsigned gen = old / nloc;
        if (old + 1u == (gen + 1u) * nloc) {
            __builtin_amdgcn_fence(__ATOMIC_RELEASE, "agent");
            asm volatile("s_waitcnt vmcnt(0)" ::: "memory");
            const unsigned og = xb_add(&bar[XB_TOP], 1u);
            const unsigned tg = og / nx;
            if (og + 1u == (tg + 1u) * nx) xb_add(&bar[XB_TOPGEN], 1u);
            else XB_SPIN(xb_ld(&bar[XB_TOPGEN]) == tg, bar);
            __builtin_amdgcn_fence(__ATOMIC_ACQUIRE, "agent");
            xb_add(&bar[XB_XGEN(b.x)], 1u);
            asm volatile("s_waitcnt vmcnt(0)" ::: "memory");
        } else {
            XB_SPIN(xb_ld(&bar[XB_XGEN(b.x)]) == gen, bar);
            __builtin_amdgcn_fence(__ATOMIC_ACQUIRE, "agent");
            asm volatile("s_waitcnt vmcnt(0)" ::: "memory");
        }
    }
    __syncthreads();
}
namespace mk {
#define LAS __attribute__((address_space(3)))
typedef unsigned short bf16_t;
typedef short bf16x8 __attribute__((ext_vector_type(8)));
typedef short s16x4 __attribute__((ext_vector_type(4)));
typedef float f32x16 __attribute__((ext_vector_type(16)));
typedef float f32x4 __attribute__((ext_vector_type(4)));
typedef unsigned u32x4 __attribute__((ext_vector_type(4)));
typedef unsigned u32x2 __attribute__((ext_vector_type(2)));

constexpr int BATCH = 8, SEQ = 2048, DM = 2048, MTOK = BATCH * SEQ, NIN = 6149, NQKV = 6144, DFF = 5632, NGU = 2 * DFF, HD = 128, NTHR = 512;
constexpr float EPS = 1e-6f;
constexpr float LOG2E = 1.4426950408889634f;
constexpr float C2 = 0.08838834764831845f * LOG2E;
constexpr int LDS_STAGE = 131072, LDS_BYTES = LDS_STAGE + 16;

constexpr size_t SZ_WIN = (size_t)NQKV * DM * 2, SZ_WO = (size_t)DM * DM * 2, SZ_WGU = (size_t)NGU * DM * 2, SZ_WD = (size_t)DM * DFF * 2, SZ_WL = SZ_WIN + SZ_WO + SZ_WGU + SZ_WD;
constexpr size_t WS_W = 0;
constexpr size_t WS_ABUF = WS_W + 2 * SZ_WL, SZ_ABUF = (size_t)MTOK * DM * 2;
constexpr size_t WS_PROJ = WS_ABUF + SZ_ABUF, SZ_PROJ = (size_t)MTOK * NQKV * 2;
constexpr size_t WS_HALO = WS_PROJ + SZ_PROJ, SZ_HALO = (size_t)(MTOK / 64) * 4 * NGU * 4;
constexpr size_t WS_H = WS_HALO + SZ_HALO, SZ_H = (size_t)MTOK * DFF * 2;
constexpr size_t WS_FC = WS_H + SZ_H, SZ_FC = (size_t)MTOK * 8 * 4;
constexpr size_t WS_CTR = WS_FC + SZ_FC, WS_BAR = WS_CTR + 256, WS_RSS = WS_BAR + 3456 * 4, WS_KN = WS_RSS + (size_t)4 * MTOK * 4, WS_END = WS_KN + (size_t)2 * MTOK * 16 * 4;

struct Params { const float *x, *g_mix, *w_in, *b_f, *g_head, *w_o, *g_ffn, *w_gu, *conv_w, *conv_b, *w_down, *g_final; float* out; unsigned char* ws; int ph_lo, ph_hi; };

__device__ __forceinline__ unsigned cvtpk(float lo, float hi) { unsigned r; asm volatile("v_cvt_pk_bf16_f32 %0, %1, %2" : "=v"(r) : "v"(lo), "v"(hi)); return r; }

struct CvTile { const float* src; bf16_t* dst; const float* gk; int ldn, K; };
constexpr int CV_PER_LAYER = 3072 + 1024 + 5632 + 2816, CV_TOTAL = 2 * CV_PER_LAYER;
__device__ __forceinline__ CvTile cv_decode(const Params& p, unsigned char* ws, int g) {
    const int l2 = g / CV_PER_LAYER, r = g - l2 * CV_PER_LAYER;
    unsigned char* wl = ws + WS_W + (size_t)l2 * SZ_WL;
    CvTile t; t.gk = nullptr; int ntn, lt; const float* W; bf16_t* Bt; bool gup = false;
    if (r < 3072) { lt = r; ntn = NQKV / 64; W = p.w_in + (size_t)l2 * DM * NIN; t.ldn = NIN; t.K = DM; Bt = (bf16_t*)wl; }
    else if (r < 4096) { lt = r - 3072; ntn = DM / 64; W = p.w_o + (size_t)l2 * DM * DM; t.ldn = DM; t.K = DM; Bt = (bf16_t*)(wl + SZ_WIN); }
    else if (r < 9728) { lt = r - 4096; ntn = NGU / 64; W = p.w_gu + (size_t)l2 * DM * NGU; t.ldn = NGU; t.K = DM; Bt = (bf16_t*)(wl + SZ_WIN + SZ_WO); gup = true; t.gk = p.g_ffn + l2 * DM; }
    else { lt = r - 9728; ntn = DM / 64; W = p.w_down + (size_t)l2 * DFF * DM; t.ldn = DM; t.K = DFF; Bt = (bf16_t*)(wl + SZ_WIN + SZ_WO + SZ_WGU); }
    const int tn = lt % ntn, tk = lt / ntn, k0 = tk * 64, n0 = tn * 64;
    const int nd0 = !gup ? n0 : (n0 < DFF ? (n0 >> 7) * 256 + (n0 & 127) : ((n0 - DFF) >> 7) * 256 + 128 + ((n0 - DFF) & 127));
    t.src = W + (size_t)k0 * t.ldn + n0; t.dst = Bt + (size_t)nd0 * t.K + k0; if (t.gk) t.gk += k0;
    return t;
}
__device__ __forceinline__ void convert_weights(const Params& p, unsigned char* ws, LAS float* tile) {
    int tid_l = threadIdx.x; asm volatile("" : "+v"(tid_l)); const int tid = tid_l, G = gridDim.x;
    const int kk = tid >> 6, nn = tid & 63, n = tid >> 3, kc = (tid & 7) * 8;
    int g = blockIdx.x, it = 0;
    if (g >= CV_TOTAL) return;
    bool has1 = g + G < CV_TOTAL;
    CvTile c0 = cv_decode(p, ws, g), c1 = cv_decode(p, ws, has1 ? g + G : g);
    float v0[8], v1[8];
#pragma unroll
    for (int i = 0; i < 8; ++i) v0[i] = c0.src[(size_t)(i * 8 + kk) * c0.ldn + nn];
#pragma unroll
    for (int i = 0; i < 8; ++i) v1[i] = c1.src[(size_t)(i * 8 + kk) * c1.ldn + nn];
    for (;;) {
        const int gn = g + 2 * G; const bool more = gn < CV_TOTAL, more1 = gn + G < CV_TOTAL;
        CvTile n0 = c0, n1 = c1; float w0[8], w1[8];
        if (more) { n0 = cv_decode(p, ws, gn); n1 = cv_decode(p, ws, more1 ? gn + G : gn);
#pragma unroll
            for (int i = 0; i < 8; ++i) w0[i] = n0.src[(size_t)(i * 8 + kk) * n0.ldn + nn];
#pragma unroll
            for (int i = 0; i < 8; ++i) w1[i] = n1.src[(size_t)(i * 8 + kk) * n1.ldn + nn]; }
        LAS float* tb0 = tile + ((it & 1) * 2) * (64 * 65); LAS float* tb1 = tb0 + 64 * 65;
        if (c0.gk) {
#pragma unroll
            for (int i = 0; i < 8; ++i) v0[i] *= c0.gk[i * 8 + kk]; }
        if (c1.gk) {
#pragma unroll
            for (int i = 0; i < 8; ++i) v1[i] *= c1.gk[i * 8 + kk]; }
#pragma unroll
        for (int i = 0; i < 8; ++i) { tb0[(i * 8 + kk) * 65 + nn] = v0[i]; tb1[(i * 8 + kk) * 65 + nn] = v1[i]; }
        __syncthreads();
        { float f[8];
#pragma unroll
          for (int j = 0; j < 8; ++j) f[j] = tb0[(kc + j) * 65 + n];
          u32x4 w = {cvtpk(f[0], f[1]), cvtpk(f[2], f[3]), cvtpk(f[4], f[5]), cvtpk(f[6], f[7])};
          *(u32x4*)(c0.dst + (size_t)n * c0.K + kc) = w; }
        if (has1) { float f[8];
#pragma unroll
          for (int j = 0; j < 8; ++j) f[j] = tb1[(kc + j) * 65 + n];
          u32x4 w = {cvtpk(f[0], f[1]), cvtpk(f[2], f[3]), cvtpk(f[4], f[5]), cvtpk(f[6], f[7])};
          *(u32x4*)(c1.dst + (size_t)n * c1.K + kc) = w; }
        if (!more) break;
#pragma unroll
        for (int i = 0; i < 8; ++i) { v0[i] = w0[i]; v1[i] = w1[i]; }
        c0 = n0; c1 = n1; has1 = more1; g = gn; ++it;
    }
    __syncthreads();
}

template <bool FC, bool OUTF32>
__device__ __forceinline__ void norm_phase(const float* X, const float* __restrict__ g, bf16_t* hn, float* outf,
                                           const float* __restrict__ w_in_l, float* __restrict__ fcbuf, LAS float* wfc) {
    int tid_l = threadIdx.x; asm volatile("" : "+v"(tid_l)); const int tid = tid_l, wid = tid >> 6, lane = tid & 63;
    if (FC) { for (int i = tid; i < 5 * DM; i += NTHR) { const int d = i / 5, j = i - d * 5; wfc[j * DM + d] = w_in_l[(size_t)d * NIN + NQKV + j]; } __syncthreads(); }
    for (int row = blockIdx.x * 8 + wid; row < MTOK; row += gridDim.x * 8) {
        const float* xr = X + (size_t)row * DM;
        f32x4 v[8];
#pragma unroll
        for (int i = 0; i < 8; ++i) v[i] = *(const f32x4*)(xr + (i * 64 + lane) * 4);
        float ss = 0.f;
#pragma unroll
        for (int i = 0; i < 8; ++i) ss += v[i][0] * v[i][0] + v[i][1] * v[i][1] + v[i][2] * v[i][2] + v[i][3] * v[i][3];
#pragma unroll
        for (int o = 32; o >= 1; o >>= 1) ss += __shfl_xor(ss, o);
        const float rs = 1.0f / sqrtf(ss * (1.0f / DM) + EPS);
        float fc0 = 0.f, fc1 = 0.f, fc2 = 0.f, fc3 = 0.f, fc4 = 0.f;
#pragma unroll
        for (int i = 0; i < 8; ++i) {
            const int d = (i * 64 + lane) * 4;
            const f32x4 gv = *(const f32x4*)(g + d);
            const f32x4 y = v[i] * rs * gv;
            if (OUTF32) *(f32x4*)(outf + (size_t)row * DM + d) = y;
            else { u32x2 w = {cvtpk(y[0], y[1]), cvtpk(y[2], y[3])}; *(u32x2*)(hn + (size_t)row * DM + d) = w; }
            if (FC) {
                const f32x4 w0 = *(const LAS f32x4*)(wfc + 0 * DM + d), w1 = *(const LAS f32x4*)(wfc + 1 * DM + d), w2 = *(const LAS f32x4*)(wfc + 2 * DM + d),
                            w3 = *(const LAS f32x4*)(wfc + 3 * DM + d), w4 = *(const LAS f32x4*)(wfc + 4 * DM + d);
                fc0 += y[0] * w0[0] + y[1] * w0[1] + y[2] * w0[2] + y[3] * w0[3];
                fc1 += y[0] * w1[0] + y[1] * w1[1] + y[2] * w1[2] + y[3] * w1[3];
                fc2 += y[0] * w2[0] + y[1] * w2[1] + y[2] * w2[2] + y[3] * w2[3];
                fc3 += y[0] * w3[0] + y[1] * w3[1] + y[2] * w3[2] + y[3] * w3[3];
                fc4 += y[0] * w4[0] + y[1] * w4[1] + y[2] * w4[2] + y[3] * w4[3];
            }
        }
        if (FC) {
#pragma unroll
            for (int o = 32; o >= 1; o >>= 1) { fc0 += __shfl_xor(fc0, o); fc1 += __shfl_xor(fc1, o); fc2 += __shfl_xor(fc2, o); fc3 += __shfl_xor(fc3, o); fc4 += __shfl_xor(fc4, o); }
            if (lane == 0) { float* f = fcbuf + (size_t)row * 8; f[0] = fc0; f[1] = fc1; f[2] = fc2; f[3] = fc3; f[4] = fc4; }
        }
    }
}

__device__ __forceinline__ void fixup_phase(const float* __restrict__ halo, bf16_t* __restrict__ h, const float* __restrict__ cw, const float* __restrict__ cb) {
    constexpr int NCG = DFF / 4, NCHUNK = MTOK / 64;
    const int total = NCG * NCHUNK * 2;
    int tid_l = threadIdx.x; asm volatile("" : "+v"(tid_l));
    for (int u = blockIdx.x * NTHR + tid_l; u < total; u += gridDim.x * NTHR) {
        const int cgi = u % NCG, rs = u / NCG, slot = rs & 1, chunk = rs >> 1, j = cgi * 4;
        const bool seq0 = (chunk & 31) == 0;
        const f32x4 z = {0.f, 0.f, 0.f, 0.f};
        const float* hc = halo + (size_t)chunk * 4 * NGU + j; const float* hp = hc - (size_t)4 * NGU;
        f32x4 g0, g1, g2, u0, u1, u2;
        if (slot == 0) { g0 = *(const f32x4*)(hc); u0 = *(const f32x4*)(hc + DFF);
            g1 = seq0 ? z : *(const f32x4*)(hp + 3 * NGU); u1 = seq0 ? z : *(const f32x4*)(hp + 3 * NGU + DFF);
            g2 = seq0 ? z : *(const f32x4*)(hp + 2 * NGU); u2 = seq0 ? z : *(const f32x4*)(hp + 2 * NGU + DFF); }
        else { g0 = *(const f32x4*)(hc + NGU); u0 = *(const f32x4*)(hc + NGU + DFF);
            g1 = *(const f32x4*)(hc); u1 = *(const f32x4*)(hc + DFF);
            g2 = seq0 ? z : *(const f32x4*)(hp + 3 * NGU); u2 = seq0 ? z : *(const f32x4*)(hp + 3 * NGU + DFF); }
        const f32x4 wg0 = *(const f32x4*)(cw + j), wg1 = *(const f32x4*)(cw + NGU + j), wg2 = *(const f32x4*)(cw + 2 * NGU + j);
        const f32x4 wu0 = *(const f32x4*)(cw + DFF + j), wu1 = *(const f32x4*)(cw + NGU + DFF + j), wu2 = *(const f32x4*)(cw + 2 * NGU + DFF + j);
        const f32x4 bg = *(const f32x4*)(cb + j), bu = *(const f32x4*)(cb + DFF + j);
        float hv[4];
#pragma unroll
        for (int e = 0; e < 4; ++e) { const float G = bg[e] + wg0[e] * g2[e] + wg1[e] * g1[e] + wg2[e] * g0[e]; const float U = bu[e] + wu0[e] * u2[e] + wu1[e] * u1[e] + wu2[e] * u0[e];
            hv[e] = G / (1.0f + __expf(-G)) * U; }
        u32x2 w = {cvtpk(hv[0], hv[1]), cvtpk(hv[2], hv[3])};
        *(u32x2*)(h + (size_t)(chunk * 64 + slot) * DFF + j) = w;
    }
}

constexpr int SHM_K = 16384, SHM_V = 16384;
constexpr int AT_WS = 65536, AT_TAB = AT_WS + 2048, AT_ITEM = AT_TAB + 9216;
#define KSWZ(row, colB) ((row) * 256 + ((colB) ^ (((row) & 7) << 4)))
#define SBAR() __builtin_amdgcn_sched_barrier(0)
__device__ __forceinline__ int v_st(int k, int c) { const int kk = (k & ~0xC) | ((k & 4) << 1) | ((k & 8) >> 1); return ((kk >> 3) * 4 + (c >> 5)) * 512 + ((kk & 7) * 32 + (c & 31)) * 2; }
__device__ __forceinline__ int v_rd_base(int lane) { return ((lane & 3) << 3) | (((lane >> 2) & 3) << 6) | (((lane >> 4) & 1) << 5) | (((lane >> 5) & 1) << 8); }
constexpr int v_rd_off(int d0, int ks, int half) { return d0 * 512 + ks * 4096 + half * 2048; }
__device__ __forceinline__ int crow(int r, int hi) { return (r & 3) + 8 * (r >> 2) + 4 * hi; }
__device__ __forceinline__ float pl32_max(float x) { auto rr = __builtin_amdgcn_permlane32_swap(__float_as_uint(x), __float_as_uint(x), false, false); return fmaxf(__uint_as_float(rr[0]), __uint_as_float(rr[1])); }
__device__ __forceinline__ float pl32_sum(float x) { auto rr = __builtin_amdgcn_permlane32_swap(__float_as_uint(x), __float_as_uint(x), false, false); return __uint_as_float(rr[0]) + __uint_as_float(rr[1]); }
__device__ __forceinline__ float pl32_other(float x, int hi) { auto rr = __builtin_amdgcn_permlane32_swap(__float_as_uint(x), __float_as_uint(x), false, false); return __uint_as_float(hi ? rr[0] : rr[1]); }

__device__ __forceinline__ void qkt(f32x16& p0, f32x16& p1, const LAS char* Kb, int r32, int hi, const bf16x8* qr) {
    p0 = f32x16{}; p1 = f32x16{};
    const LAS char* kb[4];
#pragma unroll
    for (int dd = 0; dd < 4; ++dd) kb[dd] = Kb + KSWZ(r32, (dd * 16 + hi * 8) * 2);
    __builtin_amdgcn_s_setprio(1);
#pragma unroll
    for (int d0 = 0; d0 < 8; ++d0) { const LAS char* a = kb[d0 & 3] + (d0 >> 2) * 128;
        bf16x8 b0 = *reinterpret_cast<const LAS bf16x8*>(a);
        bf16x8 b1 = *reinterpret_cast<const LAS bf16x8*>(a + 32 * 256);
        p0 = __builtin_amdgcn_mfma_f32_32x32x16_bf16(b0, qr[d0], p0, 0, 0, 0);
        p1 = __builtin_amdgcn_mfma_f32_32x32x16_bf16(b1, qr[d0], p1, 0, 0, 0); }
    __builtin_amdgcn_s_setprio(0);
}
__device__ __forceinline__ void pv_tile(f32x16* o, int vb0, bf16x8 pa0, bf16x8 pa1, bf16x8 pa2, bf16x8 pa3) {
#define TRRD(dst, off) asm volatile("ds_read_b64_tr_b16 %0, %1 offset:%2" : "=&v"(dst) : "v"(vb0), "i"(off) : "memory")
#define PV_D0(d0) do { s16x4 l0, l1, l2, l3, h0, h1, h2, h3; constexpr int b_ = v_rd_off(d0, 0, 0); \
        TRRD(l0, b_); TRRD(h0, b_ + 2048); TRRD(l1, b_ + 4096); TRRD(h1, b_ + 6144); TRRD(l2, b_ + 8192); TRRD(h2, b_ + 10240); TRRD(l3, b_ + 12288); TRRD(h3, b_ + 14336); \
        asm volatile("s_waitcnt lgkmcnt(0)" ::: "memory"); SBAR(); \
        o[d0] = __builtin_amdgcn_mfma_f32_32x32x16_bf16(pa0, (bf16x8){l0[0], l0[1], l0[2], l0[3], h0[0], h0[1], h0[2], h0[3]}, o[d0], 0, 0, 0); \
        o[d0] = __builtin_amdgcn_mfma_f32_32x32x16_bf16(pa1, (bf16x8){l1[0], l1[1], l1[2], l1[3], h1[0], h1[1], h1[2], h1[3]}, o[d0], 0, 0, 0); \
        o[d0] = __builtin_amdgcn_mfma_f32_32x32x16_bf16(pa2, (bf16x8){l2[0], l2[1], l2[2], l2[3], h2[0], h2[1], h2[2], h2[3]}, o[d0], 0, 0, 0); \
        o[d0] = __builtin_amdgcn_mfma_f32_32x32x16_bf16(pa3, (bf16x8){l3[0], l3[1], l3[2], l3[3], h3[0], h3[1], h3[2], h3[3]}, o[d0], 0, 0, 0); } while (0)
    __builtin_amdgcn_s_setprio(1);
    PV_D0(0); PV_D0(1); PV_D0(2); PV_D0(3);
    __builtin_amdgcn_s_setprio(0);
#undef PV_D0
#undef TRRD
}
#define PK4(P, B_, OUT) do { unsigned a0 = cvtpk(P[B_+0], P[B_+1]), a1 = cvtpk(P[B_+2], P[B_+3]); \
        unsigned b0 = cvtpk(P[B_+4], P[B_+5]), b1 = cvtpk(P[B_+6], P[B_+7]); \
        auto r0 = __builtin_amdgcn_permlane32_swap(a0, b0, false, false); auto r1 = __builtin_amdgcn_permlane32_swap(a1, b1, false, false); \
        u32x4 w = {r0[0], r1[0], r0[1], r1[1]}; OUT = *reinterpret_cast<bf16x8*>(&w); } while (0)

template <int TYPE>
__device__ __forceinline__ void attn_item(const bf16_t* __restrict__ proj, bf16_t* __restrict__ obuf, const float* __restrict__ fcbuf, const float* __restrict__ bf_l,
                                          const float* __restrict__ ghead_l, const float* __restrict__ kn, int b, int hl, int qb, LAS char* lds) {
    int tid_l = threadIdx.x; asm volatile("" : "+v"(tid_l)); const int tid = tid_l, wid = __builtin_amdgcn_readfirstlane(tid >> 6), lane = tid & 63, r32 = lane & 31, hi = lane >> 5;
    constexpr int LD = NQKV;
    constexpr int QC = TYPE == 0 ? 0 : (TYPE == 1 ? 2304 : 4224), KC = TYPE == 0 ? 768 : (TYPE == 1 ? 2944 : 4864), VC = TYPE == 0 ? 1536 : (TYPE == 1 ? 3584 : 5504);
    constexpr int HOFF = TYPE == 0 ? 0 : (TYPE == 1 ? 6 : 11);
    const int q0 = qb * 256, qlo = q0 + wid * 32, NT = 4 * (qb + 1);
    const bf16_t* Qp = proj + (size_t)(b * SEQ + qlo + r32) * LD + QC + hl * HD;
    const bf16_t* Kp = proj + (size_t)(b * SEQ) * LD + KC + hl * HD;
    const bf16_t* Vp = proj + (size_t)(b * SEQ) * LD + VC + hl * HD;
    LAS char* V_lds = lds; LAS char* K_lds = lds + 2 * SHM_V;
    LAS float* wsf = (LAS float*)(lds + AT_WS) + wid * 64;
    LAS float* tab = (LAS float*)(lds + AT_TAB);
    LAS int* dflag = (LAS int*)(lds + AT_ITEM + 16);
    const float NEGINF = -__builtin_inff();

    const float slope2 = exp2f(-8.0f * (float)(hl + 1) / 6.0f) * LOG2E;
    float kmax2 = 0.f;
    if (TYPE != 1) {
        LAS float* kred = (LAS float*)(lds + AT_ITEM + 128);
        float mx = 0.f;
        for (int s_ = tid; s_ < q0 + 256; s_ += NTHR) mx = fmaxf(mx, kn[(size_t)(b * SEQ + s_) * 16 + HOFF + hl]);
#pragma unroll
        for (int o_ = 32; o_ >= 1; o_ >>= 1) mx = fmaxf(mx, __shfl_xor(mx, o_));
        if (lane == 0) kred[wid] = mx;
        __syncthreads();
#pragma unroll
        for (int w = 0; w < 8; ++w) kmax2 = fmaxf(kmax2, kred[w]);
    }
    if (TYPE == 0) {
        for (int i = tid; i < 2304; i += NTHR) { const int d = i - 256; float v = NEGINF;
            if (d >= 0) { const int m = (d <= 128 ? 1 : 0) + (((d & 3) == 0 && d <= 512) ? 1 : 0) + ((d & 15) == 0 ? 1 : 0);
                if (m > 0) v = -slope2 * (float)d + (m == 1 ? 0.f : (m == 2 ? 1.0f : 1.5849625007211562f)); }
            tab[i] = v; }
    }
    if (TYPE == 2) {
        const float bf = bf_l[hl]; const int t0 = tid * 4; float lf[4];
#pragma unroll
        for (int j = 0; j < 4; ++j) { const float x = fcbuf[(size_t)(b * SEQ + t0 + j) * 8 + hl] + bf; lf[j] = (fminf(x, 0.f) - log1pf(expf(-fabsf(x)))) * LOG2E; }
        lf[1] += lf[0]; lf[2] += lf[1]; lf[3] += lf[2];
        const float tot = lf[3]; float incl = tot;
#pragma unroll
        for (int o = 1; o < 64; o <<= 1) { const float t = __shfl_up(incl, o); if (lane >= o) incl += t; }
        LAS float* wsum = (LAS float*)(lds + AT_WS);
        if (lane == 63) wsum[wid] = incl;
        __syncthreads();
        float pre = 0.f;
        for (int w = 0; w < wid; ++w) pre += wsum[w];
        const float ex = incl - tot + pre;
#pragma unroll
        for (int j = 0; j < 4; ++j) tab[t0 + j] = ex + lf[j];
    }
    bf16x8 qr[8];
#pragma unroll
    for (int d0 = 0; d0 < 8; ++d0) qr[d0] = *(const bf16x8*)(Qp + d0 * 16 + hi * 8);
    float Bq = 0.f;
    if (TYPE != 1) { float qs = 0.f;
#pragma unroll
        for (int d0 = 0; d0 < 8; ++d0)
#pragma unroll
            for (int e_ = 0; e_ < 8; ++e_) { const float f = __uint_as_float(((unsigned)(unsigned short)qr[d0][e_]) << 16); qs += f * f; }
        qs = pl32_sum(qs);
        Bq = sqrtf(qs) * sqrtf(kmax2) * (1.02f * C2) + 0.5f; }
    const int sr = tid >> 4, sc = (tid & 15) * 8;
    const int kws = KSWZ(sr, sc * 2), vst0 = v_st(sr, sc), vst1 = v_st(32 + sr, sc);
#define TILE_KB(it_) ((NT - 1 - (it_)) * 64)
    bf16x8 st_k0, st_k1, st_v0, st_v1;
#define SLOAD(kb_) do { st_k0 = *(const bf16x8*)(Kp + (size_t)((kb_) + sr) * LD + sc); st_k1 = *(const bf16x8*)(Kp + (size_t)((kb_) + 32 + sr) * LD + sc); \
                        st_v0 = *(const bf16x8*)(Vp + (size_t)((kb_) + sr) * LD + sc); st_v1 = *(const bf16x8*)(Vp + (size_t)((kb_) + 32 + sr) * LD + sc); } while (0)
#define SWRITE(bf_) do { *(LAS bf16x8*)(K_lds + (bf_) * SHM_K + kws) = st_k0; *(LAS bf16x8*)(K_lds + (bf_) * SHM_K + kws + 32 * 256) = st_k1; \
                         *(LAS bf16x8*)(V_lds + (bf_) * SHM_V + vst0) = st_v0; *(LAS bf16x8*)(V_lds + (bf_) * SHM_V + vst1) = st_v1; } while (0)
    SLOAD(TILE_KB(0)); SWRITE(0);
    __syncthreads();
    const int vbase = (int)(unsigned)(uintptr_t)V_lds + v_rd_base(lane);
    float m_reg = -1e30f, l_reg = 0.f, Rc = 1.f;
    bool wdone = false;
    float cq2 = 0.f; if (TYPE == 2) cq2 = tab[qlo + r32];
    f32x16 o[4] = {};
    for (int it = 0; it < NT; ++it) {
        const int cur = it & 1, kbase = TILE_KB(it);
        if (it + 1 < NT) { const int kb2 = TILE_KB(it + 1); SLOAD(kb2); }
        const bool act = !wdone && ((TYPE == 1) ? (kbase <= qlo + 30) : (kbase <= qlo + 31));
        if (act) {
            f32x16 p0, p1;
            qkt(p0, p1, K_lds + cur * SHM_K, r32, hi, qr);
            const int dq = qlo + r32 - 4 * hi - kbase;
            bf16x8 pa0, pa1, pa2, pa3;
            if (TYPE != 1) {
                if (TYPE == 0) {
                    const LAS float* tb = tab + (dq + 256 - 63);
                    f32x16 bz0, bz1;
#pragma unroll
                    for (int r = 0; r < 16; ++r) { const int c = (r & 3) + 8 * (r >> 2); bz0[r] = tb[63 - c]; bz1[r] = tb[31 - c]; }
                    p0 = p0 * C2 + bz0; p1 = p1 * C2 + bz1;
                } else {
                    f32x16 kz0, kz1;
#pragma unroll
                    for (int g = 0; g < 4; ++g) { const f32x4 ck0 = *(const LAS f32x4*)(tab + kbase + 8 * g + 4 * hi), ck1 = *(const LAS f32x4*)(tab + kbase + 32 + 8 * g + 4 * hi);
#pragma unroll
                        for (int j = 0; j < 4; ++j) { kz0[4 * g + j] = ck0[j]; kz1[4 * g + j] = ck1[j]; } }
                    p0 = p0 * C2 + (cq2 - kz0); p1 = p1 * C2 + (cq2 - kz1);
                    if (kbase + 63 > qlo) {
#pragma unroll
                        for (int r = 0; r < 16; ++r) { const int c = (r & 3) + 8 * (r >> 2); if (dq - c < 0) p0[r] = NEGINF; if (dq - c - 32 < 0) p1[r] = NEGINF; }
                    }
                }
                float pmax = p0[0];
#pragma unroll
                for (int r = 1; r < 16; ++r) pmax = fmaxf(pmax, p0[r]);
#pragma unroll
                for (int r = 0; r < 16; ++r) pmax = fmaxf(pmax, p1[r]);
                pmax = pl32_max(pmax);
                float mn, alpha;
                if (__all((pmax - m_reg) <= 11.5f)) { mn = m_reg; alpha = 1.f; }
                else { mn = fmaxf(m_reg, pmax); alpha = __builtin_amdgcn_exp2f(m_reg - mn); m_reg = mn; }
                float ps = 0.f;
                { const float nm = -mn; f32x16 nmv; for (int r = 0; r < 16; ++r) nmv[r] = nm; p0 = p0 + nmv; p1 = p1 + nmv; }
#pragma unroll
                for (int r = 0; r < 16; ++r) { p0[r] = __builtin_amdgcn_exp2f(p0[r]); p1[r] = __builtin_amdgcn_exp2f(p1[r]); }
                { const f32x16 sv = p0 + p1; const f32x4 s4 = (f32x4){sv[0], sv[1], sv[2], sv[3]} + (f32x4){sv[4], sv[5], sv[6], sv[7]} + (f32x4){sv[8], sv[9], sv[10], sv[11]} + (f32x4){sv[12], sv[13], sv[14], sv[15]};
                  ps = (s4[0] + s4[1]) + (s4[2] + s4[3]); }
                ps = pl32_sum(ps);
                l_reg = l_reg * alpha + ps;
                if (__any(alpha < 1.f)) {
                    if (hi == 0) wsf[32 + r32] = alpha;
                    asm volatile("s_waitcnt lgkmcnt(0)" ::: "memory");
#pragma unroll
                    for (int r = 0; r < 16; ++r) { const float a = wsf[32 + crow(r, hi)];
#pragma unroll
                        for (int d_ = 0; d_ < 4; ++d_) o[d_][r] *= a; }
                }
            } else {
                f32x16 l0, l1;
                const bool diag = (kbase + 63 >= qlo);
#pragma unroll
                for (int r = 0; r < 16; ++r) { const int c = (r & 3) + 8 * (r >> 2);
                    float u0 = __builtin_amdgcn_rcpf(1.0f + __builtin_amdgcn_exp2f(p0[r] * C2));
                    float u1 = __builtin_amdgcn_rcpf(1.0f + __builtin_amdgcn_exp2f(p1[r] * C2));
                    float s0 = 1.0f - u0, s1 = 1.0f - u1;
                    if (diag) { if (dq - c <= 0) { u0 = 1.f; s0 = 0.f; } if (dq - c - 32 <= 0) { u1 = 1.f; s1 = 0.f; } }
                    p0[r] = s0; p1[r] = s1; l0[r] = u0; l1[r] = u1; }
                float cs[2][4], pc[2][4];
#pragma unroll
                for (int g = 0; g < 4; ++g) { cs[0][g] = (l0[4 * g] * l0[4 * g + 1]) * (l0[4 * g + 2] * l0[4 * g + 3]); cs[1][g] = (l1[4 * g] * l1[4 * g + 1]) * (l1[4 * g + 2] * l1[4 * g + 3]); }
#pragma unroll
                for (int g = 0; g < 4; ++g) { pc[0][g] = pl32_other(cs[0][g], hi); pc[1][g] = pl32_other(cs[1][g], hi); }
                float run = Rc;
#pragma unroll
                for (int p = 1; p >= 0; --p)
#pragma unroll
                    for (int g = 3; g >= 0; --g) {
                        float acc = hi == 0 ? run * pc[p][g] : run;
                        run *= cs[p][g] * pc[p][g];
#pragma unroll
                        for (int j = 3; j >= 0; --j) { if (p == 0) { const float a = p0[4 * g + j] * acc; acc *= l0[4 * g + j]; p0[4 * g + j] = a; }
                                                       else { const float a = p1[4 * g + j] * acc; acc *= l1[4 * g + j]; p1[4 * g + j] = a; } }
                    }
                Rc = run;
            }
            PK4(p0, 0, pa0); PK4(p0, 8, pa1); PK4(p1, 0, pa2); PK4(p1, 8, pa3);
            pv_tile(o, vbase + cur * SHM_V, pa0, pa1, pa2, pa3);
        }
        if (it + 1 < NT) { SWRITE(cur ^ 1); }
        { bool drow;
          if (TYPE == 1) drow = Rc < 1e-30f;
          else {
              const float bmax = (TYPE == 0) ? (1.5849625f - slope2 * (float)(qlo + r32 - kbase + 1)) : (cq2 - tab[kbase > 0 ? kbase - 1 : 0]);
              drow = (Bq + bmax - m_reg) < -64.f; }
          const int dn = (wdone || __all(drow)) ? 1 : 0; wdone = dn != 0; if (lane == 0) dflag[(it & 1) * 8 + wid] = dn; }
        __syncthreads();
        { const LAS int* f = dflag + (it & 1) * 8; if ((f[0] & f[1] & f[2] & f[3] & f[4] & f[5] & f[6] & f[7]) != 0) break; }
    }
    float rli[16];
    if (TYPE != 1) {
        if (hi == 0) wsf[r32] = l_reg;
        asm volatile("s_waitcnt lgkmcnt(0)" ::: "memory");
#pragma unroll
        for (int r = 0; r < 16; ++r) rli[r] = 1.0f / wsf[crow(r, hi)];
    } else {
#pragma unroll
        for (int r = 0; r < 16; ++r) rli[r] = 1.0f;
    }
    float gh[4];
#pragma unroll
    for (int d0 = 0; d0 < 4; ++d0) gh[d0] = ghead_l[(HOFF + hl) * HD + d0 * 32 + r32];
    bf16_t* Ow = obuf + (size_t)(b * SEQ + qlo) * DM + (HOFF + hl) * HD;
#pragma unroll
    for (int r = 0; r < 16; ++r) {
        float v[4], ss = 0.f;
#pragma unroll
        for (int d0 = 0; d0 < 4; ++d0) { v[d0] = o[d0][r] * rli[r]; ss += v[d0] * v[d0]; }
        ss += __shfl_xor(ss, 1); ss += __shfl_xor(ss, 2); ss += __shfl_xor(ss, 4); ss += __shfl_xor(ss, 8); ss += __shfl_xor(ss, 16);
        const float scl = 1.0f / sqrtf(ss * (1.0f / HD) + EPS);
        const int orow = crow(r, hi);
#pragma unroll
        for (int d0 = 0; d0 < 4; ++d0) { const float y = v[d0] * scl * gh[d0]; const float yn = __shfl_xor(y, 1);
            if ((r32 & 1) == 0) *(unsigned*)(Ow + (size_t)orow * DM + d0 * 32 + r32) = cvtpk(y, yn); }
    }
    __syncthreads();
#undef TILE_KB
#undef SLOAD
#undef SWRITE
}

__device__ __forceinline__ void attn_phase(const bf16_t* proj, bf16_t* obuf, const float* fcbuf, const float* bf_l, const float* ghead_l, const float* kn, unsigned* ctr, LAS char* lds) {
    LAS int* item_s = (LAS int*)(lds + AT_ITEM);
    for (;;) {
        if (threadIdx.x == 0) *item_s = (int)atomicAdd(ctr, 1u);
        __syncthreads();
        const int i = *item_s;
        __syncthreads();
        if (i >= 1024) break;
        int qb, hh, b;
        if (i < 192) { qb = 7 - i / 24; const int r = i % 24; b = r / 3; hh = 3 + r % 3; }
        else if (i < 512) { const int j = i - 192; qb = 7 - j / 40; const int r = j % 40; b = r / 5; hh = 11 + r % 5; }
        else if (i < 704) { const int j = i - 512; qb = 7 - j / 24; const int r = j % 24; b = r / 3; hh = r % 3; }
        else { const int j = i - 704; qb = 7 - j / 40; const int r = j % 40; b = r / 5; hh = 6 + r % 5; }
        if (hh < 6) attn_item<0>(proj, obuf, fcbuf, bf_l, ghead_l, kn, b, hh, qb, lds);
        if (hh >= 6 && hh < 11) attn_item<1>(proj, obuf, fcbuf, bf_l, ghead_l, kn, b, hh - 6, qb, lds);
        if (hh >= 11) attn_item<2>(proj, obuf, fcbuf, bf_l, ghead_l, kn, b, hh - 11, qb, lds);
    }
}

__global__ void __launch_bounds__(NTHR) fwd(Params p) {
    extern __shared__ __attribute__((aligned(16))) unsigned char lds_raw[];
    LAS unsigned char* lds = (LAS unsigned char*)lds_raw;
    cg::grid_group grid = cg::this_grid();
    unsigned char* ws = p.ws;
    bf16_t* abuf = (bf16_t*)(ws + WS_ABUF); bf16_t* proj = (bf16_t*)(ws + WS_PROJ); bf16_t* hbuf = (bf16_t*)(ws + WS_H); float* halo = (float*)(ws + WS_HALO);
    float* fcbuf = (float*)(ws + WS_FC); unsigned* ctr = (unsigned*)(ws + WS_CTR); float* rss = (float*)(ws + WS_RSS); float* kn = (float*)(ws + WS_KN); bf16_t* xbf = proj;
    if (threadIdx.x < 4) ((LAS unsigned*)(lds + LDS_STAGE))[threadIdx.x] = 0u;
    __syncthreads();
    XcdBarrier xb; xb.bar = (unsigned*)(ws + WS_BAR); xb.x = xb_xcc_id(); xb.st = (volatile LAS unsigned*)(lds + LDS_STAGE);
    { unsigned* z = (unsigned*)(ws + WS_CTR); const size_t nz = (WS_END - WS_CTR) / 4;
      for (size_t i = (size_t)blockIdx.x * NTHR + threadIdx.x; i < nz; i += (size_t)gridDim.x * NTHR) z[i] = 0u; }
    int vc = blockIdx.x;
    int ph = 0;
#define PH_BEGIN if (ph >= p.ph_lo && ph < p.ph_hi) { if (ph > p.ph_lo) { if (ph == p.ph_lo + 1) { grid.sync(); \
            if (threadIdx.x == 0) xb.st[2] = xb_add(&xb.bar[XB_XCNT(xb.x)], 1u);     \
            __syncthreads(); } \
          else { xcd_barrier(xb); \
            if (ph == p.ph_lo + 2) { bool okc = true; for (int j = 0; j < 16; ++j) okc = okc && (xb_ld(&xb.bar[XB_XCNT(j)]) == (j < 8 ? 32u : 0u)); \
                if (okc) vc = 8 * (int)xb.st[2] + (int)xb.x; } } }
#define PH_END } ++ph;
    for (int l = 0; l < 2; ++l) {
        const float* xin = (l == 0) ? p.x : p.out;
        bf16_t* WinT = (bf16_t*)(ws + WS_W + (size_t)l * SZ_WL); bf16_t* WoT = (bf16_t*)((unsigned char*)WinT + SZ_WIN); bf16_t* WguT = (bf16_t*)((unsigned char*)WoT + SZ_WO); bf16_t* WdT = (bf16_t*)((unsigned char*)WguT + SZ_WGU);
        PH_BEGIN
            if (l == 0) {
                convert_weights(p, ws, (LAS float*)lds);
            }
            norm_phase<true, false>(xin, p.g_mix + l * DM, abuf, nullptr, p.w_in + (size_t)l * DM * NIN, fcbuf, (LAS float*)lds);
        PH_END
        PH_BEGIN
            pg8::Gemm g{abuf, WinT, MTOK, NQKV, DM}; pg8::StaticOrder S; S.init(MTOK, NQKV, gridDim.x, vc);
            pg8::EpiProj E{proj, NQKV, kn + (size_t)l * MTOK * 16};
            pg8::gemm_phase<pg8::EpiProj, pg8::StaticOrder>(lds, g, S, E, nullptr);
        PH_END
        PH_BEGIN
            attn_phase(proj, abuf, fcbuf, p.b_f + l * 5, p.g_head + l * DM, kn + (size_t)l * MTOK * 16, ctr + l * 16, (LAS char*)lds);
        PH_END
        PH_BEGIN
            pg8::Gemm g{abuf, WoT, MTOK, DM, DM}; pg8::StaticOrder S; S.init(MTOK, DM, gridDim.x, vc);
            pg8::EpiResN E{xin, p.out, xbf, rss + (size_t)l * MTOK, DM};
            pg8::gemm_phase<pg8::EpiResN, pg8::StaticOrder>(lds, g, S, E, nullptr);
        PH_END
        PH_BEGIN
            pg8::Gemm g{xbf, WguT, MTOK, NGU, DM}; pg8::StaticOrder S; S.init(MTOK, NGU, gridDim.x, vc);
            pg8::EpiConv E{hbuf, halo, p.conv_w + (size_t)l * 3 * NGU, p.conv_b + (size_t)l * NGU, DFF, rss + (size_t)l * MTOK, 1.0f / DM, EPS};
            pg8::gemm_phase<pg8::EpiConv, pg8::StaticOrder>(lds, g, S, E, nullptr);
        PH_END
        PH_BEGIN
            fixup_phase(halo, hbuf, p.conv_w + (size_t)l * 3 * NGU, p.conv_b + (size_t)l * NGU);
        PH_END
        PH_BEGIN
            pg8::Gemm g{hbuf, WdT, MTOK, DM, DFF}; pg8::StaticOrder S; S.init(MTOK, DM, gridDim.x, vc);
            pg8::EpiRes E{p.out, p.out, DM};
            pg8::gemm_phase<pg8::EpiRes, pg8::StaticOrder>(lds, g, S, E, nullptr);
        PH_END
    }
    PH_BEGIN
        norm_phase<false, true>(p.out, p.g_final, nullptr, p.out, nullptr, nullptr, (LAS float*)lds);
    PH_END
#undef PH_BEGIN
#undef PH_END
}
}

extern "C" void kernel_launch(void* const* d_in, const int* in_sizes, int n_in, void* d_out, int out_size, void* d_ws, size_t ws_size, hipStream_t stream) {
    static int grid_blocks = 0;
    if (!grid_blocks) {
        if (n_in != 12 || ws_size < mk::WS_END) { fprintf(stderr, "kernel_launch: unexpected n_in %d or ws_size %zu (< %zu)\n", n_in, ws_size, (size_t)mk::WS_END); grid_blocks = -1; return; }
        int dev = 0, cus = 0, per_cu = 0;
        (void)hipGetDevice(&dev);
        if (hipDeviceGetAttribute(&cus, hipDeviceAttributeMultiprocessorCount, dev) != hipSuccess || cus <= 0) cus = 256;
        if (hipFuncSetAttribute((const void*)mk::fwd, hipFuncAttributeMaxDynamicSharedMemorySize, mk::LDS_BYTES) != hipSuccess) fprintf(stderr, "kernel_launch: hipFuncSetAttribute failed\n");
        if (hipOccupancyMaxActiveBlocksPerMultiprocessor(&per_cu, (const void*)mk::fwd, mk::NTHR, mk::LDS_BYTES) != hipSuccess || per_cu < 1) { per_cu = 1; (void)hipGetLastError(); }
        grid_blocks = cus * per_cu;
    }
    if (grid_blocks < 0) return;
    mk::Params p{};
    p.x = (const float*)d_in[0]; p.g_mix = (const float*)d_in[1]; p.w_in = (const float*)d_in[2]; p.b_f = (const float*)d_in[3]; p.g_head = (const float*)d_in[4];
    p.w_o = (const float*)d_in[5]; p.g_ffn = (const float*)d_in[6]; p.w_gu = (const float*)d_in[7]; p.conv_w = (const float*)d_in[8]; p.conv_b = (const float*)d_in[9];
    p.w_down = (const float*)d_in[10]; p.g_final = (const float*)d_in[11];
    p.out = (float*)d_out; p.ws = (unsigned char*)d_ws; p.ph_lo = 0; p.ph_hi = 1000;
    void* args[] = {&p};
    hipError_t e = hipLaunchCooperativeKernel((void*)mk::fwd, dim3(grid_blocks), dim3(mk::NTHR), args, mk::LDS_BYTES, stream);
    if (e != hipSuccess) fprintf(stderr, "cooperative launch failed: %s (grid %d)\n", hipGetErrorString(e), grid_blocks);
}
```

```cpp
#include <hip/hip_runtime.h>
#include <hip/hip_cooperative_groups.h>
#include <cstdio>
#include <cstdint>
namespace cg = cooperative_groups;
namespace pg8 {
#define PG8_LAS __attribute__((address_space(3)))
typedef unsigned short bf16_t;
typedef short bf16x8 __attribute__((ext_vector_type(8)));
typedef float f32x4 __attribute__((ext_vector_type(4)));
typedef unsigned u32x4 __attribute__((ext_vector_type(4)));
constexpr int BM = 256, BK = 64, HALF = 128, HTB = HALF * BK * 2  , STAGE_BYTES = 8 * HTB, NXCD = 8, WGM = 8;

__host__ __device__ __forceinline__ int lds_byte(int r, int c) { const int st = (r >> 4) * 2 + (c >> 5), rr = r & 15, cc = c & 31, ob = rr * 64 + cc * 2; return st * 1024 + (ob ^ (((ob >> 9) & 1) << 5)); }
__host__ __device__ __forceinline__ void stage_rc(int b, int& R, int& C) { const int st = b / 1024, sb = b % 1024, swz = sb ^ (((sb >> 9) & 1) << 5); R = (st >> 1) * 16 + swz / 64; C = (st & 1) * 32 + (swz % 64) / 2; }
__host__ __device__ __forceinline__ int perm32(int rho) { const int n = rho >> 4, i = rho & 15; return 8 * (i >> 2) + 4 * n + (i & 3); }

struct Unit { int pm, pn; };
struct Gemm { const bf16_t* A; const bf16_t* Bt; int M, N, K; };

struct StaticOrder {
    int nM, nN, nwg, G, c;
    __host__ __device__ void init(int M, int N, int G_, int c_) { nM = M / BM; nN = N / BM; nwg = nM * nN; G = G_; c = c_; }
    __host__ __device__ __forceinline__ bool next(int i, Unit& u) const {
        const long L = (long)i * G + c; if (L >= nwg) return false;
        int wgid = (int)L; { const int q = nwg / NXCD, r = nwg % NXCD, xcd = wgid % NXCD, off = wgid / NXCD; wgid = (xcd < r ? xcd * (q + 1) : r * (q + 1) + (xcd - r) * q) + off; }
        const int nig = WGM * nN, gid = wgid / nig, fm = gid * WGM, gsz = (nM - fm) < WGM ? (nM - fm) : WGM;
        u.pm = fm + ((wgid % nig) % gsz); u.pn = (wgid % nig) / gsz; return true;
    }
    __device__ __forceinline__ void a_ready(const Unit&) const {}
    __device__ __forceinline__ void done(const Unit&) const {}
};
struct CountedOrder : StaticOrder {
    const unsigned* ready; unsigned need; unsigned* tmo;
    __device__ __forceinline__ void a_ready(const Unit& u) const {
        if (threadIdx.x < 64) {
            const unsigned long long t0 = __builtin_amdgcn_s_memrealtime(); unsigned polls = 0;
            while ((unsigned)__builtin_amdgcn_readfirstlane(__hip_atomic_load(ready + 64 * u.pm, __ATOMIC_RELAXED, __HIP_MEMORY_SCOPE_AGENT)) < need) {
                if ((++polls & 255u) == 0u && __builtin_amdgcn_readfirstlane(__hip_atomic_load(tmo, __ATOMIC_RELAXED, __HIP_MEMORY_SCOPE_AGENT)) != 0u) break;
                if (__builtin_amdgcn_s_memrealtime() - t0 > 2000000ull) {
                    if (threadIdx.x == 0) { unsigned expect = 0u; __hip_atomic_compare_exchange_strong(tmo + 1, &expect, 0x600u | (unsigned)(u.pm & 0xff), __ATOMIC_RELAXED, __ATOMIC_RELAXED, __HIP_MEMORY_SCOPE_AGENT); __hip_atomic_store(tmo, 1u, __ATOMIC_RELAXED, __HIP_MEMORY_SCOPE_AGENT); }
                    break; }
                __builtin_amdgcn_s_sleep(2); }
            __builtin_amdgcn_fence(__ATOMIC_ACQUIRE, "agent");
            asm volatile("s_waitcnt vmcnt(0)" ::: "memory");
        }
#if !defined(BROKEN_HOOK_NO_BARRIER)
        asm volatile("" ::: "memory"); __builtin_amdgcn_s_barrier(); asm volatile("" ::: "memory");
#endif
    }
};

__device__ __forceinline__ unsigned cvt_pk_bf16(float lo, float hi) { unsigned r; asm volatile("v_cvt_pk_bf16_f32 %0, %1, %2" : "=v"(r) : "v"(lo), "v"(hi)); return r; }
typedef float f32x2 __attribute__((ext_vector_type(2)));
__device__ __forceinline__ f32x2 gelu_pk(f32x2 v) {
    const f32x2 av = __builtin_elementwise_abs(v), d = av * 0.2316418882f + 1.0f;
    f32x2 t; t.x = __builtin_amdgcn_rcpf(d.x); t.y = __builtin_amdgcn_rcpf(d.y);
    f32x2 q = t * 0.5307027145f + (-0.7265760135f); q = q * t + 0.7107068705f; q = q * t + (-0.142248368f); q = q * t + 0.127414796f; q = q * t;
    const f32x2 s = (v * v) * (-0.72134752044f);
    f32x2 e; e.x = __builtin_amdgcn_exp2f(s.x); e.y = __builtin_amdgcn_exp2f(s.y);
    const f32x2 m = v * (q * e), r = v - m;
    f32x2 o; o.x = v.x < 0.f ? m.x : r.x; o.y = v.y < 0.f ? m.y : r.y; return o;
}

struct EpiF32 {
    static constexpr bool PERM = false, AFTER_DRAIN = false;
    float* C; int ldc; const float* bias;
    __device__ __forceinline__ void operator()(const f32x4 (&acc)[2][2][4][2], const Unit& u, int wr, int wc, int fr, int fq) const {
        const int row0 = u.pm * BM + wr * 64 + fr, col0 = u.pn * BM + wc * 32 + 4 * fq;
        f32x4 bv[2][2];
#pragma unroll
        for (int bj = 0; bj < 2; ++bj)
#pragma unroll
            for (int n = 0; n < 2; ++n) bv[bj][n] = bias ? *(const f32x4*)(bias + col0 + bj * HALF + n * 16) : (f32x4){0.f, 0.f, 0.f, 0.f};
#pragma unroll
        for (int ai = 0; ai < 2; ++ai)
#pragma unroll
            for (int m = 0; m < 4; ++m) { float* rowp = C + (size_t)(row0 + ai * HALF + m * 16) * ldc + col0;
#pragma unroll
                for (int bj = 0; bj < 2; ++bj)
#pragma unroll
                    for (int n = 0; n < 2; ++n) *(f32x4*)(rowp + bj * HALF + n * 16) = acc[ai][bj][m][n] + bv[bj][n]; }
    }
};
template <int ACT  > struct EpiBf16 {
    static constexpr bool PERM = true, AFTER_DRAIN = false;
    bf16_t* O; int ldc; const float* bias; int split_cols; size_t split_stride;
    __device__ __forceinline__ void operator()(const f32x4 (&acc)[2][2][4][2], const Unit& u, int wr, int wc, int fr, int fq) const {
        const int row0 = u.pm * BM + wr * 64 + fr; int colt = u.pn * BM; bf16_t* base = O;
        if (split_cols) { const int t = colt / split_cols; base += (size_t)t * split_stride; colt -= t * split_cols; }
        const int col0 = colt + wc * 32 + 8 * fq, bcol0 = u.pn * BM + wc * 32 + 8 * fq;
        f32x4 bv[2][2];
#pragma unroll
        for (int bj = 0; bj < 2; ++bj)
#pragma unroll
            for (int n = 0; n < 2; ++n) bv[bj][n] = bias ? *(const f32x4*)(bias + bcol0 + bj * HALF + 4 * n) : (f32x4){0.f, 0.f, 0.f, 0.f};
#pragma unroll
        for (int ai = 0; ai < 2; ++ai)
#pragma unroll
            for (int m = 0; m < 4; ++m) { bf16_t* rowp = base + (size_t)(row0 + ai * HALF + m * 16) * ldc + col0;
#pragma unroll
                for (int bj = 0; bj < 2; ++bj) { f32x4 v0 = acc[ai][bj][m][0] + bv[bj][0], v1 = acc[ai][bj][m][1] + bv[bj][1];
                    if (ACT == 1) { f32x2 a = gelu_pk((f32x2){v0[0], v0[1]}), b = gelu_pk((f32x2){v0[2], v0[3]}), c = gelu_pk((f32x2){v1[0], v1[1]}), d = gelu_pk((f32x2){v1[2], v1[3]});
                        v0 = (f32x4){a.x, a.y, b.x, b.y}; v1 = (f32x4){c.x, c.y, d.x, d.y}; }
                    if (ACT == 2) {
#pragma unroll
                        for (int j = 0; j < 4; ++j) { v0[j] = 0.5f * v0[j] * (1.0f + erff(v0[j] * 0.70710678f)); v1[j] = 0.5f * v1[j] * (1.0f + erff(v1[j] * 0.70710678f)); } }
                    u32x4 w; w.x = cvt_pk_bf16(v0[0], v0[1]); w.y = cvt_pk_bf16(v0[2], v0[3]); w.z = cvt_pk_bf16(v1[0], v1[1]); w.w = cvt_pk_bf16(v1[2], v1[3]);
                    *(u32x4*)(rowp + bj * HALF) = w; } }
    }
};
struct EpiRes {
    static constexpr bool PERM = false, AFTER_DRAIN = false, APERM = false;
    const float* base; float* out; int ldc;
    __device__ __forceinline__ void operator()(const f32x4 (&acc)[2][2][4][2], const Unit& u, int wr, int wc, int fr, int fq) const {
        const int row0 = u.pm * BM + wr * 64 + fr, col0 = u.pn * BM + wc * 32 + 4 * fq;
#pragma unroll
        for (int ai = 0; ai < 2; ++ai) {
            f32x4 bv[4][2][2];
#pragma unroll
            for (int m = 0; m < 4; ++m) { const size_t off = (size_t)(row0 + ai * HALF + m * 16) * ldc + col0;
#pragma unroll
                for (int bj = 0; bj < 2; ++bj)
#pragma unroll
                    for (int n = 0; n < 2; ++n) bv[m][bj][n] = *(const f32x4*)(base + off + bj * HALF + n * 16); }
            asm volatile("" ::: "memory");
#pragma unroll
            for (int m = 0; m < 4; ++m) { const size_t off = (size_t)(row0 + ai * HALF + m * 16) * ldc + col0;
#pragma unroll
                for (int bj = 0; bj < 2; ++bj)
#pragma unroll
                    for (int n = 0; n < 2; ++n) *(f32x4*)(out + off + bj * HALF + n * 16) = acc[ai][bj][m][n] + bv[m][bj][n]; }
            asm volatile("" ::: "memory");
        }
    }
};
struct EpiResN {
    static constexpr bool PERM = true, AFTER_DRAIN = false, APERM = false;
    const float* base; float* out; bf16_t* xb; float* rowss; int ldc;
    __device__ __forceinline__ void operator()(const f32x4 (&acc)[2][2][4][2], const Unit& u, int wr, int wc, int fr, int fq) const {
        const int row0 = u.pm * BM + wr * 64 + fr, col0 = u.pn * BM + wc * 32 + 8 * fq;
#pragma unroll
        for (int ai = 0; ai < 2; ++ai)
#pragma unroll
          for (int mh = 0; mh < 2; ++mh) {
            f32x4 bv[2][2][2];
#pragma unroll
            for (int mm = 0; mm < 2; ++mm) { const size_t off = (size_t)(row0 + ai * HALF + (mh * 2 + mm) * 16) * ldc + col0;
#pragma unroll
                for (int bj = 0; bj < 2; ++bj)
#pragma unroll
                    for (int n = 0; n < 2; ++n) bv[mm][bj][n] = *(const f32x4*)(base + off + bj * HALF + n * 4); }
            asm volatile("" ::: "memory");
#pragma unroll
            for (int mm = 0; mm < 2; ++mm) { const int m = mh * 2 + mm; const int row = row0 + ai * HALF + m * 16; const size_t off = (size_t)row * ldc + col0; float ss = 0.f;
#pragma unroll
                for (int bj = 0; bj < 2; ++bj) {
                    const f32x4 v0 = acc[ai][bj][m][0] + bv[mm][bj][0], v1 = acc[ai][bj][m][1] + bv[mm][bj][1];
                    *(f32x4*)(out + off + bj * HALF) = v0; *(f32x4*)(out + off + bj * HALF + 4) = v1;
                    u32x4 w; w.x = cvt_pk_bf16(v0[0], v0[1]); w.y = cvt_pk_bf16(v0[2], v0[3]); w.z = cvt_pk_bf16(v1[0], v1[1]); w.w = cvt_pk_bf16(v1[2], v1[3]);
                    *(u32x4*)(xb + off + bj * HALF) = w;
                    { const f32x4 q4 = v0 * v0 + v1 * v1; ss += (q4[0] + q4[1]) + (q4[2] + q4[3]); } }
                ss += __shfl_xor(ss, 16); ss += __shfl_xor(ss, 32);
                if (fq == 0) atomicAdd(rowss + row, ss); }
            asm volatile("" ::: "memory");
          }
    }
};
struct EpiProj {
    static constexpr bool PERM = true, AFTER_DRAIN = false, APERM = false;
    bf16_t* O; int ldc; float* kn;
    __device__ __forceinline__ void operator()(const f32x4 (&acc)[2][2][4][2], const Unit& u, int wr, int wc, int fr, int fq) const {
        const int row0 = u.pm * BM + wr * 64 + fr, col0 = u.pn * BM + wc * 32 + 8 * fq;
        int slot0 = -1, slot1 = -1;
        if (u.pn >= 3 && u.pn <= 5) { slot0 = (u.pn - 3) * 2; slot1 = slot0 + 1; }
        else if (u.pn >= 19 && u.pn <= 21) { slot0 = 11 + (u.pn - 19) * 2; slot1 = slot0 + 1 <= 15 ? slot0 + 1 : -1; }
#pragma unroll
        for (int ai = 0; ai < 2; ++ai)
#pragma unroll
            for (int m = 0; m < 4; ++m) { const int row = row0 + ai * HALF + m * 16; bf16_t* rowp = O + (size_t)row * ldc + col0;
#pragma unroll
                for (int bj = 0; bj < 2; ++bj) { const f32x4 v0 = acc[ai][bj][m][0], v1 = acc[ai][bj][m][1];
                    u32x4 w; w.x = cvt_pk_bf16(v0[0], v0[1]); w.y = cvt_pk_bf16(v0[2], v0[3]); w.z = cvt_pk_bf16(v1[0], v1[1]); w.w = cvt_pk_bf16(v1[2], v1[3]);
                    *(u32x4*)(rowp + bj * HALF) = w;
                    const int slot = bj ? slot1 : slot0;
                    if (slot >= 0) { const f32x4 q4 = v0 * v0 + v1 * v1; float ss = (q4[0] + q4[1]) + (q4[2] + q4[3]);
                        ss += __shfl_xor(ss, 16); ss += __shfl_xor(ss, 32);
                        if (fq == 0) atomicAdd(kn + (size_t)row * 16 + slot, ss); } } }
    }
};
__device__ __forceinline__ float dpp_ror1(float x) { return __int_as_float(__builtin_amdgcn_update_dpp(__float_as_int(x), __float_as_int(x), 0x121, 0xf, 0xf, false)); }
__device__ __forceinline__ float dpp_ror2(float x) { return __int_as_float(__builtin_amdgcn_update_dpp(__float_as_int(x), __float_as_int(x), 0x122, 0xf, 0xf, false)); }
__device__ __forceinline__ float dpp_shr1z(float x) { return __int_as_float(__builtin_amdgcn_update_dpp(__float_as_int(x), __float_as_int(x), 0x111, 0xf, 0xf, true)); }
struct EpiConv {
    static constexpr bool PERM = true, AFTER_DRAIN = false, APERM = true;
    bf16_t* H; float* halo; const float* cw; const float* cb; int dff; const float* rowss; float inv_k, eps;
    __device__ __forceinline__ void operator()(const f32x4 (&acc)[2][2][4][2], const Unit& u, int wr, int wc, int fr, int fq) const {
        const int j0 = u.pn * 128 + wc * 32 + 8 * fq; const int ngu = 2 * dff;
        const int chunk0 = u.pm * 4 + wr;
        float rs[2][4];
#pragma unroll
        for (int ai = 0; ai < 2; ++ai)
#pragma unroll
            for (int m = 0; m < 4; ++m) rs[ai][m] = __builtin_amdgcn_rsqf(rowss[(chunk0 + 2 * ai) * 64 + 4 * fr + m] * inv_k + eps);
#pragma unroll
        for (int ai = 0; ai < 2; ++ai) { const int chunk = chunk0 + 2 * ai;
            if (fr == 0) {
#pragma unroll
                for (int m = 0; m < 2; ++m) { float* hp = halo + ((size_t)chunk * 4 + m) * ngu + j0;
#pragma unroll
                    for (int n = 0; n < 2; ++n) { *(f32x4*)(hp + 4 * n) = acc[ai][0][m][n] * rs[ai][m]; *(f32x4*)(hp + dff + 4 * n) = acc[ai][1][m][n] * rs[ai][m]; } } }
            if (fr == 15) {
#pragma unroll
                for (int m = 2; m < 4; ++m) { float* hp = halo + ((size_t)chunk * 4 + m) * ngu + j0;
#pragma unroll
                    for (int n = 0; n < 2; ++n) { *(f32x4*)(hp + 4 * n) = acc[ai][0][m][n] * rs[ai][m]; *(f32x4*)(hp + dff + 4 * n) = acc[ai][1][m][n] * rs[ai][m]; } } } }
        u32x4 pk[2][4];
#pragma unroll
        for (int n = 0; n < 2; ++n) {
            const float* wp = cw + j0 + 4 * n;
            const f32x4 wg0 = *(const f32x4*)(wp), wg1 = *(const f32x4*)(wp + ngu), wg2 = *(const f32x4*)(wp + 2 * ngu);
            const f32x4 wu0 = *(const f32x4*)(wp + dff), wu1 = *(const f32x4*)(wp + ngu + dff), wu2 = *(const f32x4*)(wp + 2 * ngu + dff);
            const f32x4 bg = *(const f32x4*)(cb + j0 + 4 * n), bu = *(const f32x4*)(cb + dff + j0 + 4 * n);
#pragma unroll
            for (int ai = 0; ai < 2; ++ai) {
                f32x4 xg[4], xu[4];
#pragma unroll
                for (int m = 0; m < 4; ++m) { xg[m] = acc[ai][0][m][n] * rs[ai][m]; xu[m] = acc[ai][1][m][n] * rs[ai][m]; }
                f32x4 sg3, sg2, su3, su2;
#pragma unroll
                for (int e = 0; e < 4; ++e) { sg3[e] = dpp_shr1z(xg[3][e]); sg2[e] = dpp_shr1z(xg[2][e]); su3[e] = dpp_shr1z(xu[3][e]); su2[e] = dpp_shr1z(xu[2][e]); }
#pragma unroll
                for (int m = 0; m < 4; ++m) {
                    const f32x4 g1 = m == 0 ? sg3 : xg[m > 0 ? m - 1 : 0], g2 = m == 0 ? sg2 : (m == 1 ? sg3 : xg[m > 1 ? m - 2 : 0]);
                    const f32x4 u1 = m == 0 ? su3 : xu[m > 0 ? m - 1 : 0], u2 = m == 0 ? su2 : (m == 1 ? su3 : xu[m > 1 ? m - 2 : 0]);
                    const f32x4 G = bg + wg0 * g2 + wg1 * g1 + wg2 * xg[m];
                    const f32x4 U = bu + wu0 * u2 + wu1 * u1 + wu2 * xu[m];
                    const f32x4 t = G * (-1.4426950408889634f);
                    f32x4 d; d[0] = __builtin_amdgcn_exp2f(t[0]); d[1] = __builtin_amdgcn_exp2f(t[1]); d[2] = __builtin_amdgcn_exp2f(t[2]); d[3] = __builtin_amdgcn_exp2f(t[3]); d = d + 1.0f;
                    f32x4 r; r[0] = __builtin_amdgcn_rcpf(d[0]); r[1] = __builtin_amdgcn_rcpf(d[1]); r[2] = __builtin_amdgcn_rcpf(d[2]); r[3] = __builtin_amdgcn_rcpf(d[3]);
                    const f32x4 hv = (G * r) * U;
                    if (n == 0) { pk[ai][m].x = cvt_pk_bf16(hv[0], hv[1]); pk[ai][m].y = cvt_pk_bf16(hv[2], hv[3]); }
                    else { pk[ai][m].z = cvt_pk_bf16(hv[0], hv[1]); pk[ai][m].w = cvt_pk_bf16(hv[2], hv[3]); }
                }
            }
        }
#pragma unroll
        for (int ai = 0; ai < 2; ++ai)
#pragma unroll
            for (int m = 0; m < 4; ++m) if (fr > 0 || m >= 2) *(u32x4*)(H + (size_t)((chunk0 + 2 * ai) * 64 + 4 * fr + m) * dff + j0) = pk[ai][m];
    }
};
template <class Epi, class Sched, bool STAMP = false>
__device__ __forceinline__ void gemm_phase(PG8_LAS unsigned char* lds, const Gemm g, const Sched& S, const Epi& E, unsigned long long* stamps) {
    int tid_l = threadIdx.x; asm volatile("" : "+v"(tid_l)); const int tid = tid_l, wid = __builtin_amdgcn_readfirstlane(tid >> 6), lane = tid & 63, wr = wid >> 2, wc = wid & 3, fr = lane & 15, fq = lane >> 4;
    const int K = g.K, nt = K / BK;
    int ts_lo = 0, ts_hi = 0, nts = 0; const unsigned long long rt_entry = STAMP ? (unsigned long long)wall_clock64() : 0ull;
#define PG8_STAMP() do { if (STAMP && wid == 0 && nts < 64) { const unsigned long long _c = (unsigned long long)clock64(); \
        ts_lo = (lane == nts) ? (int)(unsigned)_c : ts_lo; ts_hi = (lane == nts) ? (int)(unsigned)(_c >> 32) : ts_hi; ++nts; } } while (0)
    PG8_STAMP();
    unsigned voffA[2], voffB[2];
#pragma unroll
    for (int i = 0; i < 2; ++i) { int R, C; stage_rc(tid * 16 + i * 8192, R, C); const int Rb = Epi::PERM ? ((R & ~31) + perm32(R & 31)) : R;
        const int Ra = Epi::APERM ? ((R & ~63) + 4 * (R & 15) + ((R >> 4) & 3)) : R;
        voffA[i] = (unsigned)(Ra * K + C) * 2u; voffB[i] = (unsigned)(Rb * K + C) * 2u; }
    const size_t kstep = (size_t)(BK * 2);
    const size_t hstep = (size_t)HALF * K * 2;
    const size_t tstep = 2 * hstep;
    const unsigned ldsw = (unsigned)wid * 1024u;
    const int aoff = lds_byte(wr * 64 + fr, fq * 8), boff = lds_byte(wc * 32 + fr, fq * 8);
#define PG8_SA(b, h) (((b) * 2 + (h)) * HTB)
#define PG8_SB(b, h) ((4 + (b) * 2 + (h)) * HTB)
#define PG8_STAGE(bufoff, gbase, voff) do { _Pragma("unroll") for (int _i = 0; _i < 2; ++_i) \
        __builtin_amdgcn_global_load_lds((const unsigned*)((const char*)(gbase) + (voff)[_i]), (PG8_LAS unsigned*)(lds + (bufoff) + ldsw + _i * 8192), 16, 0, 0); } while (0)
#define PG8_LDA(dst, b, h) do { _Pragma("unroll") for (int m = 0; m < 4; ++m) _Pragma("unroll") for (int k = 0; k < 2; ++k) dst[m][k] = *(const PG8_LAS bf16x8*)(lds + PG8_SA(b, h) + aoff + m * 2048 + k * 1024); } while (0)
#define PG8_LDB(dst, b, h) do { _Pragma("unroll") for (int n = 0; n < 2; ++n) _Pragma("unroll") for (int k = 0; k < 2; ++k) dst[n][k] = *(const PG8_LAS bf16x8*)(lds + PG8_SB(b, h) + boff + n * 2048 + k * 1024); } while (0)
#define PG8_MMA(ai, bj, At, Bt) do { __builtin_amdgcn_s_setprio(1); _Pragma("unroll") for (int m = 0; m < 4; ++m) _Pragma("unroll") for (int n = 0; n < 2; ++n) _Pragma("unroll") for (int k = 0; k < 2; ++k) \
        acc[ai][bj][m][n] = __builtin_amdgcn_mfma_f32_16x16x32_bf16(Bt[n][k], At[m][k], acc[ai][bj][m][n], 0, 0, 0); __builtin_amdgcn_s_setprio(0); } while (0)
#define PG8_WAIT_V(n) asm volatile("s_waitcnt vmcnt(" #n ")" ::: "memory")
#define PG8_WAIT_L(n) asm volatile("s_waitcnt lgkmcnt(" #n ")" ::: "memory")
#define PG8_BAR __builtin_amdgcn_s_barrier()
#define PG8_SCHED __builtin_amdgcn_sched_barrier(0)
    Unit cur, nxt; int ui = 0;
    if (!S.next(0, cur)) return;
    f32x4 acc[2][2][4][2];
#pragma unroll
    for (int a = 0; a < 2; ++a)
#pragma unroll
        for (int b = 0; b < 2; ++b)
#pragma unroll
            for (int m = 0; m < 4; ++m)
#pragma unroll
                for (int n = 0; n < 2; ++n) acc[a][b][m][n] = (f32x4){0.f, 0.f, 0.f, 0.f};
    bf16x8 At[4][2], B0[2][2], B1[2][2];
    const char* cA = (const char*)g.A + (size_t)cur.pm * tstep; const char* cB = (const char*)g.Bt + (size_t)cur.pn * tstep;
    S.a_ready(cur);
    PG8_STAGE(PG8_SB(0, 0), cB, voffB); PG8_STAGE(PG8_SA(0, 0), cA, voffA); PG8_STAGE(PG8_SB(0, 1), cB + hstep, voffB); PG8_STAGE(PG8_SA(0, 1), cA + hstep, voffA);
    if (wr == 1) PG8_BAR;
    PG8_WAIT_V(4); PG8_BAR;
    PG8_STAGE(PG8_SB(1, 0), cB + kstep, voffB); PG8_STAGE(PG8_SA(1, 0), cA + kstep, voffA); PG8_STAGE(PG8_SB(1, 1), cB + hstep + kstep, voffB);
    PG8_WAIT_V(6); PG8_BAR;
    PG8_STAMP();
    for (;;) {
        const bool has_next = S.next(ui + 1, nxt);
        const char* nA = has_next ? (const char*)g.A + (size_t)nxt.pm * tstep : cA; const char* nB = has_next ? (const char*)g.Bt + (size_t)nxt.pn * tstep : cB;
        for (int t = 0; t < nt; t += 2) {
            const bool last = (t == nt - 2);
            const char* a1 = cA + (size_t)(t + 1) * kstep;
            const char* a2 = last ? nA : cA + (size_t)(t + 2) * kstep; const char* b2 = last ? nB : cB + (size_t)(t + 2) * kstep;
            const char* a3 = a2 + kstep; const char* b3 = b2 + kstep;
            if (last && has_next) S.a_ready(nxt);
            PG8_LDB(B0, 0, 0); PG8_SCHED; PG8_LDA(At, 0, 0); PG8_STAGE(PG8_SA(1, 1), a1 + hstep, voffA);
            PG8_WAIT_L(8); PG8_BAR; PG8_WAIT_L(0); PG8_MMA(0, 0, At, B0); PG8_BAR; PG8_SCHED;
            PG8_LDB(B1, 0, 1); PG8_STAGE(PG8_SB(0, 0), b2, voffB);
            PG8_BAR; PG8_WAIT_L(0); PG8_MMA(0, 1, At, B1); PG8_BAR;
            PG8_LDA(At, 0, 1); PG8_STAGE(PG8_SA(0, 0), a2, voffA);
            PG8_BAR; PG8_WAIT_L(0); PG8_MMA(1, 0, At, B0); PG8_BAR; PG8_SCHED;
            PG8_STAGE(PG8_SB(0, 1), b2 + hstep, voffB);
            PG8_WAIT_V(6); PG8_BAR; PG8_MMA(1, 1, At, B1); PG8_BAR;
            PG8_LDB(B0, 1, 0); PG8_SCHED; PG8_LDA(At, 1, 0); PG8_STAGE(PG8_SA(0, 1), a2 + hstep, voffA);
            PG8_WAIT_L(8); PG8_BAR; PG8_WAIT_L(0); PG8_MMA(0, 0, At, B0); PG8_BAR; PG8_SCHED;
            PG8_LDB(B1, 1, 1); PG8_STAGE(PG8_SB(1, 0), b3, voffB);
            PG8_BAR; PG8_WAIT_L(0); PG8_MMA(0, 1, At, B1); PG8_BAR;
            PG8_LDA(At, 1, 1); PG8_STAGE(PG8_SA(1, 0), a3, voffA);
            PG8_BAR; PG8_WAIT_L(0); PG8_MMA(1, 0, At, B0); PG8_BAR; PG8_SCHED;
            PG8_STAGE(PG8_SB(1, 1), b3 + hstep, voffB);
            PG8_WAIT_V(6); PG8_BAR; PG8_MMA(1, 1, At, B1); PG8_BAR;
        }
        PG8_STAMP();
        if constexpr (!Epi::AFTER_DRAIN) { E(acc, cur, wr, wc, fr, fq); S.done(cur); }
        PG8_STAMP();
        if (!has_next) break;
#pragma unroll
        for (int a = 0; a < 2; ++a)
#pragma unroll
            for (int b = 0; b < 2; ++b)
#pragma unroll
                for (int m = 0; m < 4; ++m)
#pragma unroll
                    for (int n = 0; n < 2; ++n) acc[a][b][m][n] = (f32x4){0.f, 0.f, 0.f, 0.f};
        cur = nxt; cA = nA; cB = nB; ++ui;
    }
    PG8_WAIT_V(0);
    if (wr == 0) PG8_BAR;
    PG8_BAR;
    if constexpr (Epi::AFTER_DRAIN) { E.fused(acc, cur, wr, wc, fr, fq, lds, wid, lane); S.done(cur); }
    PG8_STAMP();
    if (STAMP && wid == 0) { stamps[lane] = lane < nts ? (((unsigned long long)(unsigned)ts_hi << 32) | (unsigned)ts_lo) : 0ull;
        if (lane == 62) stamps[62] = rt_entry; if (lane == 63) stamps[63] = (unsigned long long)wall_clock64(); }
#undef PG8_STAMP
#undef PG8_SA
#undef PG8_SB
#undef PG8_STAGE
#undef PG8_LDA
#undef PG8_LDB
#undef PG8_MMA
#undef PG8_WAIT_V
#undef PG8_WAIT_L
#undef PG8_BAR
#undef PG8_SCHED
}
}
#define XB_TMO      128
#define XB_XCNT(j)  (256  + 64 * (j))
#define XB_XSUB(j)  (1280 + 64 * (j))
#define XB_XGEN(j)  (2304 + 64 * (j))
#define XB_TOP      3328
#define XB_TOPGEN   3392
#define XCD_BAR_WORDS 3456
#define XB_SPIN_CAP (1u << 18)
#define LAS __attribute__((address_space(3)))

__device__ __forceinline__ unsigned xb_ld(unsigned* p)              { return __hip_atomic_load(p, __ATOMIC_RELAXED, __HIP_MEMORY_SCOPE_AGENT); }
__device__ __forceinline__ unsigned xb_add(unsigned* p, unsigned v) { return __hip_atomic_fetch_add(p, v, __ATOMIC_RELAXED, __HIP_MEMORY_SCOPE_AGENT); }
__device__ __forceinline__ unsigned xb_xcc_id() { return (unsigned)__builtin_amdgcn_s_getreg((3 << 11) | 20) & 0xFu; }
#define XB_SPIN(cond, bar) do { unsigned _sp = 0; while (cond) { __builtin_amdgcn_s_sleep(1); \
    if ((++_sp & 255u) == 0u) { if (xb_ld(&(bar)[XB_TMO])) break; if (_sp > XB_SPIN_CAP) { atomicAdd(&(bar)[XB_TMO], 1u); break; } } } } while (0)

struct XcdBarrier {
    unsigned* bar; unsigned x;
    volatile LAS unsigned* st;
};

__device__ __forceinline__ XcdBarrier xcd_barrier_post(unsigned* bar, volatile LAS unsigned* st) {
    XcdBarrier b; b.bar = bar; b.x = xb_xcc_id(); b.st = st;
    if (threadIdx.x == 0) (void)xb_add(&bar[XB_XCNT(b.x)], 1u);
    return b;
}
__device__ __forceinline__ void xcd_barrier_complete(unsigned* bar, unsigned x, unsigned& nloc, unsigned& nx) {
    const unsigned G = gridDim.x * gridDim.y * gridDim.z;
    unsigned sum, cnt, mine, sp = 0u;
    for (;;) {
        sum = 0u; cnt = 0u; mine = 0u;
#pragma unroll
        for (unsigned j = 0; j < 16; ++j) { const unsigned c = xb_ld(&bar[XB_XCNT(j)]); sum += c; cnt += (c > 0u) ? 1u : 0u; mine = (j == x) ? c : mine; }
        if (sum == G) break;
        __builtin_amdgcn_s_sleep(1);
        if ((++sp & 255u) == 0u) { if (xb_ld(&bar[XB_TMO])) break; if (sp > XB_SPIN_CAP) { atomicAdd(&bar[XB_TMO], 1u); break; } }
    }
    nloc = mine > 0u ? mine : 1u; nx = cnt > 0u ? cnt : 1u;
}

__device__ __forceinline__ void xcd_barrier(const XcdBarrier& b) {
    asm volatile("s_waitcnt vmcnt(0)" ::: "memory");
    __syncthreads();
    if (threadIdx.x == 0) {
        unsigned* bar = b.bar;
        __builtin_amdgcn_s_waitcnt(0);
        unsigned nloc = b.st[0], nx = b.st[1];
        if (nloc == 0u) { xcd_barrier_complete(bar, b.x, nloc, nx); b.st[0] = nloc; b.st[1] = nx; }
        const unsigned old = xb_add(&bar[XB_XSUB(b.x)], 1u);
        const unsigned gen = old / nloc;
        if (old + 1u == (gen + 1u) * nloc) {
            __builtin_amdgcn_fence(__ATOMIC_RELEASE, "agent");
            asm volatile("s_waitcnt vmcnt(0)" ::: "memory");
            const unsigned og = xb_add(&bar[XB_TOP], 1u);
            const unsigned tg = og / nx;
            if (og + 1u == (tg + 1u) * nx) xb_add(&bar[XB_TOPGEN], 1u);
            else XB_SPIN(xb_ld(&bar[XB_TOPGEN]) == tg, bar);
            __builtin_amdgcn_fence(__ATOMIC_ACQUIRE, "agent");
            xb_add(&bar[XB_XGEN(b.x)], 1u);
            asm volatile("s_waitcnt vmcnt(0)" ::: "memory");
        } else {
            XB_SPIN(xb_ld(&bar[XB_XGEN(b.x)]) == gen, bar);
            __builtin_amdgcn_fence(__ATOMIC_ACQUIRE, "agent");
            asm volatile("s_waitcnt vmcnt(0)" ::: "memory");
        }
    }
    __syncthreads();
}
namespace mk {
#define LAS __attribute__((address_space(3)))
typedef unsigned short bf16_t;
typedef short bf16x8 __attribute__((ext_vector_type(8)));
typedef short s16x4 __attribute__((ext_vector_type(4)));
typedef float f32x16 __attribute__((ext_vector_type(16)));
typedef float f32x4 __attribute__((ext_vector_type(4)));
typedef unsigned u32x4 __attribute__((ext_vector_type(4)));
typedef unsigned u32x2 __attribute__((ext_vector_type(2)));

constexpr int BATCH = 8, SEQ = 2048, DM = 2048, MTOK = BATCH * SEQ, NIN = 6149, NQKV = 6144, DFF = 5632, NGU = 2 * DFF, HD = 128, NTHR = 512;
constexpr float EPS = 1e-6f;
constexpr float LOG2E = 1.4426950408889634f;
constexpr float C2 = 0.08838834764831845f * LOG2E;
constexpr int LDS_STAGE = 131072, LDS_BYTES = LDS_STAGE + 16;

constexpr size_t SZ_WIN = (size_t)NQKV * DM * 2, SZ_WO = (size_t)DM * DM * 2, SZ_WGU = (size_t)NGU * DM * 2, SZ_WD = (size_t)DM * DFF * 2, SZ_WL = SZ_WIN + SZ_WO + SZ_WGU + SZ_WD;
constexpr size_t WS_W = 0;
constexpr size_t WS_ABUF = WS_W + 2 * SZ_WL, SZ_ABUF = (size_t)MTOK * DM * 2;
constexpr size_t WS_PROJ = WS_ABUF + SZ_ABUF, SZ_PROJ = (size_t)MTOK * NQKV * 2;
constexpr size_t WS_HALO = WS_PROJ + SZ_PROJ, SZ_HALO = (size_t)(MTOK / 64) * 4 * NGU * 4;
constexpr size_t WS_H = WS_HALO + SZ_HALO, SZ_H = (size_t)MTOK * DFF * 2;
constexpr size_t WS_FC = WS_H + SZ_H, SZ_FC = (size_t)MTOK * 8 * 4;
constexpr size_t WS_CTR = WS_FC + SZ_FC, WS_BAR = WS_CTR + 256, WS_RSS = WS_BAR + 3456 * 4, WS_KN = WS_RSS + (size_t)4 * MTOK * 4, WS_END = WS_KN + (size_t)2 * MTOK * 16 * 4;

struct Params { const float *x, *g_mix, *w_in, *b_f, *g_head, *w_o, *g_ffn, *w_gu, *conv_w, *conv_b, *w_down, *g_final; float* out; unsigned char* ws; int ph_lo, ph_hi; };

__device__ __forceinline__ unsigned cvtpk(float lo, float hi) { unsigned r; asm volatile("v_cvt_pk_bf16_f32 %0, %1, %2" : "=v"(r) : "v"(lo), "v"(hi)); return r; }

struct CvTile { const float* src; bf16_t* dst; const float* gk; int ldn, K; };
constexpr int CV_PER_LAYER = 3072 + 1024 + 5632 + 2816, CV_TOTAL = 2 * CV_PER_LAYER;
__device__ __forceinline__ CvTile cv_decode(const Params& p, unsigned char* ws, int g) {
    const int l2 = g / CV_PER_LAYER, r = g - l2 * CV_PER_LAYER;
    unsigned char* wl = ws + WS_W + (size_t)l2 * SZ_WL;
    CvTile t; t.gk = nullptr; int ntn, lt; const float* W; bf16_t* Bt; bool gup = false;
    if (r < 3072) { lt = r; ntn = NQKV / 64; W = p.w_in + (size_t)l2 * DM * NIN; t.ldn = NIN; t.K = DM; Bt = (bf16_t*)wl; }
    else if (r < 4096) { lt = r - 3072; ntn = DM / 64; W = p.w_o + (size_t)l2 * DM * DM; t.ldn = DM; t.K = DM; Bt = (bf16_t*)(wl + SZ_WIN); }
    else if (r < 9728) { lt = r - 4096; ntn = NGU / 64; W = p.w_gu + (size_t)l2 * DM * NGU; t.ldn = NGU; t.K = DM; Bt = (bf16_t*)(wl + SZ_WIN + SZ_WO); gup = true; t.gk = p.g_ffn + l2 * DM; }
    else { lt = r - 9728; ntn = DM / 64; W = p.w_down + (size_t)l2 * DFF * DM; t.ldn = DM; t.K = DFF; Bt = (bf16_t*)(wl + SZ_WIN + SZ_WO + SZ_WGU); }
    const int tn = lt % ntn, tk = lt / ntn, k0 = tk * 64, n0 = tn * 64;
    const int nd0 = !gup ? n0 : (n0 < DFF ? (n0 >> 7) * 256 + (n0 & 127) : ((n0 - DFF) >> 7) * 256 + 128 + ((n0 - DFF) & 127));
    t.src = W + (size_t)k0 * t.ldn + n0; t.dst = Bt + (size_t)nd0 * t.K + k0; if (t.gk) t.gk += k0;
    return t;
}
__device__ __forceinline__ void convert_weights(const Params& p, unsigned char* ws, LAS float* tile) {
    int tid_l = threadIdx.x; asm volatile("" : "+v"(tid_l)); const int tid = tid_l, G = gridDim.x;
    const int kk = tid >> 6, nn = tid & 63, n = tid >> 3, kc = (tid & 7) * 8;
    int g = blockIdx.x, it = 0;
    if (g >= CV_TOTAL) return;
    bool has1 = g + G < CV_TOTAL;
    CvTile c0 = cv_decode(p, ws, g), c1 = cv_decode(p, ws, has1 ? g + G : g);
    float v0[8], v1[8];
#pragma unroll
    for (int i = 0; i < 8; ++i) v0[i] = c0.src[(size_t)(i * 8 + kk) * c0.ldn + nn];
#pragma unroll
    for (int i = 0; i < 8; ++i) v1[i] = c1.src[(size_t)(i * 8 + kk) * c1.ldn + nn];
    for (;;) {
        const int gn = g + 2 * G; const bool more = gn < CV_TOTAL, more1 = gn + G < CV_TOTAL;
        CvTile n0 = c0, n1 = c1; float w0[8], w1[8];
        if (more) { n0 = cv_decode(p, ws, gn); n1 = cv_decode(p, ws, more1 ? gn + G : gn);
#pragma unroll
            for (int i = 0; i < 8; ++i) w0[i] = n0.src[(size_t)(i * 8 + kk) * n0.ldn + nn];
#pragma unroll
            for (int i = 0; i < 8; ++i) w1[i] = n1.src[(size_t)(i * 8 + kk) * n1.ldn + nn]; }
        LAS float* tb0 = tile + ((it & 1) * 2) * (64 * 65); LAS float* tb1 = tb0 + 64 * 65;
        if (c0.gk) {
#pragma unroll
            for (int i = 0; i < 8; ++i) v0[i] *= c0.gk[i * 8 + kk]; }
        if (c1.gk) {
#pragma unroll
            for (int i = 0; i < 8; ++i) v1[i] *= c1.gk[i * 8 + kk]; }
#pragma unroll
        for (int i = 0; i < 8; ++i) { tb0[(i * 8 + kk) * 65 + nn] = v0[i]; tb1[(i * 8 + kk) * 65 + nn] = v1[i]; }
        __syncthreads();
        { float f[8];
#pragma unroll
          for (int j = 0; j < 8; ++j) f[j] = tb0[(kc + j) * 65 + n];
          u32x4 w = {cvtpk(f[0], f[1]), cvtpk(f[2], f[3]), cvtpk(f[4], f[5]), cvtpk(f[6], f[7])};
          *(u32x4*)(c0.dst + (size_t)n * c0.K + kc) = w; }
        if (has1) { float f[8];
#pragma unroll
          for (int j = 0; j < 8; ++j) f[j] = tb1[(kc + j) * 65 + n];
          u32x4 w = {cvtpk(f[0], f[1]), cvtpk(f[2], f[3]), cvtpk(f[4], f[5]), cvtpk(f[6], f[7])};
          *(u32x4*)(c1.dst + (size_t)n * c1.K + kc) = w; }
        if (!more) break;
#pragma unroll
        for (int i = 0; i < 8; ++i) { v0[i] = w0[i]; v1[i] = w1[i]; }
        c0 = n0; c1 = n1; has1 = more1; g = gn; ++it;
    }
    __syncthreads();
}

template <bool FC, bool OUTF32>
__device__ __forceinline__ void norm_phase(const float* X, const float* __restrict__ g, bf16_t* hn, float* outf,
                                           const float* __restrict__ w_in_l, float* __restrict__ fcbuf, LAS float* wfc) {
    int tid_l = threadIdx.x; asm volatile("" : "+v"(tid_l)); const int tid = tid_l, wid = tid >> 6, lane = tid & 63;
    if (FC) { for (int i = tid; i < 5 * DM; i += NTHR) { const int d = i / 5, j = i - d * 5; wfc[j * DM + d] = w_in_l[(size_t)d * NIN + NQKV + j]; } __syncthreads(); }
    for (int row = blockIdx.x * 8 + wid; row < MTOK; row += gridDim.x * 8) {
        const float* xr = X + (size_t)row * DM;
        f32x4 v[8];
#pragma unroll
        for (int i = 0; i < 8; ++i) v[i] = *(const f32x4*)(xr + (i * 64 + lane) * 4);
        float ss = 0.f;
#pragma unroll
        for (int i = 0; i < 8; ++i) ss += v[i][0] * v[i][0] + v[i][1] * v[i][1] + v[i][2] * v[i][2] + v[i][3] * v[i][3];
#pragma unroll
        for (int o = 32; o >= 1; o >>= 1) ss += __shfl_xor(ss, o);
        const float rs = 1.0f / sqrtf(ss * (1.0f / DM) + EPS);
        float fc0 = 0.f, fc1 = 0.f, fc2 = 0.f, fc3 = 0.f, fc4 = 0.f;
#pragma unroll
        for (int i = 0; i < 8; ++i) {
            const int d = (i * 64 + lane) * 4;
            const f32x4 gv = *(const f32x4*)(g + d);
            const f32x4 y = v[i] * rs * gv;
            if (OUTF32) *(f32x4*)(outf + (size_t)row * DM + d) = y;
            else { u32x2 w = {cvtpk(y[0], y[1]), cvtpk(y[2], y[3])}; *(u32x2*)(hn + (size_t)row * DM + d) = w; }
            if (FC) {
                const f32x4 w0 = *(const LAS f32x4*)(wfc + 0 * DM + d), w1 = *(const LAS f32x4*)(wfc + 1 * DM + d), w2 = *(const LAS f32x4*)(wfc + 2 * DM + d),
                            w3 = *(const LAS f32x4*)(wfc + 3 * DM + d), w4 = *(const LAS f32x4*)(wfc + 4 * DM + d);
                fc0 += y[0] * w0[0] + y[1] * w0[1] + y[2] * w0[2] + y[3] * w0[3];
                fc1 += y[0] * w1[0] + y[1] * w1[1] + y[2] * w1[2] + y[3] * w1[3];
                fc2 += y[0] * w2[0] + y[1] * w2[1] + y[2] * w2[2] + y[3] * w2[3];
                fc3 += y[0] * w3[0] + y[1] * w3[1] + y[2] * w3[2] + y[3] * w3[3];
                fc4 += y[0] * w4[0] + y[1] * w4[1] + y[2] * w4[2] + y[3] * w4[3];
            }
        }
        if (FC) {
#pragma unroll
            for (int o = 32; o >= 1; o >>= 1) { fc0 += __shfl_xor(fc0, o); fc1 += __shfl_xor(fc1, o); fc2 += __shfl_xor(fc2, o); fc3 += __shfl_xor(fc3, o); fc4 += __shfl_xor(fc4, o); }
            if (lane == 0) { float* f = fcbuf + (size_t)row * 8; f[0] = fc0; f[1] = fc1; f[2] = fc2; f[3] = fc3; f[4] = fc4; }
        }
    }
}

__device__ __forceinline__ void fixup_phase(const float* __restrict__ halo, bf16_t* __restrict__ h, const float* __restrict__ cw, const float* __restrict__ cb) {
    constexpr int NCG = DFF / 4, NCHUNK = MTOK / 64;
    const int total = NCG * NCHUNK * 2;
    int tid_l = threadIdx.x; asm volatile("" : "+v"(tid_l));
    for (int u = blockIdx.x * NTHR + tid_l; u < total; u += gridDim.x * NTHR) {
        const int cgi = u % NCG, rs = u / NCG, slot = rs & 1, chunk = rs >> 1, j = cgi * 4;
        const bool seq0 = (chunk & 31) == 0;
        const f32x4 z = {0.f, 0.f, 0.f, 0.f};
        const float* hc = halo + (size_t)chunk * 4 * NGU + j; const float* hp = hc - (size_t)4 * NGU;
        f32x4 g0, g1, g2, u0, u1, u2;
        if (slot == 0) { g0 = *(const f32x4*)(hc); u0 = *(const f32x4*)(hc + DFF);
            g1 = seq0 ? z : *(const f32x4*)(hp + 3 * NGU); u1 = seq0 ? z : *(const f32x4*)(hp + 3 * NGU + DFF);
            g2 = seq0 ? z : *(const f32x4*)(hp + 2 * NGU); u2 = seq0 ? z : *(const f32x4*)(hp + 2 * NGU + DFF); }
        else { g0 = *(const f32x4*)(hc + NGU); u0 = *(const f32x4*)(hc + NGU + DFF);
            g1 = *(const f32x4*)(hc); u1 = *(const f32x4*)(hc + DFF);
            g2 = seq0 ? z : *(const f32x4*)(hp + 3 * NGU); u2 = seq0 ? z : *(const f32x4*)(hp + 3 * NGU + DFF); }
        const f32x4 wg0 = *(const f32x4*)(cw + j), wg1 = *(const f32x4*)(cw + NGU + j), wg2 = *(const f32x4*)(cw + 2 * NGU + j);
        const f32x4 wu0 = *(const f32x4*)(cw + DFF + j), wu1 = *(const f32x4*)(cw + NGU + DFF + j), wu2 = *(const f32x4*)(cw + 2 * NGU + DFF + j);
        const f32x4 bg = *(const f32x4*)(cb + j), bu = *(const f32x4*)(cb + DFF + j);
        float hv[4];
#pragma unroll
        for (int e = 0; e < 4; ++e) { const float G = bg[e] + wg0[e] * g2[e] + wg1[e] * g1[e] + wg2[e] * g0[e]; const float U = bu[e] + wu0[e] * u2[e] + wu1[e] * u1[e] + wu2[e] * u0[e];
            hv[e] = G / (1.0f + __expf(-G)) * U; }
        u32x2 w = {cvtpk(hv[0], hv[1]), cvtpk(hv[2], hv[3])};
        *(u32x2*)(h + (size_t)(chunk * 64 + slot) * DFF + j) = w;
    }
}

constexpr int SHM_K = 16384, SHM_V = 16384;
constexpr int AT_WS = 65536, AT_TAB = AT_WS + 2048, AT_ITEM = AT_TAB + 9216;
#define KSWZ(row, colB) ((row) * 256 + ((colB) ^ (((row) & 7) << 4)))
#define SBAR() __builtin_amdgcn_sched_barrier(0)
__device__ __forceinline__ int v_st(int k, int c) { const int kk = (k & ~0xC) | ((k & 4) << 1) | ((k & 8) >> 1); return ((kk >> 3) * 4 + (c >> 5)) * 512 + ((kk & 7) * 32 + (c & 31)) * 2; }
__device__ __forceinline__ int v_rd_base(int lane) { return ((lane & 3) << 3) | (((lane >> 2) & 3) << 6) | (((lane >> 4) & 1) << 5) | (((lane >> 5) & 1) << 8); }
constexpr int v_rd_off(int d0, int ks, int half) { return d0 * 512 + ks * 4096 + half * 2048; }
__device__ __forceinline__ int crow(int r, int hi) { return (r & 3) + 8 * (r >> 2) + 4 * hi; }
__device__ __forceinline__ float pl32_max(float x) { auto rr = __builtin_amdgcn_permlane32_swap(__float_as_uint(x), __float_as_uint(x), false, false); return fmaxf(__uint_as_float(rr[0]), __uint_as_float(rr[1])); }
__device__ __forceinline__ float pl32_sum(float x) { auto rr = __builtin_amdgcn_permlane32_swap(__float_as_uint(x), __float_as_uint(x), false, false); return __uint_as_float(rr[0]) + __uint_as_float(rr[1]); }
__device__ __forceinline__ float pl32_other(float x, int hi) { auto rr = __builtin_amdgcn_permlane32_swap(__float_as_uint(x), __float_as_uint(x), false, false); return __uint_as_float(hi ? rr[0] : rr[1]); }

__device__ __forceinline__ void qkt(f32x16& p0, f32x16& p1, const LAS char* Kb, int r32, int hi, const bf16x8* qr) {
    p0 = f32x16{}; p1 = f32x16{};
    const LAS char* kb[4];
#pragma unroll
    for (int dd = 0; dd < 4; ++dd) kb[dd] = Kb + KSWZ(r32, (dd * 16 + hi * 8) * 2);
    __builtin_amdgcn_s_setprio(1);
#pragma unroll
    for (int d0 = 0; d0 < 8; ++d0) { const LAS char* a = kb[d0 & 3] + (d0 >> 2) * 128;
        bf16x8 b0 = *reinterpret_cast<const LAS bf16x8*>(a);
        bf16x8 b1 = *reinterpret_cast<const LAS bf16x8*>(a + 32 * 256);
        p0 = __builtin_amdgcn_mfma_f32_32x32x16_bf16(b0, qr[d0], p0, 0, 0, 0);
        p1 = __builtin_amdgcn_mfma_f32_32x32x16_bf16(b1, qr[d0], p1, 0, 0, 0); }
    __builtin_amdgcn_s_setprio(0);
}
__device__ __forceinline__ void pv_tile(f32x16* o, int vb0, bf16x8 pa0, bf16x8 pa1, bf16x8 pa2, bf16x8 pa3) {
#define TRRD(dst, off) asm volatile("ds_read_b64_tr_b16 %0, %1 offset:%2" : "=&v"(dst) : "v"(vb0), "i"(off) : "memory")
#define PV_D0(d0) do { s16x4 l0, l1, l2, l3, h0, h1, h2, h3; constexpr int b_ = v_rd_off(d0, 0, 0); \
        TRRD(l0, b_); TRRD(h0, b_ + 2048); TRRD(l1, b_ + 4096); TRRD(h1, b_ + 6144); TRRD(l2, b_ + 8192); TRRD(h2, b_ + 10240); TRRD(l3, b_ + 12288); TRRD(h3, b_ + 14336); \
        asm volatile("s_waitcnt lgkmcnt(0)" ::: "memory"); SBAR(); \
        o[d0] = __builtin_amdgcn_mfma_f32_32x32x16_bf16(pa0, (bf16x8){l0[0], l0[1], l0[2], l0[3], h0[0], h0[1], h0[2], h0[3]}, o[d0], 0, 0, 0); \
        o[d0] = __builtin_amdgcn_mfma_f32_32x32x16_bf16(pa1, (bf16x8){l1[0], l1[1], l1[2], l1[3], h1[0], h1[1], h1[2], h1[3]}, o[d0], 0, 0, 0); \
        o[d0] = __builtin_amdgcn_mfma_f32_32x32x16_bf16(pa2, (bf16x8){l2[0], l2[1], l2[2], l2[3], h2[0], h2[1], h2[2], h2[3]}, o[d0], 0, 0, 0); \
        o[d0] = __builtin_amdgcn_mfma_f32_32x32x16_bf16(pa3, (bf16x8){l3[0], l3[1], l3[2], l3[3], h3[0], h3[1], h3[2], h3[3]}, o[d0], 0, 0, 0); } while (0)
    __builtin_amdgcn_s_setprio(1);
    PV_D0(0); PV_D0(1); PV_D0(2); PV_D0(3);
    __builtin_amdgcn_s_setprio(0);
#undef PV_D0
#undef TRRD
}
#define PK4(P, B_, OUT) do { unsigned a0 = cvtpk(P[B_+0], P[B_+1]), a1 = cvtpk(P[B_+2], P[B_+3]); \
        unsigned b0 = cvtpk(P[B_+4], P[B_+5]), b1 = cvtpk(P[B_+6], P[B_+7]); \
        auto r0 = __builtin_amdgcn_permlane32_swap(a0, b0, false, false); auto r1 = __builtin_amdgcn_permlane32_swap(a1, b1, false, false); \
        u32x4 w = {r0[0], r1[0], r0[1], r1[1]}; OUT = *reinterpret_cast<bf16x8*>(&w); } while (0)

template <int TYPE>
__device__ __forceinline__ void attn_item(const bf16_t* __restrict__ proj, bf16_t* __restrict__ obuf, const float* __restrict__ fcbuf, const float* __restrict__ bf_l,
                                          const float* __restrict__ ghead_l, const float* __restrict__ kn, int b, int hl, int qb, LAS char* lds) {
    int tid_l = threadIdx.x; asm volatile("" : "+v"(tid_l)); const int tid = tid_l, wid = __builtin_amdgcn_readfirstlane(tid >> 6), lane = tid & 63, r32 = lane & 31, hi = lane >> 5;
    constexpr int LD = NQKV;
    constexpr int QC = TYPE == 0 ? 0 : (TYPE == 1 ? 2304 : 4224), KC = TYPE == 0 ? 768 : (TYPE == 1 ? 2944 : 4864), VC = TYPE == 0 ? 1536 : (TYPE == 1 ? 3584 : 5504);
    constexpr int HOFF = TYPE == 0 ? 0 : (TYPE == 1 ? 6 : 11);
    const int q0 = qb * 256, qlo = q0 + wid * 32, NT = 4 * (qb + 1);
    const bf16_t* Qp = proj + (size_t)(b * SEQ + qlo + r32) * LD + QC + hl * HD;
    const bf16_t* Kp = proj + (size_t)(b * SEQ) * LD + KC + hl * HD;
    const bf16_t* Vp = proj + (size_t)(b * SEQ) * LD + VC + hl * HD;
    LAS char* V_lds = lds; LAS char* K_lds = lds + 2 * SHM_V;
    LAS float* wsf = (LAS float*)(lds + AT_WS) + wid * 64;
    LAS float* tab = (LAS float*)(lds + AT_TAB);
    LAS int* dflag = (LAS int*)(lds + AT_ITEM + 16);
    const float NEGINF = -__builtin_inff();

    const float slope2 = exp2f(-8.0f * (float)(hl + 1) / 6.0f) * LOG2E;
    float kmax2 = 0.f;
    if (TYPE != 1) {
        LAS float* kred = (LAS float*)(lds + AT_ITEM + 128);
        float mx = 0.f;
        for (int s_ = tid; s_ < q0 + 256; s_ += NTHR) mx = fmaxf(mx, kn[(size_t)(b * SEQ + s_) * 16 + HOFF + hl]);
#pragma unroll
        for (int o_ = 32; o_ >= 1; o_ >>= 1) mx = fmaxf(mx, __shfl_xor(mx, o_));
        if (lane == 0) kred[wid] = mx;
        __syncthreads();
#pragma unroll
        for (int w = 0; w < 8; ++w) kmax2 = fmaxf(kmax2, kred[w]);
    }
    if (TYPE == 0) {
        for (int i = tid; i < 2304; i += NTHR) { const int d = i - 256; float v = NEGINF;
            if (d >= 0) { const int m = (d <= 128 ? 1 : 0) + (((d & 3) == 0 && d <= 512) ? 1 : 0) + ((d & 15) == 0 ? 1 : 0);
                if (m > 0) v = -slope2 * (float)d + (m == 1 ? 0.f : (m == 2 ? 1.0f : 1.5849625007211562f)); }
            tab[i] = v; }
    }
    if (TYPE == 2) {
        const float bf = bf_l[hl]; const int t0 = tid * 4; float lf[4];
#pragma unroll
        for (int j = 0; j < 4; ++j) { const float x = fcbuf[(size_t)(b * SEQ + t0 + j) * 8 + hl] + bf; lf[j] = (fminf(x, 0.f) - log1pf(expf(-fabsf(x)))) * LOG2E; }
        lf[1] += lf[0]; lf[2] += lf[1]; lf[3] += lf[2];
        const float tot = lf[3]; float incl = tot;
#pragma unroll
        for (int o = 1; o < 64; o <<= 1) { const float t = __shfl_up(incl, o); if (lane >= o) incl += t; }
        LAS float* wsum = (LAS float*)(lds + AT_WS);
        if (lane == 63) wsum[wid] = incl;
        __syncthreads();
        float pre = 0.f;
        for (int w = 0; w < wid; ++w) pre += wsum[w];
        const float ex = incl - tot + pre;
#pragma unroll
        for (int j = 0; j < 4; ++j) tab[t0 + j] = ex + lf[j];
    }
    bf16x8 qr[8];
#pragma unroll
    for (int d0 = 0; d0 < 8; ++d0) qr[d0] = *(const bf16x8*)(Qp + d0 * 16 + hi * 8);
    float Bq = 0.f;
    if (TYPE != 1) { float qs = 0.f;
#pragma unroll
        for (int d0 = 0; d0 < 8; ++d0)
#pragma unroll
            for (int e_ = 0; e_ < 8; ++e_) { const float f = __uint_as_float(((unsigned)(unsigned short)qr[d0][e_]) << 16); qs += f * f; }
        qs = pl32_sum(qs);
        Bq = sqrtf(qs) * sqrtf(kmax2) * (1.02f * C2) + 0.5f; }
    const int sr = tid >> 4, sc = (tid & 15) * 8;
    const int kws = KSWZ(sr, sc * 2), vst0 = v_st(sr, sc), vst1 = v_st(32 + sr, sc);
#define TILE_KB(it_) ((NT - 1 - (it_)) * 64)
    bf16x8 st_k0, st_k1, st_v0, st_v1;
#define SLOAD(kb_) do { st_k0 = *(const bf16x8*)(Kp + (size_t)((kb_) + sr) * LD + sc); st_k1 = *(const bf16x8*)(Kp + (size_t)((kb_) + 32 + sr) * LD + sc); \
                        st_v0 = *(const bf16x8*)(Vp + (size_t)((kb_) + sr) * LD + sc); st_v1 = *(const bf16x8*)(Vp + (size_t)((kb_) + 32 + sr) * LD + sc); } while (0)
#define SWRITE(bf_) do { *(LAS bf16x8*)(K_lds + (bf_) * SHM_K + kws) = st_k0; *(LAS bf16x8*)(K_lds + (bf_) * SHM_K + kws + 32 * 256) = st_k1; \
                         *(LAS bf16x8*)(V_lds + (bf_) * SHM_V + vst0) = st_v0; *(LAS bf16x8*)(V_lds + (bf_) * SHM_V + vst1) = st_v1; } while (0)
    SLOAD(TILE_KB(0)); SWRITE(0);
    __syncthreads();
    const int vbase = (int)(unsigned)(uintptr_t)V_lds + v_rd_base(lane);
    float m_reg = -1e30f, l_reg = 0.f, Rc = 1.f;
    bool wdone = false;
    float cq2 = 0.f; if (TYPE == 2) cq2 = tab[qlo + r32];
    f32x16 o[4] = {};
    for (int it = 0; it < NT; ++it) {
        const int cur = it & 1, kbase = TILE_KB(it);
        if (it + 1 < NT) { const int kb2 = TILE_KB(it + 1); SLOAD(kb2); }
        const bool act = !wdone && ((TYPE == 1) ? (kbase <= qlo + 30) : (kbase <= qlo + 31));
        if (act) {
            f32x16 p0, p1;
            qkt(p0, p1, K_lds + cur * SHM_K, r32, hi, qr);
            const int dq = qlo + r32 - 4 * hi - kbase;
            bf16x8 pa0, pa1, pa2, pa3;
            if (TYPE != 1) {
                if (TYPE == 0) {
                    const LAS float* tb = tab + (dq + 256 - 63);
                    f32x16 bz0, bz1;
#pragma unroll
                    for (int r = 0; r < 16; ++r) { const int c = (r & 3) + 8 * (r >> 2); bz0[r] = tb[63 - c]; bz1[r] = tb[31 - c]; }
                    p0 = p0 * C2 + bz0; p1 = p1 * C2 + bz1;
                } else {
                    f32x16 kz0, kz1;
#pragma unroll
                    for (int g = 0; g < 4; ++g) { const f32x4 ck0 = *(const LAS f32x4*)(tab + kbase + 8 * g + 4 * hi), ck1 = *(const LAS f32x4*)(tab + kbase + 32 + 8 * g + 4 * hi);
#pragma unroll
                        for (int j = 0; j < 4; ++j) { kz0[4 * g + j] = ck0[j]; kz1[4 * g + j] = ck1[j]; } }
                    p0 = p0 * C2 + (cq2 - kz0); p1 = p1 * C2 + (cq2 - kz1);
                    if (kbase + 63 > qlo) {
#pragma unroll
                        for (int r = 0; r < 16; ++r) { const int c = (r & 3) + 8 * (r >> 2); if (dq - c < 0) p0[r] = NEGINF; if (dq - c - 32 < 0) p1[r] = NEGINF; }
                    }
                }
                float pmax = p0[0];
#pragma unroll
                for (int r = 1; r < 16; ++r) pmax = fmaxf(pmax, p0[r]);
#pragma unroll
                for (int r = 0; r < 16; ++r) pmax = fmaxf(pmax, p1[r]);
                pmax = pl32_max(pmax);
                float mn, alpha;
                if (__all((pmax - m_reg) <= 11.5f)) { mn = m_reg; alpha = 1.f; }
                else { mn = fmaxf(m_reg, pmax); alpha = __builtin_amdgcn_exp2f(m_reg - mn); m_reg = mn; }
                float ps = 0.f;
                { const float nm = -mn; f32x16 nmv; for (int r = 0; r < 16; ++r) nmv[r] = nm; p0 = p0 + nmv; p1 = p1 + nmv; }
#pragma unroll
                for (int r = 0; r < 16; ++r) { p0[r] = __builtin_amdgcn_exp2f(p0[r]); p1[r] = __builtin_amdgcn_exp2f(p1[r]); }
                { const f32x16 sv = p0 + p1; const f32x4 s4 = (f32x4){sv[0], sv[1], sv[2], sv[3]} + (f32x4){sv[4], sv[5], sv[6], sv[7]} + (f32x4){sv[8], sv[9], sv[10], sv[11]} + (f32x4){sv[12], sv[13], sv[14], sv[15]};
                  ps = (s4[0] + s4[1]) + (s4[2] + s4[3]); }
                ps = pl32_sum(ps);
                l_reg = l_reg * alpha + ps;
                if (__any(alpha < 1.f)) {
                    if (hi == 0) wsf[32 + r32] = alpha;
                    asm volatile("s_waitcnt lgkmcnt(0)" ::: "memory");
#pragma unroll
                    for (int r = 0; r < 16; ++r) { const float a = wsf[32 + crow(r, hi)];
#pragma unroll
                        for (int d_ = 0; d_ < 4; ++d_) o[d_][r] *= a; }
                }
            } else {
                f32x16 l0, l1;
                const bool diag = (kbase + 63 >= qlo);
#pragma unroll
                for (int r = 0; r < 16; ++r) { const int c = (r & 3) + 8 * (r >> 2);
                    float u0 = __builtin_amdgcn_rcpf(1.0f + __builtin_amdgcn_exp2f(p0[r] * C2));
                    float u1 = __builtin_amdgcn_rcpf(1.0f + __builtin_amdgcn_exp2f(p1[r] * C2));
                    float s0 = 1.0f - u0, s1 = 1.0f - u1;
                    if (diag) { if (dq - c <= 0) { u0 = 1.f; s0 = 0.f; } if (dq - c - 32 <= 0) { u1 = 1.f; s1 = 0.f; } }
                    p0[r] = s0; p1[r] = s1; l0[r] = u0; l1[r] = u1; }
                float cs[2][4], pc[2][4];
#pragma unroll
                for (int g = 0; g < 4; ++g) { cs[0][g] = (l0[4 * g] * l0[4 * g + 1]) * (l0[4 * g + 2] * l0[4 * g + 3]); cs[1][g] = (l1[4 * g] * l1[4 * g + 1]) * (l1[4 * g + 2] * l1[4 * g + 3]); }
#pragma unroll
                for (int g = 0; g < 4; ++g) { pc[0][g] = pl32_other(cs[0][g], hi); pc[1][g] = pl32_other(cs[1][g], hi); }
                float run = Rc;
#pragma unroll
                for (int p = 1; p >= 0; --p)
#pragma unroll
                    for (int g = 3; g >= 0; --g) {
                        float acc = hi == 0 ? run * pc[p][g] : run;
                        run *= cs[p][g] * pc[p][g];
#pragma unroll
                        for (int j = 3; j >= 0; --j) { if (p == 0) { const float a = p0[4 * g + j] * acc; acc *= l0[4 * g + j]; p0[4 * g + j] = a; }
                                                       else { const float a = p1[4 * g + j] * acc; acc *= l1[4 * g + j]; p1[4 * g + j] = a; } }
                    }
                Rc = run;
            }
            PK4(p0, 0, pa0); PK4(p0, 8, pa1); PK4(p1, 0, pa2); PK4(p1, 8, pa3);
            pv_tile(o, vbase + cur * SHM_V, pa0, pa1, pa2, pa3);
        }
        if (it + 1 < NT) { SWRITE(cur ^ 1); }
        { bool drow;
          if (TYPE == 1) drow = Rc < 1e-30f;
          else {
              const float bmax = (TYPE == 0) ? (1.5849625f - slope2 * (float)(qlo + r32 - kbase + 1)) : (cq2 - tab[kbase > 0 ? kbase - 1 : 0]);
              drow = (Bq + bmax - m_reg) < -64.f; }
          const int dn = (wdone || __all(drow)) ? 1 : 0; wdone = dn != 0; if (lane == 0) dflag[(it & 1) * 8 + wid] = dn; }
        __syncthreads();
        { const LAS int* f = dflag + (it & 1) * 8; if ((f[0] & f[1] & f[2] & f[3] & f[4] & f[5] & f[6] & f[7]) != 0) break; }
    }
    float rli[16];
    if (TYPE != 1) {
        if (hi == 0) wsf[r32] = l_reg;
        asm volatile("s_waitcnt lgkmcnt(0)" ::: "memory");
#pragma unroll
        for (int r = 0; r < 16; ++r) rli[r] = __builtin_amdgcn_rcpf(wsf[crow(r, hi)]);
    } else {
#pragma unroll
        for (int r = 0; r < 16; ++r) rli[r] = 1.0f;
    }
    float gh[4];
#pragma unroll
    for (int d0 = 0; d0 < 4; ++d0) gh[d0] = ghead_l[(HOFF + hl) * HD + d0 * 32 + r32];
    bf16_t* Ow = obuf + (size_t)(b * SEQ + qlo) * DM + (HOFF + hl) * HD;
#pragma unroll
    for (int r = 0; r < 16; ++r) {
        float v[4], ss = 0.f;
#pragma unroll
        for (int d0 = 0; d0 < 4; ++d0) { v[d0] = o[d0][r] * rli[r]; ss += v[d0] * v[d0]; }
        ss += __shfl_xor(ss, 1); ss += __shfl_xor(ss, 2); ss += __shfl_xor(ss, 4); ss += __shfl_xor(ss, 8); ss += __shfl_xor(ss, 16);
        const float scl = __builtin_amdgcn_rsqf(ss * (1.0f / HD) + EPS);
        const int orow = crow(r, hi);
#pragma unroll
        for (int d0 = 0; d0 < 4; ++d0) { const float y = v[d0] * scl * gh[d0]; const float yn = __shfl_xor(y, 1);
            if ((r32 & 1) == 0) *(unsigned*)(Ow + (size_t)orow * DM + d0 * 32 + r32) = cvtpk(y, yn); }
    }
    __syncthreads();
#undef TILE_KB
#undef SLOAD
#undef SWRITE
}

__device__ __forceinline__ void attn_phase(const bf16_t* proj, bf16_t* obuf, const float* fcbuf, const float* bf_l, const float* ghead_l, const float* kn, unsigned* ctr, LAS char* lds) {
    LAS int* item_s = (LAS int*)(lds + AT_ITEM);
    for (;;) {
        if (threadIdx.x == 0) *item_s = (int)atomicAdd(ctr, 1u);
        __syncthreads();
        const int i = *item_s;
        __syncthreads();
        if (i >= 1024) break;
        int qb, hh, b;
        if (i < 192) { qb = 7 - i / 24; const int r = i % 24; b = r / 3; hh = 3 + r % 3; }
        else if (i < 512) { const int j = i - 192; qb = 7 - j / 40; const int r = j % 40; b = r / 5; hh = 11 + r % 5; }
        else if (i < 704) { const int j = i - 512; qb = 7 - j / 24; const int r = j % 24; b = r / 3; hh = r % 3; }
        else { const int j = i - 704; qb = 7 - j / 40; const int r = j % 40; b = r / 5; hh = 6 + r % 5; }
        if (hh < 6) attn_item<0>(proj, obuf, fcbuf, bf_l, ghead_l, kn, b, hh, qb, lds);
        if (hh >= 6 && hh < 11) attn_item<1>(proj, obuf, fcbuf, bf_l, ghead_l, kn, b, hh - 6, qb, lds);
        if (hh >= 11) attn_item<2>(proj, obuf, fcbuf, bf_l, ghead_l, kn, b, hh - 11, qb, lds);
    }
}

__global__ void __launch_bounds__(NTHR) fwd(Params p) {
    extern __shared__ __attribute__((aligned(16))) unsigned char lds_raw[];
    LAS unsigned char* lds = (LAS unsigned char*)lds_raw;
    cg::grid_group grid = cg::this_grid();
    unsigned char* ws = p.ws;
    bf16_t* abuf = (bf16_t*)(ws + WS_ABUF); bf16_t* proj = (bf16_t*)(ws + WS_PROJ); bf16_t* hbuf = (bf16_t*)(ws + WS_H); float* halo = (float*)(ws + WS_HALO);
    float* fcbuf = (float*)(ws + WS_FC); unsigned* ctr = (unsigned*)(ws + WS_CTR); float* rss = (float*)(ws + WS_RSS); float* kn = (float*)(ws + WS_KN); bf16_t* xbf = proj;
    if (threadIdx.x < 4) ((LAS unsigned*)(lds + LDS_STAGE))[threadIdx.x] = 0u;
    __syncthreads();
    XcdBarrier xb; xb.bar = (unsigned*)(ws + WS_BAR); xb.x = xb_xcc_id(); xb.st = (volatile LAS unsigned*)(lds + LDS_STAGE);
    { unsigned* z = (unsigned*)(ws + WS_CTR); const size_t nz = (WS_END - WS_CTR) / 4;
      for (size_t i = (size_t)blockIdx.x * NTHR + threadIdx.x; i < nz; i += (size_t)gridDim.x * NTHR) z[i] = 0u; }
    int vc = blockIdx.x;
    int ph = 0;
#define PH_BEGIN if (ph >= p.ph_lo && ph < p.ph_hi) { if (ph > p.ph_lo) { if (ph == p.ph_lo + 1) { grid.sync(); \
            if (threadIdx.x == 0) xb.st[2] = xb_add(&xb.bar[XB_XCNT(xb.x)], 1u);     \
            __syncthreads(); } \
          else { xcd_barrier(xb); \
            if (ph == p.ph_lo + 2) { bool okc = true; for (int j = 0; j < 16; ++j) okc = okc && (xb_ld(&xb.bar[XB_XCNT(j)]) == (j < 8 ? 32u : 0u)); \
                if (okc) vc = 8 * (int)xb.st[2] + (int)xb.x; } } }
#define PH_END } ++ph;
    for (int l = 0; l < 2; ++l) {
        const float* xin = (l == 0) ? p.x : p.out;
        bf16_t* WinT = (bf16_t*)(ws + WS_W + (size_t)l * SZ_WL); bf16_t* WoT = (bf16_t*)((unsigned char*)WinT + SZ_WIN); bf16_t* WguT = (bf16_t*)((unsigned char*)WoT + SZ_WO); bf16_t* WdT = (bf16_t*)((unsigned char*)WguT + SZ_WGU);
        PH_BEGIN
            if (l == 0) {
                convert_weights(p, ws, (LAS float*)lds);
            }
            norm_phase<true, false>(xin, p.g_mix + l * DM, abuf, nullptr, p.w_in + (size_t)l * DM * NIN, fcbuf, (LAS float*)lds);
        PH_END
        PH_BEGIN
            pg8::Gemm g{abuf, WinT, MTOK, NQKV, DM}; pg8::StaticOrder S; S.init(MTOK, NQKV, gridDim.x, vc);
            pg8::EpiProj E{proj, NQKV, kn + (size_t)l * MTOK * 16};
            pg8::gemm_phase<pg8::EpiProj, pg8::StaticOrder>(lds, g, S, E, nullptr);
        PH_END
        PH_BEGIN
            attn_phase(proj, abuf, fcbuf, p.b_f + l * 5, p.g_head + l * DM, kn + (size_t)l * MTOK * 16, ctr + l * 16, (LAS char*)lds);
        PH_END
        PH_BEGIN
            pg8::Gemm g{abuf, WoT, MTOK, DM, DM}; pg8::StaticOrder S; S.init(MTOK, DM, gridDim.x, vc);
            pg8::EpiResN E{xin, p.out, xbf, rss + (size_t)l * MTOK, DM};
            pg8::gemm_phase<pg8::EpiResN, pg8::StaticOrder>(lds, g, S, E, nullptr);
        PH_END
        PH_BEGIN
            pg8::Gemm g{xbf, WguT, MTOK, NGU, DM}; pg8::StaticOrder S; S.init(MTOK, NGU, gridDim.x, vc);
            pg8::EpiConv E{hbuf, halo, p.conv_w + (size_t)l * 3 * NGU, p.conv_b + (size_t)l * NGU, DFF, rss + (size_t)l * MTOK, 1.0f / DM, EPS};
            pg8::gemm_phase<pg8::EpiConv, pg8::StaticOrder>(lds, g, S, E, nullptr);
        PH_END
        PH_BEGIN
            fixup_phase(halo, hbuf, p.conv_w + (size_t)l * 3 * NGU, p.conv_b + (size_t)l * NGU);
        PH_END
        PH_BEGIN
            pg8::Gemm g{hbuf, WdT, MTOK, DM, DFF}; pg8::StaticOrder S; S.init(MTOK, DM, gridDim.x, vc);
            pg8::EpiRes E{p.out, p.out, DM};
            pg8::gemm_phase<pg8::EpiRes, pg8::StaticOrder>(lds, g, S, E, nullptr);
        PH_END
    }
    PH_BEGIN
        norm_phase<false, true>(p.out, p.g_final, nullptr, p.out, nullptr, nullptr, (LAS float*)lds);
    PH_END
#undef PH_BEGIN
#undef PH_END
}
}

extern "C" void kernel_launch(void* const* d_in, const int* in_sizes, int n_in, void* d_out, int out_size, void* d_ws, size_t ws_size, hipStream_t stream) {
    static int grid_blocks = 0;
    if (!grid_blocks) {
        if (n_in != 12 || ws_size < mk::WS_END) { fprintf(stderr, "kernel_launch: unexpected n_in %d or ws_size %zu (< %zu)\n", n_in, ws_size, (size_t)mk::WS_END); grid_blocks = -1; return; }
        int dev = 0, cus = 0, per_cu = 0;
        (void)hipGetDevice(&dev);
        if (hipDeviceGetAttribute(&cus, hipDeviceAttributeMultiprocessorCount, dev) != hipSuccess || cus <= 0) cus = 256;
        if (hipFuncSetAttribute((const void*)mk::fwd, hipFuncAttributeMaxDynamicSharedMemorySize, mk::LDS_BYTES) != hipSuccess) fprintf(stderr, "kernel_launch: hipFuncSetAttribute failed\n");
        if (hipOccupancyMaxActiveBlocksPerMultiprocessor(&per_cu, (const void*)mk::fwd, mk::NTHR, mk::LDS_BYTES) != hipSuccess || per_cu < 1) { per_cu = 1; (void)hipGetLastError(); }
        grid_blocks = cus * per_cu;
    }
    if (grid_blocks < 0) return;
    mk::Params p{};
    p.x = (const float*)d_in[0]; p.g_mix = (const float*)d_in[1]; p.w_in = (const float*)d_in[2]; p.b_f = (const float*)d_in[3]; p.g_head = (const float*)d_in[4];
    p.w_o = (const float*)d_in[5]; p.g_ffn = (const float*)d_in[6]; p.w_gu = (const float*)d_in[7]; p.conv_w = (const float*)d_in[8]; p.conv_b = (const float*)d_in[9];
    p.w_down = (const float*)d_in[10]; p.g_final = (const float*)d_in[11];
    p.out = (float*)d_out; p.ws = (unsigned char*)d_ws; p.ph_lo = 0; p.ph_hi = 1000;
    void* args[] = {&p};
    hipError_t e = hipLaunchCooperativeKernel((void*)mk::fwd, dim3(grid_blocks), dim3(mk::NTHR), args, mk::LDS_BYTES, stream);
    if (e != hipSuccess) fprintf(stderr, "cooperative launch failed: %s (grid %d)\n", hipGetErrorString(e), grid_blocks);
}
```
